# Optimizing an MI355X kernel written in HIP

```python
import math
import jax
import jax.numpy as jnp
from jax import lax
import numpy as np

D_MODEL = 1024
BATCH = 8
SEQ = 4096
DEPTH = 4

HEAD_DIM = 64
N_MIXERS = 3
Q_BLOCK = 128
RMS_EPS = 1e-6
A_HEADS = 16
A_PATTERNS = ((128, 1), (512, 4), (2048, 16))
A_GROUPS = len(A_PATTERNS)
A_WIDTH = A_HEADS * HEAD_DIM
B_HEADS = D_MODEL // (2 * HEAD_DIM)
B_WIDTH = B_HEADS * 2 * HEAD_DIM
C_HEADS = D_MODEL // HEAD_DIM
C_WIDTH = C_HEADS * HEAD_DIM
MOE_GROUPS = 8
MOE_EXPERTS_PER_GROUP = 8
N_EXPERTS = MOE_GROUPS * MOE_EXPERTS_PER_GROUP
MOE_TOP_K = 2
D_EXPERT = D_MODEL // 2
MOE_CHUNK = 128
PLE_DIM = 256
N_A_LAYERS = (DEPTH + N_MIXERS - 1) // N_MIXERS
N_B_LAYERS = (DEPTH + N_MIXERS - 2) // N_MIXERS
N_C_LAYERS = (DEPTH + N_MIXERS - 3) // N_MIXERS

kernel_name = 'hybrid_dilated_diff_stickbreak_hmoe'


def rmsnorm(x, g):
    xf = x.astype(jnp.float32)
    y = xf * lax.rsqrt(jnp.mean(xf * xf, axis=-1, keepdims=True) + RMS_EPS)
    return y.astype(x.dtype) * g


def alibi_slopes(n):
    return jnp.asarray(2.0 ** (-8.0 * np.arange(1, n + 1) / n), dtype=jnp.float32)


def dilated_window_group(q, k, v, window, dilation, slopes):
    B, S, H, dh = q.shape
    r = dilation
    L = S // r
    n_back = window // r
    blk = Q_BLOCK
    assert n_back <= blk
    nb = -(-L // blk)
    Lp = nb * blk

    def to_streams(t):
        t = t.reshape(B, L, r, H, dh).transpose(0, 2, 3, 1, 4)
        t = jnp.pad(t, ((0, 0), (0, 0), (0, 0), (0, Lp - L), (0, 0)))
        return t.reshape(B, r, H, nb, blk, dh)

    def with_prev(t):
        prev = jnp.pad(t, ((0, 0),) * 3 + ((1, 0), (0, 0), (0, 0)))[:, :, :, :-1]
        return jnp.concatenate([prev, t], axis=4)

    qs = to_streams(q * (1.0 / math.sqrt(dh)))
    kk = with_prev(to_streams(k))
    vv = with_prev(to_streams(v))
    scores = jnp.einsum('brhnqd,brhnkd->brhnqk', qs, kk, preferred_element_type=jnp.float32)
    a = jnp.arange(blk)[:, None]
    b = jnp.arange(2 * blk)[None, :]
    delta = blk + a - b
    key_pos = (jnp.arange(nb)[:, None, None] - 1) * blk + b[None]
    valid = (delta >= 0) & (delta <= n_back) & (key_pos >= 0)
    bias = -slopes[:, None, None, None] * (delta * r).astype(jnp.float32)[None, None]
    scores = jnp.where(valid, scores + bias, -jnp.inf)
    m = jnp.max(scores, axis=-1, keepdims=True)
    e = jnp.exp(scores - m)
    s = jnp.sum(e, axis=-1, keepdims=True)
    o = jnp.einsum('brhnqk,brhnkd->brhnqd', e, vv) / s
    lse = (m + jnp.log(s))[..., 0]
    o = o.reshape(B, r, H, Lp, dh)[:, :, :, :L].transpose(0, 3, 1, 2, 4).reshape(B, S, H, dh)
    lse = lse.reshape(B, r, H, Lp)[:, :, :, :L].transpose(0, 3, 1, 2).reshape(B, S, H)
    return o, lse


def dilated_attention(x, w_in, w_out):
    B, S, _ = x.shape
    qkv = (x @ w_in).reshape(B, S, A_GROUPS, 3, A_HEADS, HEAD_DIM)
    slopes = alibi_slopes(A_HEADS)
    outs, lses = [], []
    for g, (window, dilation) in enumerate(A_PATTERNS):
        o, lse = dilated_window_group(qkv[:, :, g, 0], qkv[:, :, g, 1], qkv[:, :, g, 2],
                                      window, dilation, slopes)
        outs.append(o)
        lses.append(lse)
    w = jax.nn.softmax(jnp.stack(lses), axis=0)[..., None]
    o = jnp.sum(w * jnp.stack(outs), axis=0)
    return o.reshape(B, S, A_WIDTH).astype(x.dtype) @ w_out


def differential_attention(x, w_in, w_out, lq1, lk1, lq2, lk2, subln, lambda_init):
    B, S, _ = x.shape
    H, dh = B_HEADS, HEAD_DIM
    qkv = x @ w_in
    q = (qkv[..., :B_WIDTH] * (1.0 / math.sqrt(dh))).reshape(B, S, H, 2, dh)
    k = qkv[..., B_WIDTH:2 * B_WIDTH].reshape(B, S, H, 2, dh)
    v = qkv[..., 2 * B_WIDTH:].reshape(B, S, H, 2 * dh)
    lam = (jnp.exp(jnp.sum(lq1.astype(jnp.float32) * lk1.astype(jnp.float32)))
           - jnp.exp(jnp.sum(lq2.astype(jnp.float32) * lk2.astype(jnp.float32))) + lambda_init)
    slopes = alibi_slopes(H)
    nb = S // Q_BLOCK
    qb = q.reshape(B, nb, Q_BLOCK, H, 2, dh).transpose(1, 0, 2, 3, 4, 5)
    kpos = jnp.arange(S)

    def block(args):
        qblk, n = args
        sc = jnp.einsum('bqhcd,bkhcd->bhcqk', qblk, k, preferred_element_type=jnp.float32)
        dist = (n * Q_BLOCK + jnp.arange(Q_BLOCK))[:, None] - kpos[None, :]
        sc = sc - slopes[:, None, None, None] * dist.astype(jnp.float32)
        sc = jnp.where(dist >= 0, sc, -jnp.inf)
        pr = jax.nn.softmax(sc, axis=-1)
        attn = pr[:, :, 0] - lam * pr[:, :, 1]
        return jnp.einsum('bhqk,bkhe->bqhe', attn, v)

    o = lax.map(block, (qb, jnp.arange(nb)))
    o = o.transpose(1, 0, 2, 3, 4).reshape(B, S, H, 2 * dh)
    o = rmsnorm(o, subln) * (1.0 - lambda_init)
    return o.reshape(B, S, B_WIDTH).astype(x.dtype) @ w_out


def stick_breaking_attention(x, w_in, w_out):
    B, S, _ = x.shape
    H, dh = C_HEADS, HEAD_DIM
    qkv = x @ w_in
    q = (qkv[..., :C_WIDTH] * (1.0 / math.sqrt(dh))).reshape(B, S, H, dh)
    k = qkv[..., C_WIDTH:2 * C_WIDTH].reshape(B, S, H, dh)
    v = qkv[..., 2 * C_WIDTH:].reshape(B, S, H, dh)
    nb = S // Q_BLOCK
    qb = q.reshape(B, nb, Q_BLOCK, H, dh).transpose(1, 0, 2, 3, 4)
    kpos = jnp.arange(S)

    def block(args):
        qblk, n = args
        z = jnp.einsum('bqhd,bkhd->bhqk', qblk, k, preferred_element_type=jnp.float32)
        causal = kpos[None, :] < (n * Q_BLOCK + jnp.arange(Q_BLOCK))[:, None]
        log_beta = jax.nn.log_sigmoid(z)
        log_rest = jnp.where(causal, jax.nn.log_sigmoid(-z), 0.0)
        tail = lax.cumsum(log_rest, axis=3, reverse=True) - log_rest
        a = jnp.where(causal, jnp.exp(log_beta + tail), 0.0)
        return jnp.einsum('bhqk,bkhd->bqhd', a, v)

    o = lax.map(block, (qb, jnp.arange(nb)))
    o = o.transpose(1, 0, 2, 3, 4).reshape(B, S, C_WIDTH)
    return o.astype(x.dtype) @ w_out


def dropless_expert_ffn(xf, experts, gates, w_gate_up, w_down):
    T, D = xf.shape
    ne = w_gate_up.shape[0]
    C = MOE_CHUNK
    n_assign = experts.shape[0] * experts.shape[1]
    flat_e = experts.reshape(-1)
    order = jnp.argsort(flat_e)
    sorted_e = flat_e[order]
    counts = jnp.bincount(flat_e, length=ne)
    padded = (counts + C - 1) // C * C
    pad_end = jnp.cumsum(padded)
    pad_start = pad_end - padded
    start = jnp.cumsum(counts) - counts
    dest = pad_start[sorted_e] + jnp.arange(n_assign) - start[sorted_e]
    n_chunks = (n_assign + ne * (C - 1) + C - 1) // C
    P = n_chunks * C
    row_token = jnp.full((P,), T, jnp.int32).at[dest].set((order // MOE_TOP_K).astype(jnp.int32))
    row_gate = jnp.zeros((P,), jnp.float32).at[dest].set(gates.reshape(-1)[order])
    chunk_expert = jnp.minimum(jnp.searchsorted(pad_end, jnp.arange(n_chunks) * C, side='right'), ne - 1)
    x_rows = jnp.concatenate([xf, jnp.zeros((1, D), xf.dtype)], axis=0)[row_token].reshape(n_chunks, C, D)

    def chunk(args):
        xc, e = args
        gu = xc @ w_gate_up[e]
        return (jax.nn.silu(gu[:, :D_EXPERT]) * gu[:, D_EXPERT:]) @ w_down[e]

    y_rows = lax.map(chunk, (x_rows, chunk_expert)).reshape(P, D)
    y_rows = y_rows * row_gate[:, None].astype(y_rows.dtype)
    return jax.ops.segment_sum(y_rows, row_token, num_segments=T + 1)[:T]


def hierarchical_moe(x, w_coarse, b_coarse, w_fine, b_fine, w_gate_up, w_down):
    B, S, D = x.shape
    xf = x.reshape(-1, D)
    T = xf.shape[0]
    coarse = jax.nn.softmax((xf @ w_coarse + b_coarse).astype(jnp.float32), axis=-1)
    g_prob, g_idx = lax.top_k(coarse, 1)
    fine_logits = (xf @ w_fine + b_fine).astype(jnp.float32).reshape(T, MOE_GROUPS, MOE_EXPERTS_PER_GROUP)
    fine_sel = fine_logits[jnp.arange(T), g_idx[:, 0]]
    f_prob, f_idx = lax.top_k(jax.nn.softmax(fine_sel, axis=-1), MOE_TOP_K)
    f_prob = f_prob / jnp.sum(f_prob, axis=-1, keepdims=True)
    gates = g_prob * f_prob
    experts = g_idx * MOE_EXPERTS_PER_GROUP + f_idx
    y = dropless_expert_ffn(xf, experts, gates, w_gate_up, w_down)
    return y.reshape(B, S, D)


def setup_inputs(seed: int = 0) -> dict:
    key = jax.random.key(seed)
    ks = jax.random.split(key, 25)
    f32 = jnp.float32

    def nrm(k, shape, fan_in):
        return jax.random.normal(k, shape, f32) * fan_in ** -0.5

    def gain(k, shape):
        return 1.0 + 0.01 * jax.random.normal(k, shape, f32)

    D = D_MODEL
    return {
        'x': jax.random.normal(ks[0], (BATCH, SEQ, D), f32),
        'p': jax.random.normal(ks[1], (DEPTH, BATCH, SEQ, PLE_DIM), f32),
        'norm_mix': gain(ks[2], (DEPTH, D)),
        'norm_ffn': gain(ks[3], (DEPTH, D)),
        'norm_ple': gain(ks[4], (DEPTH, D)),
        'norm_final': gain(ks[5], (D,)),
        'a_w_in': nrm(ks[6], (N_A_LAYERS, D, A_GROUPS * 3 * A_WIDTH), D),
        'a_w_out': nrm(ks[7], (N_A_LAYERS, A_WIDTH, D), A_WIDTH),
        'b_w_in': nrm(ks[8], (N_B_LAYERS, D, 3 * B_WIDTH), D),
        'b_w_out': nrm(ks[9], (N_B_LAYERS, B_WIDTH, D), B_WIDTH),
        'b_lambda_q1': 0.1 * jax.random.normal(ks[10], (N_B_LAYERS, HEAD_DIM), f32),
        'b_lambda_k1': 0.1 * jax.random.normal(ks[11], (N_B_LAYERS, HEAD_DIM), f32),
        'b_lambda_q2': 0.1 * jax.random.normal(ks[12], (N_B_LAYERS, HEAD_DIM), f32),
        'b_lambda_k2': 0.1 * jax.random.normal(ks[13], (N_B_LAYERS, HEAD_DIM), f32),
        'b_subln': gain(ks[14], (N_B_LAYERS, 2 * HEAD_DIM)),
        'c_w_in': nrm(ks[15], (N_C_LAYERS, D, 3 * C_WIDTH), D),
        'c_w_out': nrm(ks[16], (N_C_LAYERS, C_WIDTH, D), C_WIDTH),
        'moe_w_coarse': nrm(ks[17], (DEPTH, D, MOE_GROUPS), D),
        'moe_b_coarse': 0.01 * jax.random.normal(ks[18], (DEPTH, MOE_GROUPS), f32),
        'moe_w_fine': nrm(ks[19], (DEPTH, D, N_EXPERTS), D),
        'moe_b_fine': 0.01 * jax.random.normal(ks[20], (DEPTH, N_EXPERTS), f32),
        'moe_w_gate_up': nrm(ks[21], (DEPTH, N_EXPERTS, D, 2 * D_EXPERT), D),
        'moe_w_down': nrm(ks[22], (DEPTH, N_EXPERTS, D_EXPERT, D), D_EXPERT),
        'ple_w_proj': nrm(ks[23], (DEPTH, PLE_DIM, D), PLE_DIM),
        'ple_w_gate': nrm(ks[24], (DEPTH, D, D), D),
    }


def reference(x, p, norm_mix, norm_ffn, norm_ple, norm_final, a_w_in, a_w_out,
              b_w_in, b_w_out, b_lambda_q1, b_lambda_k1, b_lambda_q2, b_lambda_k2, b_subln,
              c_w_in, c_w_out, moe_w_coarse, moe_b_coarse, moe_w_fine, moe_b_fine,
              moe_w_gate_up, moe_w_down, ple_w_proj, ple_w_gate):
    h = x
    for i in range(DEPTH):
        kind = i % N_MIXERS
        j = i // N_MIXERS
        hn = rmsnorm(h, norm_mix[i])
        if kind == 0:
            mix = dilated_attention(hn, a_w_in[j], a_w_out[j])
        elif kind == 1:
            lambda_init = 0.8 - 0.6 * math.exp(-0.3 * i)
            mix = differential_attention(hn, b_w_in[j], b_w_out[j], b_lambda_q1[j], b_lambda_k1[j],
                                         b_lambda_q2[j], b_lambda_k2[j], b_subln[j], lambda_init)
        else:
            mix = stick_breaking_attention(hn, c_w_in[j], c_w_out[j])
        h = h + mix
        h = h + hierarchical_moe(rmsnorm(h, norm_ffn[i]), moe_w_coarse[i], moe_b_coarse[i],
                                 moe_w_fine[i], moe_b_fine[i], moe_w_gate_up[i], moe_w_down[i])
        gate = jax.nn.sigmoid(rmsnorm(h, norm_ple[i]) @ ple_w_gate[i])
        h = h + (p[i] @ ple_w_proj[i]) * gate
    return rmsnorm(h, norm_final)
```

```cpp
#include <hip/hip_runtime.h>
#include <cstdint>
#include <cstdio>

#define DEV __device__ __forceinline__
#define LAS __attribute__((address_space(3)))
typedef unsigned short bf16_t;
typedef short bf16x8 __attribute__((ext_vector_type(8)));
typedef float f32x16 __attribute__((ext_vector_type(16)));
typedef float f32x4 __attribute__((ext_vector_type(4)));

constexpr int D = 1024, BATCH = 8, SEQ = 4096, T = BATCH * SEQ, DEPTH = 4;
constexpr int NE = 64, FE = 512, PLE = 256;
constexpr int NA = 9216, NB = 3072;
constexpr float EPS = 1e-6f;
constexpr int PMAX = 2 * T + NE * 256;
constexpr int NWAVES = 8, NTHR = 512;

constexpr size_t MiB = 1ull << 20;
constexpr size_t WS_CTL = 0;
constexpr size_t WS_WAIN = 1 * MiB;
constexpr size_t WS_WBIN = WS_WAIN + 36 * MiB;
constexpr size_t WS_WCIN = WS_WBIN + 6 * MiB;
constexpr size_t WS_WAOUT = WS_WCIN + 6 * MiB;
constexpr size_t WS_WBOUT = WS_WAOUT + 4 * MiB;
constexpr size_t WS_WCOUT = WS_WBOUT + 2 * MiB;
constexpr size_t WS_WGU = WS_WCOUT + 2 * MiB;
constexpr size_t WS_WDN = WS_WGU + 512 * MiB;
constexpr size_t WS_WPG = WS_WDN + 256 * MiB;
constexpr size_t WS_WPP = WS_WPG + 8 * MiB;
constexpr size_t WS_PB = WS_WPP + 2 * MiB;
constexpr size_t WS_H = WS_PB + 64 * MiB;
constexpr size_t WS_HB = WS_H + 128 * MiB;
constexpr size_t WS_SSQ = WS_HB + 128 * MiB;
constexpr size_t WS_QKV = WS_SSQ + 4 * MiB;
constexpr size_t WS_OG = WS_QKV + 576 * MiB;
constexpr size_t WS_LSE = WS_OG + 192 * MiB;
constexpr size_t WS_O = WS_LSE + 6 * MiB;
constexpr size_t WS_TOK = WS_O + 64 * MiB;
constexpr size_t WS_LIST = WS_TOK + 2 * MiB;
constexpr size_t WS_LRS = WS_LIST + 8 * MiB;
constexpr size_t WS_LGATE = WS_LRS + 8 * MiB;
constexpr size_t WS_ACT = WS_LGATE + 8 * MiB;
constexpr size_t WS_Y = WS_ACT + 80 * MiB;
constexpr size_t WS_PROJ = WS_Y + 160 * MiB;
constexpr size_t WS_END = WS_PROJ + 64 * MiB;
constexpr int CW_CNT = 16384;
constexpr size_t CTL_BYTES = 1 * MiB;

constexpr int LDS_BYTES = 147456;

DEV unsigned f2bf(float f) { unsigned u = __float_as_uint(f); return (u + 0x7fffu + ((u >> 16) & 1u)) >> 16; }
DEV float bf2f(unsigned b) { return __uint_as_float(b << 16); }
DEV unsigned pk2(float lo, float hi) { return f2bf(lo) | (f2bf(hi) << 16); }
DEV float wave_sum(float v) {
#pragma unroll
    for (int o = 1; o < 64; o <<= 1) v += __shfl_xor(v, o);
    return v;
}
DEV float wave_max(float v) {
#pragma unroll
    for (int o = 1; o < 64; o <<= 1) v = fmaxf(v, __shfl_xor(v, o));
    return v;
}
DEV void wave_lds_fence() { asm volatile("s_waitcnt lgkmcnt(0)" ::: "memory"); __builtin_amdgcn_wave_barrier(); }
DEV int opaque_tid() { int t = threadIdx.x; asm volatile("" : "+v"(t)); return t; }
DEV int crow(int i, int hh) { return (i & 3) + 8 * (i >> 2) + 4 * hh; }

struct Ctx {
    const float *x, *p, *norm_mix, *norm_ffn, *norm_ple, *norm_final;
    const float *a_w_in, *a_w_out, *b_w_in, *b_w_out, *lq1, *lk1, *lq2, *lk2, *subln, *c_w_in, *c_w_out;
    const float *w_coarse, *b_coarse, *w_fine, *b_fine, *w_gu, *w_dn, *w_pp, *w_pg;
    float* out;
    unsigned char* ws;
    int G;
    int pad;
};
DEV unsigned* ctl(const Ctx& c) { return (unsigned*)(c.ws + WS_CTL); }

struct Unit { int pm, pn, e, rows, lbase, orow; };

struct StaticOrder {
    int nM, nN, nwg, G, c;
    DEV void init(int M, int N, int G_, int c_) { nM = M / 256; nN = N / 256; nwg = nM * nN; G = G_; c = c_; }
    DEV bool next(int i, Unit& u) const {
        const long L = (long)i * G + c; if (L >= nwg) return false;
        int wgid = (int)L; { const int q = nwg / 8, r = nwg % 8, xcd = wgid % 8, off = wgid / 8; wgid = (xcd < r ? xcd * (q + 1) : r * (q + 1) + (xcd - r) * q) + off; }
        const int nig = 8 * nN, gid = wgid / nig, fm = gid * 8, gsz = (nM - fm) < 8 ? (nM - fm) : 8;
        u.pm = fm + ((wgid % nig) % gsz); u.pn = (wgid % nig) / gsz; u.e = 0; u.rows = 256; u.lbase = 0; u.orow = u.pm * 256; return true;
    }
};
struct MoeOrder {
    int tlo, thi, cn, ntile; int G, c, npn;
    DEV void init(const LAS int* tpre, const int* cnt, int G_, int c_, int npn_) { const int lane = threadIdx.x & 63; tlo = tpre[lane]; thi = tpre[lane + 1]; cn = cnt[lane]; ntile = tpre[64]; G = G_; c = c_; npn = npn_; }
    DEV bool next(int i, Unit& u) const {
        const int id = i * G + c;
        if (id >= ntile * npn) return false;
        const int ti = id / npn; u.pn = id % npn;
        const unsigned long long bal = __ballot(tlo <= ti && ti < thi);
        const int e = (int)__builtin_ctzll(bal | (1ull << 63));
        u.e = e; const int ch = ti - __builtin_amdgcn_readlane(tlo, e); const int n = __builtin_amdgcn_readlane(cn, e);
        u.rows = (n - ch * 256) < 256 ? (n - ch * 256) : 256; u.lbase = e * T + ch * 256; u.pm = ti; u.orow = ti * 256; return true;
    }
};
DEV void moe_prefix(const int* cnt, LAS int* tpre) {
    if (threadIdx.x == 0) { int s = 0; for (int e = 0; e < 64; ++e) { tpre[e] = s; s += (cnt[e] + 255) >> 8; } tpre[64] = s; }
    __syncthreads();
}

constexpr int TBL_OFF = 131072;
constexpr int TBL_TPRE = TBL_OFF + 4096;
typedef float f32x4a __attribute__((ext_vector_type(4)));
typedef unsigned u32x4 __attribute__((ext_vector_type(4)));
typedef unsigned u32x2 __attribute__((ext_vector_type(2)));
DEV unsigned cvt_pk_bf16(float lo, float hi) { unsigned r; asm volatile("v_cvt_pk_bf16_f32 %0, %1, %2" : "=v"(r) : "v"(lo), "v"(hi)); return r; }
DEV float sigmoidf_(float x) { return 1.f / (1.f + __expf(-x)); }

struct HState { float q[16]; };
typedef f32x4 AccT[2][2][4][2];

template <int KIND> struct Prob;

DEV unsigned rs_from_ssq(const float* ssq, int row) {
    const f32x4* s = (const f32x4*)(ssq + (size_t)row * 16); float a = 0.f;
#pragma unroll
    for (int j = 0; j < 4; ++j) { const f32x4 v = s[j]; a += (v.x + v.y) + (v.z + v.w); }
    return __float_as_uint(rsqrtf(a * (1.0f / D) + EPS));
}
DEV void ssq_store_naive(float* ssq, const Unit& u, int w, int lane, HState& s) {
    const int r = lane & 31, hh = lane >> 5;
#pragma unroll
    for (int i = 0; i < 16; ++i) { float v = s.q[i];
#pragma unroll
        for (int o = 1; o < 32; o <<= 1) v += __shfl_xor(v, o);
        if (r < 4) ssq[(size_t)(u.orow + 32 * w + crow(i, hh)) * 16 + u.pn * 4 + r] = (r == 0) ? v : 0.f; }
}

template <> struct Prob<0> {
    static constexpr int NI = 8; static constexpr bool PAIR = false, HAS_TBL = true, DMA_TBL = false;
    const bf16_t* A; int lda; const bf16_t* Bt; int N, K; bf16_t* out; const float* ssq; StaticOrder S;
    DEV void tbl_dma(const Unit&, LAS unsigned char*, int, int) const {}
    typedef int State;
    DEV bool next(int i, Unit& u) const { return S.next(i, u); }
    DEV unsigned tbl_load(const Unit& u) const { const int t = threadIdx.x; return (t < 256) ? (ssq ? rs_from_ssq(ssq, u.orow + t) : __float_as_uint(1.f)) : 0u; }
    DEV void tbl_store(unsigned v, LAS unsigned char* slot) const { const int t = threadIdx.x; if (t < 256) ((LAS unsigned*)(slot + 1024))[t] = v; }
    DEV unsigned arow(const Unit& u, int r, const LAS unsigned char*) const { return (unsigned)(u.orow + r); }
    DEV const bf16_t* b_base(const Unit& u) const { return Bt + (size_t)u.pn * 256 * K; }
    DEV void st_init(State&) const {}
    DEV void epi(const Unit& u, int w, int ni, int lane, const f32x16& a0, const f32x16&, const LAS unsigned char* slot, State&) const {
        const LAS float* tf = (const LAS float*)(slot + 1024); const int r = lane & 31, hh = lane >> 5;
#pragma unroll
        for (int i = 0; i < 16; ++i) { const int row = 32 * w + crow(i, hh); out[(size_t)(u.orow + row) * N + u.pn * 256 + 32 * ni + r] = (bf16_t)f2bf(a0[i] * (ssq ? tf[row] : 1.f)); }
    }
    DEV void finish(const Unit&, int, int, State&) const {}
    DEV void epi_fast(const AccT& acc, const Unit& u, int wr, int wc, int fr, int fq, const LAS unsigned char* slot) const {
        asm volatile("" : "+v"(fr), "+v"(fq));
        const LAS float* tf = (const LAS float*)(slot + 1024);
#pragma unroll
        for (int ai = 0; ai < 2; ++ai)
#pragma unroll
            for (int m = 0; m < 4; ++m) { const int rt = 128 * ai + 64 * wr + 16 * m + fr; const float rs = ssq ? tf[rt] : 1.f;
                bf16_t* rowp = out + (size_t)(u.orow + rt) * N + u.pn * 256 + 32 * wc + 8 * fq;
#pragma unroll
                for (int bj = 0; bj < 2; ++bj) { const f32x4 v0 = acc[ai][bj][m][0] * rs, v1 = acc[ai][bj][m][1] * rs; u32x4 w;
                    w.x = cvt_pk_bf16(v0[0], v0[1]); w.y = cvt_pk_bf16(v0[2], v0[3]); w.z = cvt_pk_bf16(v1[0], v1[1]); w.w = cvt_pk_bf16(v1[2], v1[3]);
                    *(u32x4*)(rowp + 128 * bj) = w; } }
    }
};
template <> struct Prob<1> {
    static constexpr int NI = 8; static constexpr bool PAIR = false, HAS_TBL = false, DMA_TBL = false;
    const bf16_t* A; int lda; const bf16_t* Bt; int N, K; const float* hin;
    DEV void tbl_dma(const Unit&, LAS unsigned char*, int, int) const {} float* h; bf16_t* hb; float* ssq; StaticOrder S;
    typedef HState State;
    DEV bool next(int i, Unit& u) const { return S.next(i, u); }
    DEV unsigned tbl_load(const Unit&) const { return 0u; }
    DEV void tbl_store(unsigned, LAS unsigned char*) const {}
    DEV unsigned arow(const Unit& u, int r, const LAS unsigned char*) const { return (unsigned)(u.orow + r); }
    DEV const bf16_t* b_base(const Unit& u) const { return Bt + (size_t)u.pn * 256 * K; }
    DEV void st_init(State& s) const {
#pragma unroll
        for (int i = 0; i < 16; ++i) s.q[i] = 0.f; }
    DEV void epi(const Unit& u, int w, int ni, int lane, const f32x16& a0, const f32x16&, const LAS unsigned char*, State& s) const {
        const int r = lane & 31, hh = lane >> 5;
#pragma unroll
        for (int i = 0; i < 16; ++i) { const int row = 32 * w + crow(i, hh); const size_t o = (size_t)(u.orow + row) * D + u.pn * 256 + 32 * ni + r;
            const float v = hin[o] + a0[i]; h[o] = v; hb[o] = (bf16_t)f2bf(v); s.q[i] += v * v; }
    }
    DEV void finish(const Unit& u, int w, int lane, State& s) const { ssq_store_naive(ssq, u, w, lane, s); }
    DEV void epi_fast(const AccT& acc, const Unit& u, int wr, int wc, int fr, int fq, const LAS unsigned char*) const {
        asm volatile("" : "+v"(fr), "+v"(fq));
#pragma unroll
        for (int ai = 0; ai < 2; ++ai)
#pragma unroll
            for (int m = 0; m < 4; ++m) { const int rt = 128 * ai + 64 * wr + 16 * m + fr; const size_t o = (size_t)(u.orow + rt) * D + u.pn * 256 + 32 * wc + 8 * fq; float q = 0.f;
#pragma unroll
                for (int bj = 0; bj < 2; ++bj) { const f32x4 h0 = *(const f32x4*)(hin + o + 128 * bj), h1 = *(const f32x4*)(hin + o + 128 * bj + 4);
                    const f32x4 v0 = h0 + acc[ai][bj][m][0], v1 = h1 + acc[ai][bj][m][1];
                    *(f32x4*)(h + o + 128 * bj) = v0; *(f32x4*)(h + o + 128 * bj + 4) = v1; u32x4 w;
                    w.x = cvt_pk_bf16(v0[0], v0[1]); w.y = cvt_pk_bf16(v0[2], v0[3]); w.z = cvt_pk_bf16(v1[0], v1[1]); w.w = cvt_pk_bf16(v1[2], v1[3]);
                    *(u32x4*)(hb + o + 128 * bj) = w;
                    q += (v0[0] * v0[0] + v0[1] * v0[1]) + (v0[2] * v0[2] + v0[3] * v0[3]) + (v1[0] * v1[0] + v1[1] * v1[1]) + (v1[2] * v1[2] + v1[3] * v1[3]); }
                q += __shfl_xor(q, 16); q += __shfl_xor(q, 32);
                if (fq == 0) ssq[(size_t)(u.orow + rt) * 16 + u.pn * 4 + wc] = q; }
    }
};
template <> struct Prob<2> {
    static constexpr int NI = 4; static constexpr bool PAIR = true, HAS_TBL = true, DMA_TBL = true;
    const bf16_t* A; int lda; const bf16_t* Bt; int K; bf16_t* act; const int* list; const float* list_rs; MoeOrder S;
    typedef int State;
    DEV bool next(int i, Unit& u) const { return S.next(i, u); }
    DEV unsigned tbl_load(const Unit& u) const { const int t = threadIdx.x, idx = t & 255; return (t < 256) ? (unsigned)list[u.lbase + idx] : __float_as_uint(list_rs[u.lbase + idx]); }
    DEV void tbl_store(unsigned v, LAS unsigned char* slot) const { const int t = threadIdx.x; ((LAS unsigned*)slot)[t] = v; }
    DEV void tbl_dma(const Unit& u, LAS unsigned char* slot, int wid, int lane) const {
        const unsigned* src = (wid < 4) ? (const unsigned*)list + u.lbase + 64 * wid + lane : (const unsigned*)list_rs + u.lbase + 64 * (wid - 4) + lane;
        __builtin_amdgcn_global_load_lds(src, (LAS unsigned*)(slot + 256 * wid), 4, 0, 0); }
    DEV unsigned arow(const Unit& u, int r, const LAS unsigned char* slot) const { const unsigned e = ((const LAS unsigned*)slot)[r]; return (r < u.rows) ? (e >> 1) : 0u; }
    DEV const bf16_t* b_base(const Unit& u) const { return Bt + ((size_t)u.e * 1024 + u.pn * 256) * K; }
    DEV void st_init(State&) const {}
    DEV void epi(const Unit& u, int w, int ni, int lane, const f32x16& a0, const f32x16& a1, const LAS unsigned char* slot, State&) const {
        const LAS float* tf = (const LAS float*)(slot + 1024); const int r = lane & 31, hh = lane >> 5;
#pragma unroll
        for (int i = 0; i < 16; ++i) { const int row = 32 * w + crow(i, hh); if (row < u.rows) { const float rs = tf[row], g = a0[i] * rs, up = a1[i] * rs;
            act[(size_t)(u.orow + row) * FE + u.pn * 128 + 32 * ni + r] = (bf16_t)f2bf(g * sigmoidf_(g) * up); } }
    }
    DEV void finish(const Unit&, int, int, State&) const {}
    DEV void epi_fast(const AccT& acc, const Unit& u, int wr, int wc, int fr, int fq, const LAS unsigned char* slot) const {
        asm volatile("" : "+v"(fr), "+v"(fq));
        const LAS float* tf = (const LAS float*)(slot + 1024);
#pragma unroll
        for (int ai = 0; ai < 2; ++ai)
#pragma unroll
            for (int m = 0; m < 4; ++m) { const int rt = 128 * ai + 64 * wr + 16 * m + fr; const float rs = tf[rt];
                float o[8];
#pragma unroll
                for (int n = 0; n < 2; ++n)
#pragma unroll
                    for (int j = 0; j < 4; ++j) { const float g = acc[ai][0][m][n][j] * rs, up = acc[ai][1][m][n][j] * rs; o[4 * n + j] = g * sigmoidf_(g) * up; }
                u32x4 w; w.x = cvt_pk_bf16(o[0], o[1]); w.y = cvt_pk_bf16(o[2], o[3]); w.z = cvt_pk_bf16(o[4], o[5]); w.w = cvt_pk_bf16(o[6], o[7]);
                if (rt < u.rows) *(u32x4*)(act + (size_t)(u.orow + rt) * FE + u.pn * 128 + 32 * wc + 8 * fq) = w; }
    }
};
template <> struct Prob<3> {
    static constexpr int NI = 8; static constexpr bool PAIR = false, HAS_TBL = true, DMA_TBL = true;
    const bf16_t* A; int lda; const bf16_t* Bt; int K; bf16_t* y; const float* list_gate; MoeOrder S;
    typedef int State;
    DEV bool next(int i, Unit& u) const { return S.next(i, u); }
    DEV unsigned tbl_load(const Unit& u) const { const int t = threadIdx.x; return (t < 256) ? __float_as_uint(list_gate[u.lbase + t]) : 0u; }
    DEV void tbl_store(unsigned v, LAS unsigned char* slot) const { const int t = threadIdx.x; if (t < 256) ((LAS unsigned*)(slot + 1024))[t] = v; }
    DEV void tbl_dma(const Unit& u, LAS unsigned char* slot, int wid, int lane) const {
        if (wid < 4) __builtin_amdgcn_global_load_lds((const unsigned*)list_gate + u.lbase + 64 * wid + lane, (LAS unsigned*)(slot + 1024 + 256 * wid), 4, 0, 0); }
    DEV unsigned arow(const Unit& u, int r, const LAS unsigned char*) const { return (unsigned)(u.orow + r); }
    DEV const bf16_t* b_base(const Unit& u) const { return Bt + ((size_t)u.e * 1024 + u.pn * 256) * K; }
    DEV void st_init(State&) const {}
    DEV void epi(const Unit& u, int w, int ni, int lane, const f32x16& a0, const f32x16&, const LAS unsigned char* slot, State&) const {
        const LAS float* tf = (const LAS float*)(slot + 1024); const int r = lane & 31, hh = lane >> 5;
#pragma unroll
        for (int i = 0; i < 16; ++i) { const int row = 32 * w + crow(i, hh); if (row < u.rows) y[(size_t)(u.orow + row) * D + u.pn * 256 + 32 * ni + r] = (bf16_t)f2bf(a0[i] * tf[row]); }
    }
    DEV void finish(const Unit&, int, int, State&) const {}
    DEV void epi_fast(const AccT& acc, const Unit& u, int wr, int wc, int fr, int fq, const LAS unsigned char* slot) const {
        asm volatile("" : "+v"(fr), "+v"(fq));
        const LAS float* tf = (const LAS float*)(slot + 1024);
#pragma unroll
        for (int ai = 0; ai < 2; ++ai)
#pragma unroll
            for (int m = 0; m < 4; ++m) { const int rt = 128 * ai + 64 * wr + 16 * m + fr; const float gs = tf[rt];
                bf16_t* rowp = y + (size_t)(u.orow + rt) * D + u.pn * 256 + 32 * wc + 8 * fq;
#pragma unroll
                for (int bj = 0; bj < 2; ++bj) { const f32x4 v0 = acc[ai][bj][m][0] * gs, v1 = acc[ai][bj][m][1] * gs; u32x4 w;
                    w.x = cvt_pk_bf16(v0[0], v0[1]); w.y = cvt_pk_bf16(v0[2], v0[3]); w.z = cvt_pk_bf16(v1[0], v1[1]); w.w = cvt_pk_bf16(v1[2], v1[3]);
                    if (rt < u.rows) *(u32x4*)(rowp + 128 * bj) = w; } }
    }
};
template <> struct Prob<5> {
    static constexpr int NI = 8; static constexpr bool PAIR = false, HAS_TBL = true, DMA_TBL = false;
    const bf16_t* A; int lda; const bf16_t* Bt; int N, K; const bf16_t* proj;
    DEV void tbl_dma(const Unit&, LAS unsigned char*, int, int) const {} float* h; bf16_t* hb; const float* ssq_in; float* ssq_out; StaticOrder S;
    typedef HState State;
    DEV bool next(int i, Unit& u) const { return S.next(i, u); }
    DEV unsigned tbl_load(const Unit& u) const { const int t = threadIdx.x; return (t < 256) ? rs_from_ssq(ssq_in, u.orow + t) : 0u; }
    DEV void tbl_store(unsigned v, LAS unsigned char* slot) const { const int t = threadIdx.x; if (t < 256) ((LAS unsigned*)(slot + 1024))[t] = v; }
    DEV unsigned arow(const Unit& u, int r, const LAS unsigned char*) const { return (unsigned)(u.orow + r); }
    DEV const bf16_t* b_base(const Unit& u) const { return Bt + (size_t)u.pn * 256 * K; }
    DEV void st_init(State& s) const {
#pragma unroll
        for (int i = 0; i < 16; ++i) s.q[i] = 0.f; }
    DEV void epi(const Unit& u, int w, int ni, int lane, const f32x16& a0, const f32x16&, const LAS unsigned char* slot, State& s) const {
        const LAS float* tf = (const LAS float*)(slot + 1024); const int r = lane & 31, hh = lane >> 5;
#pragma unroll
        for (int i = 0; i < 16; ++i) { const int row = 32 * w + crow(i, hh); const size_t o = (size_t)(u.orow + row) * D + u.pn * 256 + 32 * ni + r;
            const float g = sigmoidf_(a0[i] * tf[row]); const float v = h[o] + bf2f(proj[o]) * g; h[o] = v; hb[o] = (bf16_t)f2bf(v); s.q[i] += v * v; }
    }
    DEV void finish(const Unit& u, int w, int lane, State& s) const { ssq_store_naive(ssq_out, u, w, lane, s); }
    DEV void epi_fast(const AccT& acc, const Unit& u, int wr, int wc, int fr, int fq, const LAS unsigned char* slot) const {
        asm volatile("" : "+v"(fr), "+v"(fq));
        const LAS float* tf = (const LAS float*)(slot + 1024);
#pragma unroll
        for (int ai = 0; ai < 2; ++ai)
#pragma unroll
            for (int m = 0; m < 4; ++m) { const int rt = 128 * ai + 64 * wr + 16 * m + fr; const float rs = tf[rt]; const size_t o = (size_t)(u.orow + rt) * D + u.pn * 256 + 32 * wc + 8 * fq; float q = 0.f;
#pragma unroll
                for (int bj = 0; bj < 2; ++bj) { const f32x4 h0 = *(const f32x4*)(h + o + 128 * bj), h1 = *(const f32x4*)(h + o + 128 * bj + 4); const u32x4 pj = *(const u32x4*)(proj + o + 128 * bj);
                    const f32x4 a0 = acc[ai][bj][m][0] * rs, a1 = acc[ai][bj][m][1] * rs; f32x4 v0, v1;
                    v0[0] = h0[0] + bf2f(pj.x & 0xffffu) * sigmoidf_(a0[0]); v0[1] = h0[1] + bf2f(pj.x >> 16) * sigmoidf_(a0[1]); v0[2] = h0[2] + bf2f(pj.y & 0xffffu) * sigmoidf_(a0[2]); v0[3] = h0[3] + bf2f(pj.y >> 16) * sigmoidf_(a0[3]);
                    v1[0] = h1[0] + bf2f(pj.z & 0xffffu) * sigmoidf_(a1[0]); v1[1] = h1[1] + bf2f(pj.z >> 16) * sigmoidf_(a1[1]); v1[2] = h1[2] + bf2f(pj.w & 0xffffu) * sigmoidf_(a1[2]); v1[3] = h1[3] + bf2f(pj.w >> 16) * sigmoidf_(a1[3]);
                    *(f32x4*)(h + o + 128 * bj) = v0; *(f32x4*)(h + o + 128 * bj + 4) = v1; u32x4 w;
                    w.x = cvt_pk_bf16(v0[0], v0[1]); w.y = cvt_pk_bf16(v0[2], v0[3]); w.z = cvt_pk_bf16(v1[0], v1[1]); w.w = cvt_pk_bf16(v1[2], v1[3]);
                    *(u32x4*)(hb + o + 128 * bj) = w;
                    q += (v0[0] * v0[0] + v0[1] * v0[1]) + (v0[2] * v0[2] + v0[3] * v0[3]) + (v1[0] * v1[0] + v1[1] * v1[1]) + (v1[2] * v1[2] + v1[3] * v1[3]); }
                q += __shfl_xor(q, 16); q += __shfl_xor(q, 32);
                if (fq == 0) ssq_out[(size_t)(u.orow + rt) * 16 + u.pn * 4 + wc] = q; }
    }
};

template <class P> DEV void gemm_phase_naive(const P& p, LAS unsigned char* lds) {
    const int tid = threadIdx.x, w = tid >> 6, lane = tid & 63, r = lane & 31, hh = lane >> 5;
    LAS unsigned char* slot = lds + TBL_OFF;
    Unit u;
    for (int i = 0; p.next(i, u); ++i) {
        __syncthreads();
        { const unsigned v = p.tbl_load(u); p.tbl_store(v, slot); }
        __syncthreads();
        const bf16_t* arow = p.A + (size_t)p.arow(u, 32 * w + r, slot) * (size_t)p.lda + 8 * hh;
        const bf16_t* bt = p.b_base(u) + 8 * hh;
        typename P::State st; p.st_init(st);
        for (int ni = 0; ni < P::NI; ++ni) {
            f32x16 a0, a1;
#pragma unroll
            for (int j = 0; j < 16; ++j) { a0[j] = 0.f; a1[j] = 0.f; }
            const bf16_t* b0 = bt + (size_t)(32 * ni + r) * p.K;
            const bf16_t* b1 = bt + (size_t)(32 * ni + 128 + r) * p.K;
            for (int k0 = 0; k0 < p.K; k0 += 16) {
                const bf16x8 a = *(const bf16x8*)(arow + k0);
                const bf16x8 b = *(const bf16x8*)(b0 + k0);
                a0 = __builtin_amdgcn_mfma_f32_32x32x16_bf16(a, b, a0, 0, 0, 0);
                if (P::PAIR) { const bf16x8 bb = *(const bf16x8*)(b1 + k0); a1 = __builtin_amdgcn_mfma_f32_32x32x16_bf16(a, bb, a1, 0, 0, 0); }
            }
            p.epi(u, w, ni, lane, a0, a1, slot, st);
        }
        p.finish(u, w, lane, st);
    }
    __syncthreads();
}

namespace fg {
constexpr int BK = 64, HALF = 128, HTB = HALF * BK * 2;
DEV int lds_byte(int r, int c) { const int st = (r >> 4) * 2 + (c >> 5), rr = r & 15, cc = c & 31, ob = rr * 64 + cc * 2; return st * 1024 + (ob ^ (((ob >> 9) & 1) << 5)); }
DEV void stage_rc(int b, int& R, int& C) { const int st = b / 1024, sb = b % 1024, swz = sb ^ (((sb >> 9) & 1) << 5); R = (st >> 1) * 16 + swz / 64; C = (st & 1) * 32 + (swz % 64) / 2; }
DEV int perm32(int rho) { const int n = rho >> 4, i = rho & 15; return 8 * (i >> 2) + 4 * n + (i & 3); }
}
template <class P> DEV void gemm_phase_fast(const P& p, LAS unsigned char* lds) {
    using namespace fg;
    const int tid = opaque_tid(), wid = __builtin_amdgcn_readfirstlane(tid >> 6), lane = tid & 63, wr = wid >> 2, wc = wid & 3, fr = lane & 15, fq = lane >> 4;
    const int K = p.K, nt = K / BK, lda = p.lda;
    unsigned voffB[2];
#pragma unroll
    for (int i = 0; i < 2; ++i) { int R, C; stage_rc(tid * 16 + i * 8192, R, C); const int Rb = (R & ~31) + perm32(R & 31); voffB[i] = (unsigned)(Rb * K + C) * 2u; }
    const size_t kstep = (size_t)(BK * 2);
    const size_t hstepB = (size_t)HALF * K * 2;
    const unsigned ldsw = (unsigned)wid * 1024u;
    const int aoffl = lds_byte(wr * 64 + fr, fq * 8), boffl = lds_byte(wc * 32 + fr, fq * 8);
#define PG8_SA(b, h) (((b) * 2 + (h)) * HTB)
#define PG8_SB(b, h) ((4 + (b) * 2 + (h)) * HTB)
#define PG8_STAGE(bufoff, gbase, voff) do { _Pragma("unroll") for (int _i = 0; _i < 2; ++_i) \
        __builtin_amdgcn_global_load_lds((const unsigned*)((const char*)(gbase) + (voff)[_i]), (LAS unsigned*)(lds + (bufoff) + ldsw + _i * 8192), 16, 0, 0); } while (0)
#define PG8_LDA(dst, b, h) do { _Pragma("unroll") for (int m = 0; m < 4; ++m) _Pragma("unroll") for (int k = 0; k < 2; ++k) dst[m][k] = *(const LAS bf16x8*)(lds + PG8_SA(b, h) + aoffl + m * 2048 + k * 1024); } while (0)
#define PG8_LDB(dst, b, h) do { _Pragma("unroll") for (int n = 0; n < 2; ++n) _Pragma("unroll") for (int k = 0; k < 2; ++k) dst[n][k] = *(const LAS bf16x8*)(lds + PG8_SB(b, h) + boffl + n * 2048 + k * 1024); } while (0)
#define PG8_MMA(ai, bj, At, Bt) do { __builtin_amdgcn_s_setprio(1); _Pragma("unroll") for (int m = 0; m < 4; ++m) _Pragma("unroll") for (int n = 0; n < 2; ++n) _Pragma("unroll") for (int k = 0; k < 2; ++k) \
        acc[ai][bj][m][n] = __builtin_amdgcn_mfma_f32_16x16x32_bf16(Bt[n][k], At[m][k], acc[ai][bj][m][n], 0, 0, 0); __builtin_amdgcn_s_setprio(0); } while (0)
#define PG8_WAIT_V(n) asm volatile("s_waitcnt vmcnt(" #n ")" ::: "memory")
#define PG8_WAIT_L(n) asm volatile("s_waitcnt lgkmcnt(" #n ")" ::: "memory")
#define PG8_BAR __builtin_amdgcn_s_barrier()
#define PG8_SCHED __builtin_amdgcn_sched_barrier(0)
#define PG8_AOFF(dst, un, slotp) do { _Pragma("unroll") for (int _i = 0; _i < 2; ++_i) { int _R, _C; stage_rc(tid * 16 + _i * 8192, _R, _C); _Pragma("unroll") for (int _h = 0; _h < 2; ++_h) \
        dst[_h][_i] = (p.arow(un, 128 * _h + _R, slotp) * (unsigned)lda + (unsigned)_C) * 2u; } } while (0)
    Unit cur, nxt; int ui = 0;
    if (!p.next(0, cur)) return;
    LAS unsigned char* const tbl = lds + TBL_OFF;
    if constexpr (P::DMA_TBL) { p.tbl_dma(cur, tbl, wid, lane); asm volatile("s_waitcnt vmcnt(0)" ::: "memory"); }
    else { const unsigned v = p.tbl_load(cur); p.tbl_store(v, tbl); }
    __syncthreads();
    AccT acc;
#pragma unroll
    for (int a = 0; a < 2; ++a)
#pragma unroll
        for (int b = 0; b < 2; ++b)
#pragma unroll
            for (int m = 0; m < 4; ++m)
#pragma unroll
                for (int n = 0; n < 2; ++n) acc[a][b][m][n] = (f32x4){0.f, 0.f, 0.f, 0.f};
    bf16x8 At[4][2], B0[2][2], B1[2][2];
    unsigned ao[2][2];
    PG8_AOFF(ao, cur, tbl);
    const char* const Ab = (const char*)p.A;
    const char* cB = (const char*)p.b_base(cur);
    PG8_STAGE(PG8_SB(0, 0), cB, voffB); PG8_STAGE(PG8_SB(0, 1), cB + hstepB, voffB); PG8_STAGE(PG8_SA(0, 0), Ab, ao[0]); PG8_STAGE(PG8_SA(0, 1), Ab, ao[1]);
    if (wr == 1) PG8_BAR;
    PG8_WAIT_V(2); PG8_BAR;
    PG8_STAGE(PG8_SB(1, 0), cB + kstep, voffB); PG8_STAGE(PG8_SA(1, 0), Ab + kstep, ao[0]); PG8_STAGE(PG8_SB(1, 1), cB + hstepB + kstep, voffB);
    PG8_WAIT_V(6); PG8_BAR;
    for (;;) {
        const bool has_next = p.next(ui + 1, nxt);
        const char* nB = has_next ? (const char*)p.b_base(nxt) : cB;
        LAS unsigned char* const nslot = tbl + ((ui + 1) & 1) * 2048;
        for (int t = 0; t < nt; t += 2) {
            const bool last = (t == nt - 2);
            unsigned tv = 0u; const bool do_tbl = P::HAS_TBL && (t == 2) && has_next && !last;
            if constexpr (P::DMA_TBL) { if (do_tbl) p.tbl_dma(nxt, nslot, wid, lane); } else { if (do_tbl) tv = p.tbl_load(nxt); }
            const char* a1 = Ab + (size_t)(t + 1) * kstep;
            const char* a2 = last ? Ab : Ab + (size_t)(t + 2) * kstep; const char* b2 = last ? nB : cB + (size_t)(t + 2) * kstep;
            const char* a3 = a2 + kstep; const char* b3 = b2 + kstep;
            PG8_LDB(B0, 0, 0); PG8_LDB(B1, 0, 1); PG8_SCHED; PG8_LDA(At, 0, 0); PG8_STAGE(PG8_SA(1, 1), a1, ao[1]);
            if (last && has_next) { PG8_AOFF(ao, nxt, nslot); }
            PG8_WAIT_V(8); PG8_WAIT_L(0); PG8_BAR; PG8_MMA(0, 0, At, B0); PG8_MMA(0, 1, At, B1); PG8_BAR; PG8_SCHED;
            PG8_LDA(At, 0, 1); PG8_STAGE(PG8_SB(0, 0), b2, voffB); PG8_STAGE(PG8_SB(0, 1), b2 + hstepB, voffB); PG8_STAGE(PG8_SA(0, 0), a2, ao[0]);
            PG8_WAIT_V(8); PG8_WAIT_L(0); PG8_BAR; PG8_MMA(1, 0, At, B0); PG8_MMA(1, 1, At, B1); PG8_BAR; PG8_SCHED;
            PG8_LDB(B0, 1, 0); PG8_LDB(B1, 1, 1); PG8_SCHED; PG8_LDA(At, 1, 0); PG8_STAGE(PG8_SA(0, 1), a2, ao[1]);
            PG8_WAIT_V(8); PG8_WAIT_L(0); PG8_BAR; PG8_MMA(0, 0, At, B0); PG8_MMA(0, 1, At, B1); PG8_BAR; PG8_SCHED;
            PG8_LDA(At, 1, 1); PG8_STAGE(PG8_SB(1, 0), b3, voffB); PG8_STAGE(PG8_SB(1, 1), b3 + hstepB, voffB); PG8_STAGE(PG8_SA(1, 0), a3, ao[0]);
            PG8_WAIT_V(8); PG8_WAIT_L(0); PG8_BAR; PG8_MMA(1, 0, At, B0); PG8_MMA(1, 1, At, B1); PG8_BAR; PG8_SCHED;
            if constexpr (!P::DMA_TBL) { if (do_tbl) p.tbl_store(tv, nslot); }
        }
        if (wr == 0) PG8_BAR;
        p.epi_fast(acc, cur, wr, wc, fr, fq, tbl + (ui & 1) * 2048);
        if (!has_next) break;
#pragma unroll
        for (int a = 0; a < 2; ++a)
#pragma unroll
            for (int b = 0; b < 2; ++b)
#pragma unroll
                for (int m = 0; m < 4; ++m)
#pragma unroll
                    for (int n = 0; n < 2; ++n) acc[a][b][m][n] = (f32x4){0.f, 0.f, 0.f, 0.f};
        cur = nxt; cB = nB; ++ui;
        if (wr == 1) PG8_BAR;
    }
    PG8_WAIT_V(0);
    PG8_BAR;
#undef PG8_SA
#undef PG8_SB
#undef PG8_STAGE
#undef PG8_LDA
#undef PG8_LDB
#undef PG8_MMA
#undef PG8_WAIT_V
#undef PG8_WAIT_L
#undef PG8_BAR
#undef PG8_SCHED
#undef PG8_AOFF
}
#ifndef FAST_GEMM
#define FAST_GEMM 1
#endif
template <class P> DEV void gemm_phase(const P& p, LAS unsigned char* lds) {
#if FAST_GEMM
    gemm_phase_fast(p, lds);
#else
    gemm_phase(p, lds);
#endif
}

DEV void cvt_weight(const float* src, bf16_t* dst, int K, int N, int nbatch, int mode, const float* gbase, LAS unsigned char* lds, int G) {
    const int tid = opaque_tid(), half = tid >> 8, t = tid & 255;
    LAS float* tile = (LAS float*)lds + half * (64 * 65);
    const int tn = N / 64, tpm = (K / 64) * tn, total = tpm * nbatch;
    for (int base = blockIdx.x * 2; base < total; base += G * 2) {
        const int id = base + half; const bool ok = id < total;
        int b = 0, k0 = 0, n0 = 0;
        if (ok) { b = id / tpm; const int rem = id % tpm; k0 = (rem / tn) * 64; n0 = (rem % tn) * 64; }
        const float* g = nullptr;
        if (mode == 1) g = gbase + (size_t)(3 * b) * D; else if (mode == 2) g = gbase; else if (mode == 3) g = gbase + (size_t)(b / 64) * D; else if (mode == 4) g = gbase + (size_t)b * D;
        if (ok) {
            const int nn = t & 63; const int n = n0 + nn; float cs = 1.f;
            if (mode == 1) cs = ((n % 3072) < 1024) ? 0.125f : 1.f; else if (mode == 2) cs = (n < 1024) ? 0.125f : 1.f;
            const float* s = src + (size_t)b * K * N + (size_t)k0 * N + n;
#pragma unroll 4
            for (int i = 0; i < 16; ++i) { const int kk = i * 4 + (t >> 6); float v = s[(size_t)kk * N] * cs; if (g) v *= g[k0 + kk]; tile[kk * 65 + nn] = v; }
        }
        __syncthreads();
        if (ok) {
            const int nn = t >> 2, kq = t & 3; int n = n0 + nn;
            if (mode == 3) { if (n < 512) n = 256 * (n >> 7) + (n & 127); else { const int j = n - 512; n = 256 * (j >> 7) + 128 + (j & 127); } }
            unsigned w[8];
#pragma unroll
            for (int j = 0; j < 8; ++j) w[j] = pk2(tile[(kq * 16 + 2 * j) * 65 + nn], tile[(kq * 16 + 2 * j + 1) * 65 + nn]);
            uint4* d = (uint4*)(dst + (size_t)b * K * N + (size_t)n * K + k0 + kq * 16);
            d[0] = make_uint4(w[0], w[1], w[2], w[3]); d[1] = make_uint4(w[4], w[5], w[6], w[7]);
        }
        __syncthreads();
    }
}

DEV void phase_prologue(const Ctx& c, LAS unsigned char* lds) {
    unsigned char* ws = c.ws;
    cvt_weight(c.a_w_in, (bf16_t*)(ws + WS_WAIN), D, NA, 2, 1, c.norm_mix, lds, c.G);
    cvt_weight(c.b_w_in, (bf16_t*)(ws + WS_WBIN), D, NB, 1, 2, c.norm_mix + 1 * D, lds, c.G);
    cvt_weight(c.c_w_in, (bf16_t*)(ws + WS_WCIN), D, NB, 1, 2, c.norm_mix + 2 * D, lds, c.G);
    cvt_weight(c.a_w_out, (bf16_t*)(ws + WS_WAOUT), D, D, 2, 0, nullptr, lds, c.G);
    cvt_weight(c.b_w_out, (bf16_t*)(ws + WS_WBOUT), D, D, 1, 0, nullptr, lds, c.G);
    cvt_weight(c.c_w_out, (bf16_t*)(ws + WS_WCOUT), D, D, 1, 0, nullptr, lds, c.G);
    cvt_weight(c.w_gu, (bf16_t*)(ws + WS_WGU), D, 1024, DEPTH * NE, 3, c.norm_ffn, lds, c.G);
    cvt_weight(c.w_dn, (bf16_t*)(ws + WS_WDN), FE, D, DEPTH * NE, 0, nullptr, lds, c.G);
    cvt_weight(c.w_pg, (bf16_t*)(ws + WS_WPG), D, D, DEPTH, 4, c.norm_ple, lds, c.G);
    cvt_weight(c.w_pp, (bf16_t*)(ws + WS_WPP), PLE, D, DEPTH, 0, nullptr, lds, c.G);
    { const size_t n4 = (size_t)DEPTH * T * PLE / 4; const f32x4* s = (const f32x4*)c.p; uint2* d = (uint2*)(ws + WS_PB);
      for (size_t i = (size_t)blockIdx.x * NTHR + threadIdx.x; i < n4; i += (size_t)c.G * NTHR) { const f32x4 v = s[i]; d[i] = make_uint2(pk2(v.x, v.y), pk2(v.z, v.w)); } }
    { const int tid_ = opaque_tid(); const int w = tid_ >> 6, lane = tid_ & 63; bf16_t* hb = (bf16_t*)(ws + WS_HB); float* ssq = (float*)(ws + WS_SSQ);
      for (int tok = blockIdx.x * NWAVES + w; tok < T; tok += c.G * NWAVES) {
          const f32x4* xr = (const f32x4*)(c.x + (size_t)tok * D) + lane; uint2* o = (uint2*)(hb + (size_t)tok * D) + lane; float s = 0.f;
#pragma unroll
          for (int j = 0; j < 4; ++j) { const f32x4 v = xr[64 * j]; s += (v.x * v.x + v.y * v.y) + (v.z * v.z + v.w * v.w); o[64 * j] = make_uint2(pk2(v.x, v.y), pk2(v.z, v.w)); }
          s = wave_sum(s); if (lane < 16) ssq[(size_t)tok * 16 + lane] = (lane == 0) ? s : 0.f; } }
}

DEV float dot64(const LAS float* q, const bf16_t* k) {
    const uint4* kp = (const uint4*)k; float s = 0.f;
#pragma unroll
    for (int j = 0; j < 8; ++j) { const uint4 v = kp[j]; const LAS float* qq = q + 8 * j;
        s += qq[0] * __uint_as_float(v.x << 16) + qq[1] * __uint_as_float(v.x & 0xffff0000u) + qq[2] * __uint_as_float(v.y << 16) + qq[3] * __uint_as_float(v.y & 0xffff0000u)
           + qq[4] * __uint_as_float(v.z << 16) + qq[5] * __uint_as_float(v.z & 0xffff0000u) + qq[6] * __uint_as_float(v.w << 16) + qq[7] * __uint_as_float(v.w & 0xffff0000u); }
    return s;
}

DEV void attA_naive(const Ctx& c, LAS unsigned char* lds) {
    const int tid_ = opaque_tid(); const int w = tid_ >> 6, lane = tid_ & 63;
    LAS float* qs = (LAS float*)lds + w * 1024; LAS float* ps = qs + 192;
    const bf16_t* qkv = (const bf16_t*)(c.ws + WS_QKV); bf16_t* o = (bf16_t*)(c.ws + WS_O);
    for (int item = blockIdx.x * NWAVES + w; item < T * 16; item += c.G * NWAVES) {
        const int ta = item >> 4, hd = item & 15, t = ta & (SEQ - 1);
        const float slope = exp2f(-0.5f * (float)(hd + 1));
        const bf16_t* row = qkv + (size_t)ta * NA + hd * 64;
#pragma unroll
        for (int g = 0; g < 3; ++g) qs[g * 64 + lane] = bf2f(row[g * 3072 + lane]);
        wave_lds_fence();
        float sc[3][3]; float m = -INFINITY;
#pragma unroll
        for (int g = 0; g < 3; ++g) { const int r = (g == 0) ? 1 : (g == 1 ? 4 : 16); const int i = t / r;
#pragma unroll
            for (int rd = 0; rd < 3; ++rd) { const int delta = lane + 64 * rd; float s = -INFINITY;
                if (delta <= 128 && delta <= i) { const bf16_t* kr = qkv + (size_t)(ta - delta * r) * NA + g * 3072 + 1024 + hd * 64; s = dot64(qs + g * 64, kr) - slope * (float)(delta * r); }
                sc[g][rd] = s; m = fmaxf(m, s); } }
        m = wave_max(m); float sum = 0.f;
#pragma unroll
        for (int g = 0; g < 3; ++g)
#pragma unroll
            for (int rd = 0; rd < 3; ++rd) { const float pv = (sc[g][rd] == -INFINITY) ? 0.f : __expf(sc[g][rd] - m); sum += pv; ps[g * 192 + lane + 64 * rd] = pv; }
        sum = wave_sum(sum);
        wave_lds_fence();
        float acc = 0.f;
#pragma unroll
        for (int g = 0; g < 3; ++g) { const int r = (g == 0) ? 1 : (g == 1 ? 4 : 16); const int i = t / r; const int nd = i < 128 ? i : 128;
            const bf16_t* vb = qkv + (size_t)ta * NA + g * 3072 + 2048 + hd * 64 + lane;
            for (int delta = 0; delta <= nd; ++delta) acc += ps[g * 192 + delta] * bf2f(vb[-(ptrdiff_t)delta * r * NA]); }
        o[(size_t)ta * D + hd * 64 + lane] = (bf16_t)f2bf(acc / sum);
        wave_lds_fence();
    }
}

DEV void attB_naive(const Ctx& c, float lam, float lambda_init, const float* subln, LAS unsigned char* lds) {
    const int tid_ = opaque_tid(); const int w = tid_ >> 6, lane = tid_ & 63;
    LAS float* qs = (LAS float*)lds + w * 256; LAS float* wl = qs + 128;
    const bf16_t* qkv = (const bf16_t*)(c.ws + WS_QKV); bf16_t* o = (bf16_t*)(c.ws + WS_O);
    for (int item = blockIdx.x * NWAVES + w; item < T * 8; item += c.G * NWAVES) {
        const int ta = item >> 3, hd = item & 7, t = ta & (SEQ - 1), b0 = ta - t;
        const float slope = exp2f(-(float)(hd + 1));
        const bf16_t* qrow = qkv + (size_t)ta * NB + hd * 128;
        qs[lane] = bf2f(qrow[lane]); qs[64 + lane] = bf2f(qrow[64 + lane]);
        wave_lds_fence();
        const bf16_t* kb = qkv + (size_t)b0 * NB + 1024 + hd * 128;
        float m1 = -INFINITY, m2 = -INFINITY;
        for (int s0 = 0; s0 <= t; s0 += 64) { const int s = s0 + lane; if (s <= t) { const bf16_t* kr = kb + (size_t)s * NB; const float bias = slope * (float)(t - s);
            m1 = fmaxf(m1, dot64(qs, kr) - bias); m2 = fmaxf(m2, dot64(qs + 64, kr + 64) - bias); } }
        m1 = wave_max(m1); m2 = wave_max(m2);
        float l1 = 0.f, l2 = 0.f;
        for (int s0 = 0; s0 <= t; s0 += 64) { const int s = s0 + lane; if (s <= t) { const bf16_t* kr = kb + (size_t)s * NB; const float bias = slope * (float)(t - s);
            l1 += __expf(dot64(qs, kr) - bias - m1); l2 += __expf(dot64(qs + 64, kr + 64) - bias - m2); } }
        l1 = wave_sum(l1); l2 = wave_sum(l2);
        const float i1 = 1.f / l1, i2 = lam / l2;
        float o0 = 0.f, o1 = 0.f;
        const bf16_t* vb = qkv + (size_t)b0 * NB + 2048 + hd * 128 + lane;
        for (int s0 = 0; s0 <= t; s0 += 64) { const int s = s0 + lane; float wv = 0.f;
            if (s <= t) { const bf16_t* kr = kb + (size_t)s * NB; const float bias = slope * (float)(t - s);
                wv = __expf(dot64(qs, kr) - bias - m1) * i1 - __expf(dot64(qs + 64, kr + 64) - bias - m2) * i2; }
            wl[lane] = wv; wave_lds_fence();
            const int nj = (t - s0) < 63 ? (t - s0) : 63;
            for (int j = 0; j <= nj; ++j) { const bf16_t* vr = vb + (size_t)(s0 + j) * NB; const float ww = wl[j]; o0 += ww * bf2f(vr[0]); o1 += ww * bf2f(vr[64]); }
            wave_lds_fence(); }
        const float ss = wave_sum(o0 * o0 + o1 * o1) * (1.f / 128.f); const float rs = rsqrtf(ss + EPS) * (1.f - lambda_init);
        o[(size_t)ta * D + hd * 128 + lane] = (bf16_t)f2bf(o0 * rs * subln[lane]);
        o[(size_t)ta * D + hd * 128 + 64 + lane] = (bf16_t)f2bf(o1 * rs * subln[64 + lane]);
    }
}

DEV void attC_naive(const Ctx& c, LAS unsigned char* lds) {
    const int tid_ = opaque_tid(); const int w = tid_ >> 6, lane = tid_ & 63;
    LAS float* qs = (LAS float*)lds + w * 128; LAS float* wl = qs + 64;
    const bf16_t* qkv = (const bf16_t*)(c.ws + WS_QKV); bf16_t* o = (bf16_t*)(c.ws + WS_O);
    for (int item = blockIdx.x * NWAVES + w; item < T * 16; item += c.G * NWAVES) {
        const int ta = item >> 4, hd = item & 15, t = ta & (SEQ - 1), b0 = ta - t;
        qs[lane] = bf2f(qkv[(size_t)ta * NB + hd * 64 + lane]);
        wave_lds_fence();
        const bf16_t* kb = qkv + (size_t)b0 * NB + 1024 + hd * 64; const bf16_t* vb = qkv + (size_t)b0 * NB + 2048 + hd * 64 + lane;
        float R = 0.f, acc = 0.f;
        for (int sh = t - 1; sh >= 0 && R > -120.f; sh -= 64) {
            const int s = sh - lane; const bool valid = s >= 0; float z = 0.f;
            if (valid) z = dot64(qs, kb + (size_t)s * NB);
            const float ls = fminf(z, 0.f) - log1pf(__expf(-fabsf(z)));
            const float lr = valid ? (ls - z) : 0.f;
            float inc = lr;
#pragma unroll
            for (int d = 1; d < 64; d <<= 1) { const float v = __shfl_up(inc, d); if (lane >= d) inc += v; }
            const float tail = R + inc - lr;
            wl[lane] = valid ? __expf(ls + tail) : 0.f;
            R += __shfl(inc, 63);
            wave_lds_fence();
            const int nj = sh < 63 ? sh : 63;
            for (int j = 0; j <= nj; ++j) acc += wl[j] * bf2f(vb[(size_t)(sh - j) * NB]);
            wave_lds_fence();
        }
        o[(size_t)ta * D + hd * 64 + lane] = (bf16_t)f2bf(acc);
    }
}

template <int L> DEV void phase_router(const Ctx& c, LAS unsigned char* lds) {
    const int tid_ = opaque_tid(); const int w = tid_ >> 6, lane = tid_ & 63;
    LAS float* xs = (LAS float*)lds + w * 4096;
    LAS float* lg = (LAS float*)(lds + 131072) + w * 320;
    const float* h = (const float*)(c.ws + WS_H); const float* g = c.norm_ffn + L * D;
    const float* wc = c.w_coarse + (size_t)L * D * 8; const float* wf = c.w_fine + (size_t)L * D * 64;
    float* tok_gate = (float*)(c.ws + WS_TOK); int* tok_e = (int*)(c.ws + WS_TOK + 262144); int* tok_slot = (int*)(c.ws + WS_TOK + 524288); float* rs_ffn = (float*)(c.ws + WS_TOK + 786432);
    int* list = (int*)(c.ws + WS_LIST); float* list_rs = (float*)(c.ws + WS_LRS); float* list_gate = (float*)(c.ws + WS_LGATE); unsigned* cnt = ctl(c) + CW_CNT + L * 64;
    for (int grp = blockIdx.x * NWAVES + w; grp < T / 4; grp += c.G * NWAVES) {
        float rsv[4];
#pragma unroll
        for (int tk = 0; tk < 4; ++tk) { const int tok = grp * 4 + tk; const f32x4* hr = (const f32x4*)(h + (size_t)tok * D) + lane; f32x4 v[4]; float s = 0.f;
#pragma unroll
            for (int j = 0; j < 4; ++j) { v[j] = hr[64 * j]; s += (v[j].x * v[j].x + v[j].y * v[j].y) + (v[j].z * v[j].z + v[j].w * v[j].w); }
            const float rs = rsqrtf(wave_sum(s) * (1.f / D) + EPS); rsv[tk] = rs;
#pragma unroll
            for (int j = 0; j < 4; ++j) { const f32x4 gg = ((const f32x4*)g)[64 * j + lane]; f32x4 xv; xv.x = v[j].x * rs * gg.x; xv.y = v[j].y * rs * gg.y; xv.z = v[j].z * rs * gg.z; xv.w = v[j].w * rs * gg.w;
                ((LAS f32x4*)(xs + tk * 1024))[64 * j + lane] = xv; } }
        wave_lds_fence();
        float af[4] = {0.f, 0.f, 0.f, 0.f}, ac[4] = {0.f, 0.f, 0.f, 0.f};
        for (int k = 0; k < D; k += 4) {
            float wfv[4], wcv[4];
#pragma unroll
            for (int j = 0; j < 4; ++j) { wfv[j] = wf[(size_t)(k + j) * 64 + lane]; wcv[j] = wc[(size_t)(k + j) * 8 + (lane & 7)]; }
#pragma unroll
            for (int tk = 0; tk < 4; ++tk) { const f32x4 xv = *(const LAS f32x4*)(xs + tk * 1024 + k);
                af[tk] += xv.x * wfv[0]; af[tk] += xv.y * wfv[1]; af[tk] += xv.z * wfv[2]; af[tk] += xv.w * wfv[3];
                ac[tk] += xv.x * wcv[0]; ac[tk] += xv.y * wcv[1]; ac[tk] += xv.z * wcv[2]; ac[tk] += xv.w * wcv[3]; }
        }
#pragma unroll
        for (int tk = 0; tk < 4; ++tk) { lg[tk * 80 + 8 + lane] = af[tk] + c.b_fine[L * 64 + lane]; if (lane < 8) lg[tk * 80 + lane] = ac[tk] + c.b_coarse[L * 8 + lane]; }
        wave_lds_fence();
        if (lane < 4) { const int tok = grp * 4 + lane; const LAS float* l = lg + lane * 80;
            int gi = 0; float gm = l[0];
            for (int j = 1; j < 8; ++j) if (l[j] > gm) { gm = l[j]; gi = j; }
            float gs = 0.f; for (int j = 0; j < 8; ++j) gs += __expf(l[j] - gm);
            const float gp = 1.f / gs;
            const LAS float* f = l + 8 + gi * 8;
            int i1 = 0; float f1 = f[0]; for (int j = 1; j < 8; ++j) if (f[j] > f1) { f1 = f[j]; i1 = j; }
            int i2 = -1; float f2 = -INFINITY; for (int j = 0; j < 8; ++j) if (j != i1 && f[j] > f2) { f2 = f[j]; i2 = j; }
            const float e2 = __expf(f2 - f1); const float p1 = 1.f / (1.f + e2), p2 = e2 / (1.f + e2);
            float rs = 0.f; for (int tk = 0; tk < 4; ++tk) if (tk == lane) rs = rsv[tk];
            rs_ffn[tok] = rs;
            const int e1 = gi * 8 + i1, e2i = gi * 8 + i2;
            const int s1 = (int)atomicAdd(cnt + e1, 1u), s2 = (int)atomicAdd(cnt + e2i, 1u);
            list[(size_t)e1 * T + s1] = tok * 2; list[(size_t)e2i * T + s2] = tok * 2 + 1; list_rs[(size_t)e1 * T + s1] = rs; list_rs[(size_t)e2i * T + s2] = rs; list_gate[(size_t)e1 * T + s1] = gp * p1; list_gate[(size_t)e2i * T + s2] = gp * p2;
            tok_e[tok * 2] = e1; tok_e[tok * 2 + 1] = e2i; tok_slot[tok * 2] = s1; tok_slot[tok * 2 + 1] = s2; tok_gate[tok * 2] = gp * p1; tok_gate[tok * 2 + 1] = gp * p2; }
        wave_lds_fence();
    }
}

template <int L> DEV void phase_combine(const Ctx& c, LAS unsigned char* lds) {
    const int tid_ = opaque_tid(); const int w = tid_ >> 6, lane = tid_ & 63;
    LAS int* tpre = (LAS int*)(lds + TBL_TPRE);
    moe_prefix((const int*)(ctl(c) + CW_CNT + L * 64), tpre);
    float* h = (float*)(c.ws + WS_H); bf16_t* hb = (bf16_t*)(c.ws + WS_HB + (size_t)(L & 1) * 64 * MiB); float* ssq = (float*)(c.ws + WS_SSQ + (size_t)(L & 1) * 2 * MiB); const bf16_t* y = (const bf16_t*)(c.ws + WS_Y);
    const int* tok_e = (const int*)(c.ws + WS_TOK + 262144); const int* tok_slot = (const int*)(c.ws + WS_TOK + 524288);
    for (int tok = blockIdx.x * NWAVES + w; tok < T; tok += c.G * NWAVES) {
        const size_t p0 = (size_t)tpre[tok_e[tok * 2]] * 256 + tok_slot[tok * 2], p1 = (size_t)tpre[tok_e[tok * 2 + 1]] * 256 + tok_slot[tok * 2 + 1];
        f32x4* hr = (f32x4*)(h + (size_t)tok * D) + lane; const uint2* y0 = (const uint2*)(y + p0 * D) + lane; const uint2* y1 = (const uint2*)(y + p1 * D) + lane; uint2* o = (uint2*)(hb + (size_t)tok * D) + lane;
        float s = 0.f;
#pragma unroll
        for (int j = 0; j < 4; ++j) { f32x4 v = hr[64 * j]; const uint2 a = y0[64 * j], b = y1[64 * j];
            v.x += bf2f(a.x & 0xffffu) + bf2f(b.x & 0xffffu); v.y += bf2f(a.x >> 16) + bf2f(b.x >> 16); v.z += bf2f(a.y & 0xffffu) + bf2f(b.y & 0xffffu); v.w += bf2f(a.y >> 16) + bf2f(b.y >> 16);
            hr[64 * j] = v; o[64 * j] = make_uint2(pk2(v.x, v.y), pk2(v.z, v.w)); s += (v.x * v.x + v.y * v.y) + (v.z * v.z + v.w * v.w); }
        s = wave_sum(s); if (lane < 16) ssq[(size_t)tok * 16 + lane] = (lane == 0) ? s : 0.f;
    }
}

DEV void phase_final(const Ctx& c) {
    const int tid_ = opaque_tid(); const int w = tid_ >> 6, lane = tid_ & 63;
    const float* h = (const float*)(c.ws + WS_H); const float* ssq = (const float*)(c.ws + WS_SSQ);
    for (int tok = blockIdx.x * NWAVES + w; tok < T; tok += c.G * NWAVES) {
        float a = (lane < 16) ? ssq[(size_t)tok * 16 + lane] : 0.f; a = wave_sum(a); const float rs = rsqrtf(a * (1.f / D) + EPS);
        const f32x4* hr = (const f32x4*)(h + (size_t)tok * D) + lane; f32x4* o = (f32x4*)(c.out + (size_t)tok * D) + lane;
#pragma unroll
        for (int j = 0; j < 4; ++j) { const f32x4 v = hr[64 * j]; const f32x4 g = ((const f32x4*)c.norm_final)[64 * j + lane]; f32x4 r; r.x = v.x * rs * g.x; r.y = v.y * rs * g.y; r.z = v.z * rs * g.z; r.w = v.w * rs * g.w; o[64 * j] = r; }
    }
}

template <int PH> DEV void run_phase(const Ctx& c, LAS unsigned char* lds) {
    unsigned char* ws = c.ws;
    if constexpr (PH == 0) { phase_prologue(c, lds); }
    else if constexpr (PH == 41) { phase_final(c); }
    else {
        constexpr int L = (PH - 1) / 10, S = (PH - 1) % 10, KIND = L % 3, J = L / 3;
        constexpr size_t HBC = WS_HB + (size_t)(L & 1) * 64 * MiB, HBN = WS_HB + (size_t)((L + 1) & 1) * 64 * MiB, SQC = WS_SSQ + (size_t)(L & 1) * 2 * MiB, SQN = WS_SSQ + (size_t)((L + 1) & 1) * 2 * MiB;
        if constexpr (S == 0) {
            Prob<0> p; p.A = (const bf16_t*)(ws + HBC); p.lda = D; p.K = D; p.out = (bf16_t*)(ws + WS_QKV); p.ssq = (const float*)(ws + SQC);
            if (KIND == 0) { p.Bt = (const bf16_t*)(ws + WS_WAIN) + (size_t)J * NA * D; p.N = NA; } else if (KIND == 1) { p.Bt = (const bf16_t*)(ws + WS_WBIN); p.N = NB; } else { p.Bt = (const bf16_t*)(ws + WS_WCIN); p.N = NB; }
            p.S.init(T, p.N, c.G, blockIdx.x);
            gemm_phase(p, lds);
        } else if constexpr (S == 1) {
            if constexpr (KIND == 0) attA_naive(c, lds);
            else if constexpr (KIND == 1) {
                const float lambda_init = 0.8f - 0.6f * expf(-0.3f * (float)L);
                float s1 = 0.f, s2 = 0.f; for (int i = 0; i < 64; ++i) { s1 += c.lq1[J * 64 + i] * c.lk1[J * 64 + i]; s2 += c.lq2[J * 64 + i] * c.lk2[J * 64 + i]; }
                const float lam = expf(s1) - expf(s2) + lambda_init;
                attB_naive(c, lam, lambda_init, c.subln + J * 128, lds);
            } else attC_naive(c, lds);
        } else if constexpr (S == 2) {
        } else if constexpr (S == 3) {
            Prob<1> p; p.A = (const bf16_t*)(ws + WS_O); p.lda = D; p.K = D; p.N = D;
            p.Bt = (KIND == 0) ? (const bf16_t*)(ws + WS_WAOUT) + (size_t)J * D * D : (KIND == 1) ? (const bf16_t*)(ws + WS_WBOUT) : (const bf16_t*)(ws + WS_WCOUT);
            p.hin = (L == 0) ? c.x : (const float*)(ws + WS_H); p.h = (float*)(ws + WS_H); p.hb = (bf16_t*)(ws + HBC); p.ssq = (float*)(ws + SQC);
            p.S.init(T, D, c.G, blockIdx.x);
            gemm_phase(p, lds);
        } else if constexpr (S == 4) {
            phase_router<L>(c, lds);
        } else if constexpr (S == 5) {
            LAS int* tpre = (LAS int*)(lds + TBL_TPRE); const int* cnt = (const int*)(ctl(c) + CW_CNT + L * 64);
            moe_prefix(cnt, tpre);
            Prob<2> p; p.A = (const bf16_t*)(ws + HBC); p.lda = D; p.K = D; p.Bt = (const bf16_t*)(ws + WS_WGU) + (size_t)L * NE * 1024 * D; p.act = (bf16_t*)(ws + WS_ACT);
            p.list = (const int*)(ws + WS_LIST); p.list_rs = (const float*)(ws + WS_LRS); p.S.init(tpre, cnt, c.G, blockIdx.x, 4);
            gemm_phase(p, lds);
        } else if constexpr (S == 6) {
            LAS int* tpre = (LAS int*)(lds + TBL_TPRE); const int* cnt = (const int*)(ctl(c) + CW_CNT + L * 64);
            moe_prefix(cnt, tpre);
            Prob<3> p; p.A = (const bf16_t*)(ws + WS_ACT); p.lda = FE; p.K = FE; p.Bt = (const bf16_t*)(ws + WS_WDN) + (size_t)L * NE * D * FE; p.y = (bf16_t*)(ws + WS_Y);
            p.list_gate = (const float*)(ws + WS_LGATE); p.S.init(tpre, cnt, c.G, blockIdx.x, 4);
            gemm_phase(p, lds);
        } else if constexpr (S == 7) {
            phase_combine<L>(c, lds);
            __syncthreads();
            Prob<0> p; p.ssq = nullptr; p.A = (const bf16_t*)(ws + WS_PB) + (size_t)L * T * PLE; p.lda = PLE; p.K = PLE; p.N = D; p.Bt = (const bf16_t*)(ws + WS_WPP) + (size_t)L * D * PLE; p.out = (bf16_t*)(ws + WS_PROJ);
            p.S.init(T, D, c.G, blockIdx.x);
            gemm_phase(p, lds);
        } else if constexpr (S == 8) {
            Prob<5> p; p.A = (const bf16_t*)(ws + HBC); p.lda = D; p.K = D; p.N = D; p.Bt = (const bf16_t*)(ws + WS_WPG) + (size_t)L * D * D; p.proj = (const bf16_t*)(ws + WS_PROJ);
            p.h = (float*)(ws + WS_H); p.hb = (bf16_t*)(ws + HBN); p.ssq_in = (const float*)(ws + SQC); p.ssq_out = (float*)(ws + SQN);
            p.S.init(T, D, c.G, blockIdx.x);
            gemm_phase(p, lds);
        }
    }
}

#define XB_TMO      128
#define XB_XCNT(j)  (256  + 64 * (j))
#define XB_XSUB(j)  (1280 + 64 * (j))
#define XB_XGEN(j)  (2304 + 64 * (j))
#define XB_TOP      3328
#define XB_TOPGEN   3392
#define XCD_BAR_WORDS 3456
#define XB_SPIN_CAP (1u << 18)
__device__ __forceinline__ unsigned xb_ld(unsigned* p)              { return __hip_atomic_load(p, __ATOMIC_RELAXED, __HIP_MEMORY_SCOPE_AGENT); }
__device__ __forceinline__ unsigned xb_add(unsigned* p, unsigned v) { return __hip_atomic_fetch_add(p, v, __ATOMIC_RELAXED, __HIP_MEMORY_SCOPE_AGENT); }
__device__ __forceinline__ unsigned xb_xcc_id() { return (unsigned)__builtin_amdgcn_s_getreg((3 << 11) | 20) & 0xFu; }
#define XB_SPIN(cond, bar) do { unsigned _sp = 0; while (cond) { __builtin_amdgcn_s_sleep(1); \
    if ((++_sp & 255u) == 0u) { if (xb_ld(&(bar)[XB_TMO])) break; if (_sp > XB_SPIN_CAP) { atomicAdd(&(bar)[XB_TMO], 1u); break; } } } } while (0)
struct XcdBarrier {
    unsigned* bar; unsigned x;
    volatile LAS unsigned* st;
};
__device__ __forceinline__ XcdBarrier xcd_barrier_post(unsigned* bar, volatile LAS unsigned* st) {
    XcdBarrier b; b.bar = bar; b.x = xb_xcc_id(); b.st = st;
    if (threadIdx.x == 0) (void)xb_add(&bar[XB_XCNT(b.x)], 1u);
    return b;
}
__device__ __forceinline__ void xcd_barrier_complete(unsigned* bar, unsigned x, unsigned& nloc, unsigned& nx) {
    const unsigned G = gridDim.x * gridDim.y * gridDim.z;
    unsigned sum, cnt, mine, sp = 0u;
    for (;;) {
        sum = 0u; cnt = 0u; mine = 0u;
#pragma unroll
        for (unsigned j = 0; j < 16; ++j) { const unsigned c = xb_ld(&bar[XB_XCNT(j)]); sum += c; cnt += (c > 0u) ? 1u : 0u; mine = (j == x) ? c : mine; }
        if (sum == G) break;
        __builtin_amdgcn_s_sleep(1);
        if ((++sp & 255u) == 0u) { if (xb_ld(&bar[XB_TMO])) break; if (sp > XB_SPIN_CAP) { atomicAdd(&bar[XB_TMO], 1u); break; } }
    }
    nloc = mine > 0u ? mine : 1u; nx = cnt > 0u ? cnt : 1u;
}
__device__ __forceinline__ void xcd_barrier(const XcdBarrier& b) {
    asm volatile("s_waitcnt vmcnt(0)" ::: "memory");
    __syncthreads();
    if (threadIdx.x == 0) {
        unsigned* bar = b.bar;
        __builtin_amdgcn_s_waitcnt(0);
        unsigned nloc = b.st[0], nx = b.st[1];
        if (nloc == 0u) { xcd_barrier_complete(bar, b.x, nloc, nx); b.st[0] = nloc; b.st[1] = nx; }
        const unsigned old = xb_add(&bar[XB_XSUB(b.x)], 1u);
        const unsigned gen = old / nloc;
        if (old + 1u == (gen + 1u) * nloc) {
            __builtin_amdgcn_fence(__ATOMIC_RELEASE, "agent");
            asm volatile("s_waitcnt vmcnt(0)" ::: "memory");
            const unsigned og = xb_add(&bar[XB_TOP], 1u);
            const unsigned tg = og / nx;
            if (og + 1u == (tg + 1u) * nx) xb_add(&bar[XB_TOPGEN], 1u);
            else XB_SPIN(xb_ld(&bar[XB_TOPGEN]) == tg, bar);
            __builtin_amdgcn_fence(__ATOMIC_ACQUIRE, "agent");
            xb_add(&bar[XB_XGEN(b.x)], 1u);
            asm volatile("s_waitcnt vmcnt(0)" ::: "memory");
        } else {
            XB_SPIN(xb_ld(&bar[XB_XGEN(b.x)]) == gen, bar);
            __builtin_amdgcn_fence(__ATOMIC_ACQUIRE, "agent");
            asm volatile("s_waitcnt vmcnt(0)" ::: "memory");
        }
    }
    __syncthreads();
}

constexpr int CW_BAR = 4096;
constexpr int LDS_BARW = 143360;

#ifndef MK_MULTI
#define MK_MULTI 0
#endif
#if MK_MULTI
template <int PH> __global__ void __launch_bounds__(NTHR, 2) k_phase(Ctx c) {
    extern __shared__ __attribute__((aligned(16))) unsigned char lds_raw[];
    run_phase<PH>(c, (LAS unsigned char*)lds_raw);
}
template <int PH> static void launch_phase(const Ctx& c, hipStream_t stream) {
    static bool attr = false;
    if (!attr) { (void)hipFuncSetAttribute((const void*)k_phase<PH>, hipFuncAttributeMaxDynamicSharedMemorySize, LDS_BYTES); attr = true; }
    hipLaunchKernelGGL(k_phase<PH>, dim3(c.G), dim3(NTHR), LDS_BYTES, stream, c);
}
template <int L> static void launch_layer(const Ctx& c, hipStream_t s) {
    launch_phase<1 + 10 * L + 0>(c, s); launch_phase<1 + 10 * L + 1>(c, s); launch_phase<1 + 10 * L + 3>(c, s); launch_phase<1 + 10 * L + 4>(c, s);
    launch_phase<1 + 10 * L + 5>(c, s); launch_phase<1 + 10 * L + 6>(c, s); launch_phase<1 + 10 * L + 7>(c, s); launch_phase<1 + 10 * L + 8>(c, s);
}
static void launch_all(const Ctx& c, hipStream_t stream) {
    launch_all(c, stream);
}
#else
template <int L> DEV void run_layer(const Ctx& c, LAS unsigned char* lds, const XcdBarrier& bar) {
    run_phase<1 + 10 * L + 0>(c, lds); xcd_barrier(bar);
    run_phase<1 + 10 * L + 1>(c, lds); xcd_barrier(bar);
    run_phase<1 + 10 * L + 3>(c, lds); xcd_barrier(bar);
    run_phase<1 + 10 * L + 4>(c, lds); xcd_barrier(bar);
    run_phase<1 + 10 * L + 5>(c, lds); xcd_barrier(bar);
    run_phase<1 + 10 * L + 6>(c, lds); xcd_barrier(bar);
    run_phase<1 + 10 * L + 7>(c, lds); xcd_barrier(bar);
    run_phase<1 + 10 * L + 8>(c, lds); xcd_barrier(bar);
}
__global__ void __launch_bounds__(NTHR, 2) mega_fwd(Ctx c) {
    extern __shared__ __attribute__((aligned(16))) unsigned char lds_raw[];
    LAS unsigned char* lds = (LAS unsigned char*)lds_raw;
    if (threadIdx.x < 4) ((LAS unsigned*)(lds + LDS_BARW))[threadIdx.x] = 0u;
    __syncthreads();
    const XcdBarrier bar = xcd_barrier_post(ctl(c) + CW_BAR, (volatile LAS unsigned*)(lds + LDS_BARW));
    run_phase<0>(c, lds); xcd_barrier(bar);
    run_layer<0>(c, lds, bar); run_layer<1>(c, lds, bar); run_layer<2>(c, lds, bar); run_layer<3>(c, lds, bar);
    run_phase<41>(c, lds);
}
static void launch_all(const Ctx& c, hipStream_t stream) {
    static bool attr = false;
    if (!attr) { (void)hipFuncSetAttribute((const void*)mega_fwd, hipFuncAttributeMaxDynamicSharedMemorySize, LDS_BYTES);
        int per_cu = 0; if (hipOccupancyMaxActiveBlocksPerMultiprocessor(&per_cu, (const void*)mega_fwd, NTHR, LDS_BYTES) != hipSuccess || per_cu < 1) fprintf(stderr, "kernel_launch: occupancy query reports %d blocks per CU\n", per_cu);
        (void)hipGetLastError(); attr = true; }
    hipLaunchKernelGGL(mega_fwd, dim3(c.G), dim3(NTHR), LDS_BYTES, stream, c);
}
#endif

extern "C" void kernel_launch(void* const* d_in, const int* in_sizes, int n_in, void* d_out, int out_size, void* d_ws, size_t ws_size, hipStream_t stream) {
    if (n_in != 25 || ws_size < WS_END) { fprintf(stderr, "kernel_launch: unexpected n_in %d or ws_size %zu (< %zu)\n", n_in, ws_size, (size_t)WS_END); return; }
    static int grid = 0;
    if (!grid) { int dev = 0, cus = 0; (void)hipGetDevice(&dev); (void)hipDeviceGetAttribute(&cus, hipDeviceAttributeMultiprocessorCount, dev); grid = cus > 0 ? cus : 256; }
    Ctx c{};
    const float* const* in = (const float* const*)d_in;
    c.x = in[0]; c.p = in[1]; c.norm_mix = in[2]; c.norm_ffn = in[3]; c.norm_ple = in[4]; c.norm_final = in[5];
    c.a_w_in = in[6]; c.a_w_out = in[7]; c.b_w_in = in[8]; c.b_w_out = in[9]; c.lq1 = in[10]; c.lk1 = in[11]; c.lq2 = in[12]; c.lk2 = in[13]; c.subln = in[14];
    c.c_w_in = in[15]; c.c_w_out = in[16]; c.w_coarse = in[17]; c.b_coarse = in[18]; c.w_fine = in[19]; c.b_fine = in[20]; c.w_gu = in[21]; c.w_dn = in[22]; c.w_pp = in[23]; c.w_pg = in[24];
    c.out = (float*)d_out; c.ws = (unsigned char*)d_ws; c.G = grid; c.pad = 0;
    (void)hipMemsetAsync((char*)d_ws + WS_CTL, 0, CTL_BYTES, stream);
    launch_all(c, stream);
}
```

```cpp
#include <hip/hip_runtime.h>
#include <cstdint>
#include <cstdio>

#define DEV __device__ __forceinline__
#define LAS __attribute__((address_space(3)))
typedef unsigned short bf16_t;
typedef short bf16x8 __attribute__((ext_vector_type(8)));
typedef float f32x16 __attribute__((ext_vector_type(16)));
typedef float f32x4 __attribute__((ext_vector_type(4)));

constexpr int D = 1024, BATCH = 8, SEQ = 4096, T = BATCH * SEQ, DEPTH = 4;
constexpr int NE = 64, FE = 512, PLE = 256;
constexpr int NA = 9216, NB = 3072;
constexpr float EPS = 1e-6f;
constexpr float LOG2E = 1.4426950408889634f, LN2 = 0.6931471805599453f;
constexpr float QSCALE = 0.125f * LOG2E;
constexpr int PMAX = 2 * T + NE * 256;
constexpr int NWAVES = 8, NTHR = 512;

constexpr size_t MiB = 1ull << 20;
constexpr size_t WS_CTL = 0;
constexpr size_t WS_WAIN = 1 * MiB;
constexpr size_t WS_WBIN = WS_WAIN + 36 * MiB;
constexpr size_t WS_WCIN = WS_WBIN + 6 * MiB;
constexpr size_t WS_WAOUT = WS_WCIN + 6 * MiB;
constexpr size_t WS_WBOUT = WS_WAOUT + 4 * MiB;
constexpr size_t WS_WCOUT = WS_WBOUT + 2 * MiB;
constexpr size_t WS_WGU = WS_WCOUT + 2 * MiB;
constexpr size_t WS_WDN = WS_WGU + 512 * MiB;
constexpr size_t WS_WPG = WS_WDN + 256 * MiB;
constexpr size_t WS_WPP = WS_WPG + 8 * MiB;
constexpr size_t WS_PB = WS_WPP + 2 * MiB;
constexpr size_t WS_H = WS_PB + 64 * MiB;
constexpr size_t WS_HB = WS_H + 128 * MiB;
constexpr size_t WS_SSQ = WS_HB + 128 * MiB;
constexpr size_t WS_QKV = WS_SSQ + 4 * MiB;
constexpr size_t WS_OG = WS_QKV + 576 * MiB;
constexpr size_t WS_LSE = WS_OG + 192 * MiB;
constexpr size_t WS_O = WS_LSE + 6 * MiB;
constexpr size_t WS_TOK = WS_O + 64 * MiB;
constexpr size_t WS_LIST = WS_TOK + 2 * MiB;
constexpr size_t WS_LRS = WS_LIST + 8 * MiB;
constexpr size_t WS_LGATE = WS_LRS + 8 * MiB;
constexpr size_t WS_ACT = WS_LGATE + 8 * MiB;
constexpr size_t WS_Y = WS_ACT + 80 * MiB;
constexpr size_t WS_PROJ = WS_Y + 160 * MiB;
constexpr size_t WS_END = WS_PROJ + 64 * MiB;
constexpr int CW_CNT = 16384;
constexpr size_t CTL_BYTES = 1 * MiB;

constexpr int LDS_BYTES = 147456;

DEV unsigned f2bf(float f) { unsigned u = __float_as_uint(f); return (u + 0x7fffu + ((u >> 16) & 1u)) >> 16; }
DEV float bf2f(unsigned b) { return __uint_as_float(b << 16); }
DEV unsigned pk2(float lo, float hi) { return f2bf(lo) | (f2bf(hi) << 16); }
DEV float wave_sum(float v) {
#pragma unroll
    for (int o = 1; o < 64; o <<= 1) v += __shfl_xor(v, o);
    return v;
}
DEV float wave_max(float v) {
#pragma unroll
    for (int o = 1; o < 64; o <<= 1) v = fmaxf(v, __shfl_xor(v, o));
    return v;
}
DEV void wave_lds_fence() { asm volatile("s_waitcnt lgkmcnt(0)" ::: "memory"); __builtin_amdgcn_wave_barrier(); }
DEV int opaque_tid() { int t = threadIdx.x; asm volatile("" : "+v"(t)); return t; }
DEV int crow(int i, int hh) { return (i & 3) + 8 * (i >> 2) + 4 * hh; }

struct Ctx {
    const float *x, *p, *norm_mix, *norm_ffn, *norm_ple, *norm_final;
    const float *a_w_in, *a_w_out, *b_w_in, *b_w_out, *lq1, *lk1, *lq2, *lk2, *subln, *c_w_in, *c_w_out;
    const float *w_coarse, *b_coarse, *w_fine, *b_fine, *w_gu, *w_dn, *w_pp, *w_pg;
    float* out;
    unsigned char* ws;
    int G;
    int pad;
};
DEV unsigned* ctl(const Ctx& c) { return (unsigned*)(c.ws + WS_CTL); }

struct Unit { int pm, pn, e, rows, lbase, orow; };

struct StaticOrder {
    int nM, nN, nwg, G, c;
    DEV void init(int M, int N, int G_, int c_) { nM = M / 256; nN = N / 256; nwg = nM * nN; G = G_; c = c_; }
    DEV bool next(int i, Unit& u) const {
        const long L = (long)i * G + c; if (L >= nwg) return false;
        int wgid = (int)L; { const int q = nwg / 8, r = nwg % 8, xcd = wgid % 8, off = wgid / 8; wgid = (xcd < r ? xcd * (q + 1) : r * (q + 1) + (xcd - r) * q) + off; }
        const int nig = 8 * nN, gid = wgid / nig, fm = gid * 8, gsz = (nM - fm) < 8 ? (nM - fm) : 8;
        u.pm = fm + ((wgid % nig) % gsz); u.pn = (wgid % nig) / gsz; u.e = 0; u.rows = 256; u.lbase = 0; u.orow = u.pm * 256; return true;
    }
};
struct MoeOrder {
    int tlo, thi, cn, ntile; int G, c, npn;
    DEV void init(const LAS int* tpre, const int* cnt, int G_, int c_, int npn_) { const int lane = threadIdx.x & 63; tlo = tpre[lane]; thi = tpre[lane + 1]; cn = cnt[lane]; ntile = tpre[64]; G = G_; c = c_; npn = npn_; }
    DEV bool next(int i, Unit& u) const {
        const int id = i * G + c;
        if (id >= ntile * npn) return false;
        const int ti = id / npn; u.pn = id % npn;
        const unsigned long long bal = __ballot(tlo <= ti && ti < thi);
        const int e = (int)__builtin_ctzll(bal | (1ull << 63));
        u.e = e; const int ch = ti - __builtin_amdgcn_readlane(tlo, e); const int n = __builtin_amdgcn_readlane(cn, e);
        u.rows = (n - ch * 256) < 256 ? (n - ch * 256) : 256; u.lbase = e * T + ch * 256; u.pm = ti; u.orow = ti * 256; return true;
    }
};
DEV void moe_prefix(const int* cnt, LAS int* tpre) {
    if (threadIdx.x == 0) { int s = 0; for (int e = 0; e < 64; ++e) { tpre[e] = s; s += (cnt[e] + 255) >> 8; } tpre[64] = s; }
    __syncthreads();
}

constexpr int TBL_OFF = 131072;
constexpr int TBL_TPRE = TBL_OFF + 4096;
typedef float f32x4a __attribute__((ext_vector_type(4)));
typedef unsigned u32x4 __attribute__((ext_vector_type(4)));
typedef unsigned u32x2 __attribute__((ext_vector_type(2)));
DEV unsigned cvt_pk_bf16(float lo, float hi) { unsigned r; asm volatile("v_cvt_pk_bf16_f32 %0, %1, %2" : "=v"(r) : "v"(lo), "v"(hi)); return r; }
DEV float sigmoidf_(float x) { return 1.f / (1.f + __expf(-x)); }

struct HState { float q[16]; };
typedef f32x4 AccT[2][2][4][2];

template <int KIND> struct Prob;

DEV unsigned rs_from_ssq(const float* ssq, int row) {
    const f32x4* s = (const f32x4*)(ssq + (size_t)row * 16); float a = 0.f;
#pragma unroll
    for (int j = 0; j < 4; ++j) { const f32x4 v = s[j]; a += (v.x + v.y) + (v.z + v.w); }
    return __float_as_uint(rsqrtf(a * (1.0f / D) + EPS));
}
DEV void ssq_store_naive(float* ssq, const Unit& u, int w, int lane, HState& s) {
    const int r = lane & 31, hh = lane >> 5;
#pragma unroll
    for (int i = 0; i < 16; ++i) { float v = s.q[i];
#pragma unroll
        for (int o = 1; o < 32; o <<= 1) v += __shfl_xor(v, o);
        if (r < 4) ssq[(size_t)(u.orow + 32 * w + crow(i, hh)) * 16 + u.pn * 4 + r] = (r == 0) ? v : 0.f; }
}

template <> struct Prob<0> {
    static constexpr int NI = 8; static constexpr bool PAIR = false, HAS_TBL = true, DMA_TBL = false;
    const bf16_t* A; int lda; const bf16_t* Bt; int N, K; bf16_t* out; const float* ssq; StaticOrder S;
    DEV void tbl_dma(const Unit&, LAS unsigned char*, int, int) const {}
    typedef int State;
    DEV bool next(int i, Unit& u) const { return S.next(i, u); }
    DEV unsigned tbl_load(const Unit& u) const { const int t = threadIdx.x; return (t < 256) ? (ssq ? rs_from_ssq(ssq, u.orow + t) : __float_as_uint(1.f)) : 0u; }
    DEV void tbl_store(unsigned v, LAS unsigned char* slot) const { const int t = threadIdx.x; if (t < 256) ((LAS unsigned*)(slot + 1024))[t] = v; }
    DEV unsigned arow(const Unit& u, int r, const LAS unsigned char*) const { return (unsigned)(u.orow + r); }
    DEV const bf16_t* b_base(const Unit& u) const { return Bt + (size_t)u.pn * 256 * K; }
    DEV void st_init(State&) const {}
    DEV void epi(const Unit& u, int w, int ni, int lane, const f32x16& a0, const f32x16&, const LAS unsigned char* slot, State&) const {
        const LAS float* tf = (const LAS float*)(slot + 1024); const int r = lane & 31, hh = lane >> 5;
#pragma unroll
        for (int i = 0; i < 16; ++i) { const int row = 32 * w + crow(i, hh); out[(size_t)(u.orow + row) * N + u.pn * 256 + 32 * ni + r] = (bf16_t)f2bf(a0[i] * (ssq ? tf[row] : 1.f)); }
    }
    DEV void finish(const Unit&, int, int, State&) const {}
    DEV void epi_fast(const AccT& acc, const Unit& u, int wr, int wc, int fr, int fq, const LAS unsigned char* slot) const {
        asm volatile("" : "+v"(fr), "+v"(fq));
        const LAS float* tf = (const LAS float*)(slot + 1024);
#pragma unroll
        for (int ai = 0; ai < 2; ++ai)
#pragma unroll
            for (int m = 0; m < 4; ++m) { const int rt = 128 * ai + 64 * wr + 16 * m + fr; const float rs = ssq ? tf[rt] : 1.f;
                bf16_t* rowp = out + (size_t)(u.orow + rt) * N + u.pn * 256 + 32 * wc + 8 * fq;
#pragma unroll
                for (int bj = 0; bj < 2; ++bj) { const f32x4 v0 = acc[ai][bj][m][0] * rs, v1 = acc[ai][bj][m][1] * rs; u32x4 w;
                    w.x = cvt_pk_bf16(v0[0], v0[1]); w.y = cvt_pk_bf16(v0[2], v0[3]); w.z = cvt_pk_bf16(v1[0], v1[1]); w.w = cvt_pk_bf16(v1[2], v1[3]);
                    *(u32x4*)(rowp + 128 * bj) = w; } }
    }
};
template <> struct Prob<1> {
    static constexpr int NI = 8; static constexpr bool PAIR = false, HAS_TBL = false, DMA_TBL = false;
    const bf16_t* A; int lda; const bf16_t* Bt; int N, K; const float* hin;
    DEV void tbl_dma(const Unit&, LAS unsigned char*, int, int) const {} float* h; bf16_t* hb; float* ssq; StaticOrder S;
    typedef HState State;
    DEV bool next(int i, Unit& u) const { return S.next(i, u); }
    DEV unsigned tbl_load(const Unit&) const { return 0u; }
    DEV void tbl_store(unsigned, LAS unsigned char*) const {}
    DEV unsigned arow(const Unit& u, int r, const LAS unsigned char*) const { return (unsigned)(u.orow + r); }
    DEV const bf16_t* b_base(const Unit& u) const { return Bt + (size_t)u.pn * 256 * K; }
    DEV void st_init(State& s) const {
#pragma unroll
        for (int i = 0; i < 16; ++i) s.q[i] = 0.f; }
    DEV void epi(const Unit& u, int w, int ni, int lane, const f32x16& a0, const f32x16&, const LAS unsigned char*, State& s) const {
        const int r = lane & 31, hh = lane >> 5;
#pragma unroll
        for (int i = 0; i < 16; ++i) { const int row = 32 * w + crow(i, hh); const size_t o = (size_t)(u.orow + row) * D + u.pn * 256 + 32 * ni + r;
            const float v = hin[o] + a0[i]; h[o] = v; hb[o] = (bf16_t)f2bf(v); s.q[i] += v * v; }
    }
    DEV void finish(const Unit& u, int w, int lane, State& s) const { ssq_store_naive(ssq, u, w, lane, s); }
    DEV void epi_fast(const AccT& acc, const Unit& u, int wr, int wc, int fr, int fq, const LAS unsigned char*) const {
        asm volatile("" : "+v"(fr), "+v"(fq));
#pragma unroll
        for (int ai = 0; ai < 2; ++ai)
#pragma unroll
            for (int m = 0; m < 4; ++m) { const int rt = 128 * ai + 64 * wr + 16 * m + fr; const size_t o = (size_t)(u.orow + rt) * D + u.pn * 256 + 32 * wc + 8 * fq; float q = 0.f;
#pragma unroll
                for (int bj = 0; bj < 2; ++bj) { const f32x4 h0 = *(const f32x4*)(hin + o + 128 * bj), h1 = *(const f32x4*)(hin + o + 128 * bj + 4);
                    const f32x4 v0 = h0 + acc[ai][bj][m][0], v1 = h1 + acc[ai][bj][m][1];
                    *(f32x4*)(h + o + 128 * bj) = v0; *(f32x4*)(h + o + 128 * bj + 4) = v1; u32x4 w;
                    w.x = cvt_pk_bf16(v0[0], v0[1]); w.y = cvt_pk_bf16(v0[2], v0[3]); w.z = cvt_pk_bf16(v1[0], v1[1]); w.w = cvt_pk_bf16(v1[2], v1[3]);
                    *(u32x4*)(hb + o + 128 * bj) = w;
                    q += (v0[0] * v0[0] + v0[1] * v0[1]) + (v0[2] * v0[2] + v0[3] * v0[3]) + (v1[0] * v1[0] + v1[1] * v1[1]) + (v1[2] * v1[2] + v1[3] * v1[3]); }
                q += __shfl_xor(q, 16); q += __shfl_xor(q, 32);
                if (fq == 0) ssq[(size_t)(u.orow + rt) * 16 + u.pn * 4 + wc] = q; }
    }
};
template <> struct Prob<2> {
    static constexpr int NI = 4; static constexpr bool PAIR = true, HAS_TBL = true, DMA_TBL = true;
    const bf16_t* A; int lda; const bf16_t* Bt; int K; bf16_t* act; const int* list; const float* list_rs; MoeOrder S;
    typedef int State;
    DEV bool next(int i, Unit& u) const { return S.next(i, u); }
    DEV unsigned tbl_load(const Unit& u) const { const int t = threadIdx.x, idx = t & 255; return (t < 256) ? (unsigned)list[u.lbase + idx] : __float_as_uint(list_rs[u.lbase + idx]); }
    DEV void tbl_store(unsigned v, LAS unsigned char* slot) const { const int t = threadIdx.x; ((LAS unsigned*)slot)[t] = v; }
    DEV void tbl_dma(const Unit& u, LAS unsigned char* slot, int wid, int lane) const {
        const unsigned* src = (wid < 4) ? (const unsigned*)list + u.lbase + 64 * wid + lane : (const unsigned*)list_rs + u.lbase + 64 * (wid - 4) + lane;
        __builtin_amdgcn_global_load_lds(src, (LAS unsigned*)(slot + 256 * wid), 4, 0, 0); }
    DEV unsigned arow(const Unit& u, int r, const LAS unsigned char* slot) const { const unsigned e = ((const LAS unsigned*)slot)[r]; return (r < u.rows) ? (e >> 1) : 0u; }
    DEV const bf16_t* b_base(const Unit& u) const { return Bt + ((size_t)u.e * 1024 + u.pn * 256) * K; }
    DEV void st_init(State&) const {}
    DEV void epi(const Unit& u, int w, int ni, int lane, const f32x16& a0, const f32x16& a1, const LAS unsigned char* slot, State&) const {
        const LAS float* tf = (const LAS float*)(slot + 1024); const int r = lane & 31, hh = lane >> 5;
#pragma unroll
        for (int i = 0; i < 16; ++i) { const int row = 32 * w + crow(i, hh); if (row < u.rows) { const float rs = tf[row], g = a0[i] * rs, up = a1[i] * rs;
            act[(size_t)(u.orow + row) * FE + u.pn * 128 + 32 * ni + r] = (bf16_t)f2bf(g * sigmoidf_(g) * up); } }
    }
    DEV void finish(const Unit&, int, int, State&) const {}
    DEV void epi_fast(const AccT& acc, const Unit& u, int wr, int wc, int fr, int fq, const LAS unsigned char* slot) const {
        asm volatile("" : "+v"(fr), "+v"(fq));
        const LAS float* tf = (const LAS float*)(slot + 1024);
#pragma unroll
        for (int ai = 0; ai < 2; ++ai)
#pragma unroll
            for (int m = 0; m < 4; ++m) { const int rt = 128 * ai + 64 * wr + 16 * m + fr; const float rs = tf[rt];
                float o[8];
#pragma unroll
                for (int n = 0; n < 2; ++n)
#pragma unroll
                    for (int j = 0; j < 4; ++j) { const float g = acc[ai][0][m][n][j] * rs, up = acc[ai][1][m][n][j] * rs; o[4 * n + j] = g * sigmoidf_(g) * up; }
                u32x4 w; w.x = cvt_pk_bf16(o[0], o[1]); w.y = cvt_pk_bf16(o[2], o[3]); w.z = cvt_pk_bf16(o[4], o[5]); w.w = cvt_pk_bf16(o[6], o[7]);
                if (rt < u.rows) *(u32x4*)(act + (size_t)(u.orow + rt) * FE + u.pn * 128 + 32 * wc + 8 * fq) = w; }
    }
};
template <> struct Prob<3> {
    static constexpr int NI = 8; static constexpr bool PAIR = false, HAS_TBL = true, DMA_TBL = true;
    const bf16_t* A; int lda; const bf16_t* Bt; int K; bf16_t* y; const float* list_gate; MoeOrder S;
    typedef int State;
    DEV bool next(int i, Unit& u) const { return S.next(i, u); }
    DEV unsigned tbl_load(const Unit& u) const { const int t = threadIdx.x; return (t < 256) ? __float_as_uint(list_gate[u.lbase + t]) : 0u; }
    DEV void tbl_store(unsigned v, LAS unsigned char* slot) const { const int t = threadIdx.x; if (t < 256) ((LAS unsigned*)(slot + 1024))[t] = v; }
    DEV void tbl_dma(const Unit& u, LAS unsigned char* slot, int wid, int lane) const {
        if (wid < 4) __builtin_amdgcn_global_load_lds((const unsigned*)list_gate + u.lbase + 64 * wid + lane, (LAS unsigned*)(slot + 1024 + 256 * wid), 4, 0, 0); }
    DEV unsigned arow(const Unit& u, int r, const LAS unsigned char*) const { return (unsigned)(u.orow + r); }
    DEV const bf16_t* b_base(const Unit& u) const { return Bt + ((size_t)u.e * 1024 + u.pn * 256) * K; }
    DEV void st_init(State&) const {}
    DEV void epi(const Unit& u, int w, int ni, int lane, const f32x16& a0, const f32x16&, const LAS unsigned char* slot, State&) const {
        const LAS float* tf = (const LAS float*)(slot + 1024); const int r = lane & 31, hh = lane >> 5;
#pragma unroll
        for (int i = 0; i < 16; ++i) { const int row = 32 * w + crow(i, hh); if (row < u.rows) y[(size_t)(u.orow + row) * D + u.pn * 256 + 32 * ni + r] = (bf16_t)f2bf(a0[i] * tf[row]); }
    }
    DEV void finish(const Unit&, int, int, State&) const {}
    DEV void epi_fast(const AccT& acc, const Unit& u, int wr, int wc, int fr, int fq, const LAS unsigned char* slot) const {
        asm volatile("" : "+v"(fr), "+v"(fq));
        const LAS float* tf = (const LAS float*)(slot + 1024);
#pragma unroll
        for (int ai = 0; ai < 2; ++ai)
#pragma unroll
            for (int m = 0; m < 4; ++m) { const int rt = 128 * ai + 64 * wr + 16 * m + fr; const float gs = tf[rt];
                bf16_t* rowp = y + (size_t)(u.orow + rt) * D + u.pn * 256 + 32 * wc + 8 * fq;
#pragma unroll
                for (int bj = 0; bj < 2; ++bj) { const f32x4 v0 = acc[ai][bj][m][0] * gs, v1 = acc[ai][bj][m][1] * gs; u32x4 w;
                    w.x = cvt_pk_bf16(v0[0], v0[1]); w.y = cvt_pk_bf16(v0[2], v0[3]); w.z = cvt_pk_bf16(v1[0], v1[1]); w.w = cvt_pk_bf16(v1[2], v1[3]);
                    if (rt < u.rows) *(u32x4*)(rowp + 128 * bj) = w; } }
    }
};
template <> struct Prob<5> {
    static constexpr int NI = 8; static constexpr bool PAIR = false, HAS_TBL = true, DMA_TBL = false;
    const bf16_t* A; int lda; const bf16_t* Bt; int N, K; const bf16_t* proj;
    DEV void tbl_dma(const Unit&, LAS unsigned char*, int, int) const {} float* h; bf16_t* hb; const float* ssq_in; float* ssq_out; StaticOrder S;
    typedef HState State;
    DEV bool next(int i, Unit& u) const { return S.next(i, u); }
    DEV unsigned tbl_load(const Unit& u) const { const int t = threadIdx.x; return (t < 256) ? rs_from_ssq(ssq_in, u.orow + t) : 0u; }
    DEV void tbl_store(unsigned v, LAS unsigned char* slot) const { const int t = threadIdx.x; if (t < 256) ((LAS unsigned*)(slot + 1024))[t] = v; }
    DEV unsigned arow(const Unit& u, int r, const LAS unsigned char*) const { return (unsigned)(u.orow + r); }
    DEV const bf16_t* b_base(const Unit& u) const { return Bt + (size_t)u.pn * 256 * K; }
    DEV void st_init(State& s) const {
#pragma unroll
        for (int i = 0; i < 16; ++i) s.q[i] = 0.f; }
    DEV void epi(const Unit& u, int w, int ni, int lane, const f32x16& a0, const f32x16&, const LAS unsigned char* slot, State& s) const {
        const LAS float* tf = (const LAS float*)(slot + 1024); const int r = lane & 31, hh = lane >> 5;
#pragma unroll
        for (int i = 0; i < 16; ++i) { const int row = 32 * w + crow(i, hh); const size_t o = (size_t)(u.orow + row) * D + u.pn * 256 + 32 * ni + r;
            const float g = sigmoidf_(a0[i] * tf[row]); const float v = h[o] + bf2f(proj[o]) * g; h[o] = v; hb[o] = (bf16_t)f2bf(v); s.q[i] += v * v; }
    }
    DEV void finish(const Unit& u, int w, int lane, State& s) const { ssq_store_naive(ssq_out, u, w, lane, s); }
    DEV void epi_fast(const AccT& acc, const Unit& u, int wr, int wc, int fr, int fq, const LAS unsigned char* slot) const {
        asm volatile("" : "+v"(fr), "+v"(fq));
        const LAS float* tf = (const LAS float*)(slot + 1024);
#pragma unroll
        for (int ai = 0; ai < 2; ++ai)
#pragma unroll
            for (int m = 0; m < 4; ++m) { const int rt = 128 * ai + 64 * wr + 16 * m + fr; const float rs = tf[rt]; const size_t o = (size_t)(u.orow + rt) * D + u.pn * 256 + 32 * wc + 8 * fq; float q = 0.f;
#pragma unroll
                for (int bj = 0; bj < 2; ++bj) { const f32x4 h0 = *(const f32x4*)(h + o + 128 * bj), h1 = *(const f32x4*)(h + o + 128 * bj + 4); const u32x4 pj = *(const u32x4*)(proj + o + 128 * bj);
                    const f32x4 a0 = acc[ai][bj][m][0] * rs, a1 = acc[ai][bj][m][1] * rs; f32x4 v0, v1;
                    v0[0] = h0[0] + bf2f(pj.x & 0xffffu) * sigmoidf_(a0[0]); v0[1] = h0[1] + bf2f(pj.x >> 16) * sigmoidf_(a0[1]); v0[2] = h0[2] + bf2f(pj.y & 0xffffu) * sigmoidf_(a0[2]); v0[3] = h0[3] + bf2f(pj.y >> 16) * sigmoidf_(a0[3]);
                    v1[0] = h1[0] + bf2f(pj.z & 0xffffu) * sigmoidf_(a1[0]); v1[1] = h1[1] + bf2f(pj.z >> 16) * sigmoidf_(a1[1]); v1[2] = h1[2] + bf2f(pj.w & 0xffffu) * sigmoidf_(a1[2]); v1[3] = h1[3] + bf2f(pj.w >> 16) * sigmoidf_(a1[3]);
                    *(f32x4*)(h + o + 128 * bj) = v0; *(f32x4*)(h + o + 128 * bj + 4) = v1; u32x4 w;
                    w.x = cvt_pk_bf16(v0[0], v0[1]); w.y = cvt_pk_bf16(v0[2], v0[3]); w.z = cvt_pk_bf16(v1[0], v1[1]); w.w = cvt_pk_bf16(v1[2], v1[3]);
                    *(u32x4*)(hb + o + 128 * bj) = w;
                    q += (v0[0] * v0[0] + v0[1] * v0[1]) + (v0[2] * v0[2] + v0[3] * v0[3]) + (v1[0] * v1[0] + v1[1] * v1[1]) + (v1[2] * v1[2] + v1[3] * v1[3]); }
                q += __shfl_xor(q, 16); q += __shfl_xor(q, 32);
                if (fq == 0) ssq_out[(size_t)(u.orow + rt) * 16 + u.pn * 4 + wc] = q; }
    }
};

template <class P> DEV void gemm_phase_naive(const P& p, LAS unsigned char* lds) {
    const int tid = threadIdx.x, w = tid >> 6, lane = tid & 63, r = lane & 31, hh = lane >> 5;
    LAS unsigned char* slot = lds + TBL_OFF;
    Unit u;
    for (int i = 0; p.next(i, u); ++i) {
        __syncthreads();
        { const unsigned v = p.tbl_load(u); p.tbl_store(v, slot); }
        __syncthreads();
        const bf16_t* arow = p.A + (size_t)p.arow(u, 32 * w + r, slot) * (size_t)p.lda + 8 * hh;
        const bf16_t* bt = p.b_base(u) + 8 * hh;
        typename P::State st; p.st_init(st);
        for (int ni = 0; ni < P::NI; ++ni) {
            f32x16 a0, a1;
#pragma unroll
            for (int j = 0; j < 16; ++j) { a0[j] = 0.f; a1[j] = 0.f; }
            const bf16_t* b0 = bt + (size_t)(32 * ni + r) * p.K;
            const bf16_t* b1 = bt + (size_t)(32 * ni + 128 + r) * p.K;
            for (int k0 = 0; k0 < p.K; k0 += 16) {
                const bf16x8 a = *(const bf16x8*)(arow + k0);
                const bf16x8 b = *(const bf16x8*)(b0 + k0);
                a0 = __builtin_amdgcn_mfma_f32_32x32x16_bf16(a, b, a0, 0, 0, 0);
                if (P::PAIR) { const bf16x8 bb = *(const bf16x8*)(b1 + k0); a1 = __builtin_amdgcn_mfma_f32_32x32x16_bf16(a, bb, a1, 0, 0, 0); }
            }
            p.epi(u, w, ni, lane, a0, a1, slot, st);
        }
        p.finish(u, w, lane, st);
    }
    __syncthreads();
}

namespace fg {
constexpr int BK = 64, HALF = 128, HTB = HALF * BK * 2;
DEV int lds_byte(int r, int c) { const int st = (r >> 4) * 2 + (c >> 5), rr = r & 15, cc = c & 31, ob = rr * 64 + cc * 2; return st * 1024 + (ob ^ (((ob >> 9) & 1) << 5)); }
DEV void stage_rc(int b, int& R, int& C) { const int st = b / 1024, sb = b % 1024, swz = sb ^ (((sb >> 9) & 1) << 5); R = (st >> 1) * 16 + swz / 64; C = (st & 1) * 32 + (swz % 64) / 2; }
DEV int perm32(int rho) { const int n = rho >> 4, i = rho & 15; return 8 * (i >> 2) + 4 * n + (i & 3); }
}
template <class P> DEV void gemm_phase_fast(const P& p, LAS unsigned char* lds) {
    using namespace fg;
    const int tid = opaque_tid(), wid = __builtin_amdgcn_readfirstlane(tid >> 6), lane = tid & 63, wr = wid >> 2, wc = wid & 3, fr = lane & 15, fq = lane >> 4;
    const int K = p.K, nt = K / BK, lda = p.lda;
    unsigned voffB[2];
#pragma unroll
    for (int i = 0; i < 2; ++i) { int R, C; stage_rc(tid * 16 + i * 8192, R, C); const int Rb = (R & ~31) + perm32(R & 31); voffB[i] = (unsigned)(Rb * K + C) * 2u; }
    const size_t kstep = (size_t)(BK * 2);
    const size_t hstepB = (size_t)HALF * K * 2;
    const unsigned ldsw = (unsigned)wid * 1024u;
    const int aoffl = lds_byte(wr * 64 + fr, fq * 8), boffl = lds_byte(wc * 32 + fr, fq * 8);
#define PG8_SA(b, h) (((b) * 2 + (h)) * HTB)
#define PG8_SB(b, h) ((4 + (b) * 2 + (h)) * HTB)
#define PG8_STAGE(bufoff, gbase, voff) do { _Pragma("unroll") for (int _i = 0; _i < 2; ++_i) \
        __builtin_amdgcn_global_load_lds((const unsigned*)((const char*)(gbase) + (voff)[_i]), (LAS unsigned*)(lds + (bufoff) + ldsw + _i * 8192), 16, 0, 0); } while (0)
#define PG8_LDA(dst, b, h) do { _Pragma("unroll") for (int m = 0; m < 4; ++m) _Pragma("unroll") for (int k = 0; k < 2; ++k) dst[m][k] = *(const LAS bf16x8*)(lds + PG8_SA(b, h) + aoffl + m * 2048 + k * 1024); } while (0)
#define PG8_LDB(dst, b, h) do { _Pragma("unroll") for (int n = 0; n < 2; ++n) _Pragma("unroll") for (int k = 0; k < 2; ++k) dst[n][k] = *(const LAS bf16x8*)(lds + PG8_SB(b, h) + boffl + n * 2048 + k * 1024); } while (0)
#define PG8_MMA(ai, bj, At, Bt) do { __builtin_amdgcn_s_setprio(1); _Pragma("unroll") for (int m = 0; m < 4; ++m) _Pragma("unroll") for (int n = 0; n < 2; ++n) _Pragma("unroll") for (int k = 0; k < 2; ++k) \
        acc[ai][bj][m][n] = __builtin_amdgcn_mfma_f32_16x16x32_bf16(Bt[n][k], At[m][k], acc[ai][bj][m][n], 0, 0, 0); __builtin_amdgcn_s_setprio(0); } while (0)
#define PG8_WAIT_V(n) asm volatile("s_waitcnt vmcnt(" #n ")" ::: "memory")
#define PG8_WAIT_L(n) asm volatile("s_waitcnt lgkmcnt(" #n ")" ::: "memory")
#define PG8_BAR __builtin_amdgcn_s_barrier()
#define PG8_SCHED __builtin_amdgcn_sched_barrier(0)
#define PG8_AOFF(dst, un, slotp) do { _Pragma("unroll") for (int _i = 0; _i < 2; ++_i) { int _R, _C; stage_rc(tid * 16 + _i * 8192, _R, _C); _Pragma("unroll") for (int _h = 0; _h < 2; ++_h) \
        dst[_h][_i] = (p.arow(un, 128 * _h + _R, slotp) * (unsigned)lda + (unsigned)_C) * 2u; } } while (0)
    Unit cur, nxt; int ui = 0;
    if (!p.next(0, cur)) return;
    LAS unsigned char* const tbl = lds + TBL_OFF;
    if constexpr (P::DMA_TBL) { p.tbl_dma(cur, tbl, wid, lane); asm volatile("s_waitcnt vmcnt(0)" ::: "memory"); }
    else { const unsigned v = p.tbl_load(cur); p.tbl_store(v, tbl); }
    __syncthreads();
    AccT acc;
#pragma unroll
    for (int a = 0; a < 2; ++a)
#pragma unroll
        for (int b = 0; b < 2; ++b)
#pragma unroll
            for (int m = 0; m < 4; ++m)
#pragma unroll
                for (int n = 0; n < 2; ++n) acc[a][b][m][n] = (f32x4){0.f, 0.f, 0.f, 0.f};
    bf16x8 At[4][2], B0[2][2], B1[2][2];
    unsigned ao[2][2];
    PG8_AOFF(ao, cur, tbl);
    const char* const Ab = (const char*)p.A;
    const char* cB = (const char*)p.b_base(cur);
    PG8_STAGE(PG8_SB(0, 0), cB, voffB); PG8_STAGE(PG8_SB(0, 1), cB + hstepB, voffB); PG8_STAGE(PG8_SA(0, 0), Ab, ao[0]); PG8_STAGE(PG8_SA(0, 1), Ab, ao[1]);
    if (wr == 1) PG8_BAR;
    PG8_WAIT_V(2); PG8_BAR;
    PG8_STAGE(PG8_SB(1, 0), cB + kstep, voffB); PG8_STAGE(PG8_SA(1, 0), Ab + kstep, ao[0]); PG8_STAGE(PG8_SB(1, 1), cB + hstepB + kstep, voffB);
    PG8_WAIT_V(6); PG8_BAR;
    for (;;) {
        const bool has_next = p.next(ui + 1, nxt);
        const char* nB = has_next ? (const char*)p.b_base(nxt) : cB;
        LAS unsigned char* const nslot = tbl + ((ui + 1) & 1) * 2048;
        for (int t = 0; t < nt; t += 2) {
            const bool last = (t == nt - 2);
            unsigned tv = 0u; const bool do_tbl = P::HAS_TBL && (t == 2) && has_next && !last;
            if constexpr (P::DMA_TBL) { if (do_tbl) p.tbl_dma(nxt, nslot, wid, lane); } else { if (do_tbl) tv = p.tbl_load(nxt); }
            const char* a1 = Ab + (size_t)(t + 1) * kstep;
            const char* a2 = last ? Ab : Ab + (size_t)(t + 2) * kstep; const char* b2 = last ? nB : cB + (size_t)(t + 2) * kstep;
            const char* a3 = a2 + kstep; const char* b3 = b2 + kstep;
            PG8_LDB(B0, 0, 0); PG8_LDB(B1, 0, 1); PG8_SCHED; PG8_LDA(At, 0, 0); PG8_STAGE(PG8_SA(1, 1), a1, ao[1]);
            if (last && has_next) { PG8_AOFF(ao, nxt, nslot); }
            PG8_WAIT_V(8); PG8_WAIT_L(0); PG8_BAR; PG8_MMA(0, 0, At, B0); PG8_MMA(0, 1, At, B1); PG8_BAR; PG8_SCHED;
            PG8_LDA(At, 0, 1); PG8_STAGE(PG8_SB(0, 0), b2, voffB); PG8_STAGE(PG8_SB(0, 1), b2 + hstepB, voffB); PG8_STAGE(PG8_SA(0, 0), a2, ao[0]);
            PG8_WAIT_V(8); PG8_WAIT_L(0); PG8_BAR; PG8_MMA(1, 0, At, B0); PG8_MMA(1, 1, At, B1); PG8_BAR; PG8_SCHED;
            PG8_LDB(B0, 1, 0); PG8_LDB(B1, 1, 1); PG8_SCHED; PG8_LDA(At, 1, 0); PG8_STAGE(PG8_SA(0, 1), a2, ao[1]);
            PG8_WAIT_V(8); PG8_WAIT_L(0); PG8_BAR; PG8_MMA(0, 0, At, B0); PG8_MMA(0, 1, At, B1); PG8_BAR; PG8_SCHED;
            PG8_LDA(At, 1, 1); PG8_STAGE(PG8_SB(1, 0), b3, voffB); PG8_STAGE(PG8_SB(1, 1), b3 + hstepB, voffB); PG8_STAGE(PG8_SA(1, 0), a3, ao[0]);
            PG8_WAIT_V(8); PG8_WAIT_L(0); PG8_BAR; PG8_MMA(1, 0, At, B0); PG8_MMA(1, 1, At, B1); PG8_BAR; PG8_SCHED;
            if constexpr (!P::DMA_TBL) { if (do_tbl) p.tbl_store(tv, nslot); }
        }
        if (wr == 0) PG8_BAR;
        p.epi_fast(acc, cur, wr, wc, fr, fq, tbl + (ui & 1) * 2048);
        if (!has_next) break;
#pragma unroll
        for (int a = 0; a < 2; ++a)
#pragma unroll
            for (int b = 0; b < 2; ++b)
#pragma unroll
                for (int m = 0; m < 4; ++m)
#pragma unroll
                    for (int n = 0; n < 2; ++n) acc[a][b][m][n] = (f32x4){0.f, 0.f, 0.f, 0.f};
        cur = nxt; cB = nB; ++ui;
        if (wr == 1) PG8_BAR;
    }
    PG8_WAIT_V(0);
    PG8_BAR;
#undef PG8_SA
#undef PG8_SB
#undef PG8_STAGE
#undef PG8_LDA
#undef PG8_LDB
#undef PG8_MMA
#undef PG8_WAIT_V
#undef PG8_WAIT_L
#undef PG8_BAR
#undef PG8_SCHED
#undef PG8_AOFF
}
#ifndef FAST_ATT_A
#define FAST_ATT_A 1
#endif
#ifndef FAST_ATT_C
#define FAST_ATT_C 1
#endif
#ifndef FAST_ATT_B
#define FAST_ATT_B 1
#endif
#ifndef FAST_GEMM
#define FAST_GEMM 1
#endif
template <class P> DEV void gemm_phase(const P& p, LAS unsigned char* lds) {
#if FAST_GEMM
    gemm_phase_fast(p, lds);
#else
    gemm_phase(p, lds);
#endif
}

DEV void cvt_weight(const float* src, bf16_t* dst, int K, int N, int nbatch, int mode, const float* gbase, LAS unsigned char* lds, int G) {
    const int tid = opaque_tid(), half = tid >> 8, t = tid & 255;
    LAS float* tile = (LAS float*)lds + half * (64 * 65);
    const int tn = N / 64, tpm = (K / 64) * tn, total = tpm * nbatch;
    for (int base = blockIdx.x * 2; base < total; base += G * 2) {
        const int id = base + half; const bool ok = id < total;
        int b = 0, k0 = 0, n0 = 0;
        if (ok) { b = id / tpm; const int rem = id % tpm; k0 = (rem / tn) * 64; n0 = (rem % tn) * 64; }
        const float* g = nullptr;
        if (mode == 1) g = gbase + (size_t)(3 * b) * D; else if (mode == 2) g = gbase; else if (mode == 3) g = gbase + (size_t)(b / 64) * D; else if (mode == 4) g = gbase + (size_t)b * D;
        if (ok) {
            const int nn = t & 63; const int n = n0 + nn; float cs = 1.f;
            if (mode == 1) cs = ((n % 3072) < 1024) ? QSCALE : 1.f; else if (mode == 2) cs = (n < 1024) ? QSCALE : 1.f;
            const float* s = src + (size_t)b * K * N + (size_t)k0 * N + n;
#pragma unroll 4
            for (int i = 0; i < 16; ++i) { const int kk = i * 4 + (t >> 6); float v = s[(size_t)kk * N] * cs; if (g) v *= g[k0 + kk]; tile[kk * 65 + nn] = v; }
        }
        __syncthreads();
        if (ok) {
            const int nn = t >> 2, kq = t & 3; int n = n0 + nn;
            if (mode == 3) { if (n < 512) n = 256 * (n >> 7) + (n & 127); else { const int j = n - 512; n = 256 * (j >> 7) + 128 + (j & 127); } }
            unsigned w[8];
#pragma unroll
            for (int j = 0; j < 8; ++j) w[j] = pk2(tile[(kq * 16 + 2 * j) * 65 + nn], tile[(kq * 16 + 2 * j + 1) * 65 + nn]);
            uint4* d = (uint4*)(dst + (size_t)b * K * N + (size_t)n * K + k0 + kq * 16);
            d[0] = make_uint4(w[0], w[1], w[2], w[3]); d[1] = make_uint4(w[4], w[5], w[6], w[7]);
        }
        __syncthreads();
    }
}

DEV void phase_prologue(const Ctx& c, LAS unsigned char* lds) {
    unsigned char* ws = c.ws;
    cvt_weight(c.a_w_in, (bf16_t*)(ws + WS_WAIN), D, NA, 2, 1, c.norm_mix, lds, c.G);
    cvt_weight(c.b_w_in, (bf16_t*)(ws + WS_WBIN), D, NB, 1, 2, c.norm_mix + 1 * D, lds, c.G);
    cvt_weight(c.c_w_in, (bf16_t*)(ws + WS_WCIN), D, NB, 1, 2, c.norm_mix + 2 * D, lds, c.G);
    cvt_weight(c.a_w_out, (bf16_t*)(ws + WS_WAOUT), D, D, 2, 0, nullptr, lds, c.G);
    cvt_weight(c.b_w_out, (bf16_t*)(ws + WS_WBOUT), D, D, 1, 0, nullptr, lds, c.G);
    cvt_weight(c.c_w_out, (bf16_t*)(ws + WS_WCOUT), D, D, 1, 0, nullptr, lds, c.G);
    cvt_weight(c.w_gu, (bf16_t*)(ws + WS_WGU), D, 1024, DEPTH * NE, 3, c.norm_ffn, lds, c.G);
    cvt_weight(c.w_dn, (bf16_t*)(ws + WS_WDN), FE, D, DEPTH * NE, 0, nullptr, lds, c.G);
    cvt_weight(c.w_pg, (bf16_t*)(ws + WS_WPG), D, D, DEPTH, 4, c.norm_ple, lds, c.G);
    cvt_weight(c.w_pp, (bf16_t*)(ws + WS_WPP), PLE, D, DEPTH, 0, nullptr, lds, c.G);
    { const size_t n4 = (size_t)DEPTH * T * PLE / 4; const f32x4* s = (const f32x4*)c.p; uint2* d = (uint2*)(ws + WS_PB);
      for (size_t i = (size_t)blockIdx.x * NTHR + threadIdx.x; i < n4; i += (size_t)c.G * NTHR) { const f32x4 v = s[i]; d[i] = make_uint2(pk2(v.x, v.y), pk2(v.z, v.w)); } }
    { const int tid_ = opaque_tid(); const int w = tid_ >> 6, lane = tid_ & 63; bf16_t* hb = (bf16_t*)(ws + WS_HB); float* ssq = (float*)(ws + WS_SSQ);
      for (int tok = blockIdx.x * NWAVES + w; tok < T; tok += c.G * NWAVES) {
          const f32x4* xr = (const f32x4*)(c.x + (size_t)tok * D) + lane; uint2* o = (uint2*)(hb + (size_t)tok * D) + lane; float s = 0.f;
#pragma unroll
          for (int j = 0; j < 4; ++j) { const f32x4 v = xr[64 * j]; s += (v.x * v.x + v.y * v.y) + (v.z * v.z + v.w * v.w); o[64 * j] = make_uint2(pk2(v.x, v.y), pk2(v.z, v.w)); }
          s = wave_sum(s); if (lane < 16) ssq[(size_t)tok * 16 + lane] = (lane == 0) ? s : 0.f; } }
}

DEV float dot64(const LAS float* q, const bf16_t* k) {
    const uint4* kp = (const uint4*)k; float s = 0.f;
#pragma unroll
    for (int j = 0; j < 8; ++j) { const uint4 v = kp[j]; const LAS float* qq = q + 8 * j;
        s += qq[0] * __uint_as_float(v.x << 16) + qq[1] * __uint_as_float(v.x & 0xffff0000u) + qq[2] * __uint_as_float(v.y << 16) + qq[3] * __uint_as_float(v.y & 0xffff0000u)
           + qq[4] * __uint_as_float(v.z << 16) + qq[5] * __uint_as_float(v.z & 0xffff0000u) + qq[6] * __uint_as_float(v.w << 16) + qq[7] * __uint_as_float(v.w & 0xffff0000u); }
    return s;
}

DEV void attA_naive(const Ctx& c, LAS unsigned char* lds) {
    const int tid_ = opaque_tid(); const int w = tid_ >> 6, lane = tid_ & 63;
    LAS float* qs = (LAS float*)lds + w * 1024; LAS float* ps = qs + 192;
    const bf16_t* qkv = (const bf16_t*)(c.ws + WS_QKV); bf16_t* o = (bf16_t*)(c.ws + WS_O);
    for (int item = blockIdx.x * NWAVES + w; item < T * 16; item += c.G * NWAVES) {
        const int ta = item >> 4, hd = item & 15, t = ta & (SEQ - 1);
        const float slope = exp2f(-0.5f * (float)(hd + 1)) * LOG2E;
        const bf16_t* row = qkv + (size_t)ta * NA + hd * 64;
#pragma unroll
        for (int g = 0; g < 3; ++g) qs[g * 64 + lane] = bf2f(row[g * 3072 + lane]);
        wave_lds_fence();
        float sc[3][3]; float m = -INFINITY;
#pragma unroll
        for (int g = 0; g < 3; ++g) { const int r = (g == 0) ? 1 : (g == 1 ? 4 : 16); const int i = t / r;
#pragma unroll
            for (int rd = 0; rd < 3; ++rd) { const int delta = lane + 64 * rd; float s = -INFINITY;
                if (delta <= 128 && delta <= i) { const bf16_t* kr = qkv + (size_t)(ta - delta * r) * NA + g * 3072 + 1024 + hd * 64; s = dot64(qs + g * 64, kr) - slope * (float)(delta * r); }
                sc[g][rd] = s; m = fmaxf(m, s); } }
        m = wave_max(m); float sum = 0.f;
#pragma unroll
        for (int g = 0; g < 3; ++g)
#pragma unroll
            for (int rd = 0; rd < 3; ++rd) { const float pv = (sc[g][rd] == -INFINITY) ? 0.f : exp2f(sc[g][rd] - m); sum += pv; ps[g * 192 + lane + 64 * rd] = pv; }
        sum = wave_sum(sum);
        wave_lds_fence();
        float acc = 0.f;
#pragma unroll
        for (int g = 0; g < 3; ++g) { const int r = (g == 0) ? 1 : (g == 1 ? 4 : 16); const int i = t / r; const int nd = i < 128 ? i : 128;
            const bf16_t* vb = qkv + (size_t)ta * NA + g * 3072 + 2048 + hd * 64 + lane;
            for (int delta = 0; delta <= nd; ++delta) acc += ps[g * 192 + delta] * bf2f(vb[-(ptrdiff_t)delta * r * NA]); }
        o[(size_t)ta * D + hd * 64 + lane] = (bf16_t)f2bf(acc / sum);
        wave_lds_fence();
    }
}

DEV void attB_naive(const Ctx& c, float lam, float lambda_init, const float* subln, LAS unsigned char* lds) {
    const int tid_ = opaque_tid(); const int w = tid_ >> 6, lane = tid_ & 63;
    LAS float* qs = (LAS float*)lds + w * 256; LAS float* wl = qs + 128;
    const bf16_t* qkv = (const bf16_t*)(c.ws + WS_QKV); bf16_t* o = (bf16_t*)(c.ws + WS_O);
    for (int item = blockIdx.x * NWAVES + w; item < T * 8; item += c.G * NWAVES) {
        const int ta = item >> 3, hd = item & 7, t = ta & (SEQ - 1), b0 = ta - t;
        const float slope = exp2f(-(float)(hd + 1)) * LOG2E;
        const bf16_t* qrow = qkv + (size_t)ta * NB + hd * 128;
        qs[lane] = bf2f(qrow[lane]); qs[64 + lane] = bf2f(qrow[64 + lane]);
        wave_lds_fence();
        const bf16_t* kb = qkv + (size_t)b0 * NB + 1024 + hd * 128;
        float m1 = -INFINITY, m2 = -INFINITY;
        for (int s0 = 0; s0 <= t; s0 += 64) { const int s = s0 + lane; if (s <= t) { const bf16_t* kr = kb + (size_t)s * NB; const float bias = slope * (float)(t - s);
            m1 = fmaxf(m1, dot64(qs, kr) - bias); m2 = fmaxf(m2, dot64(qs + 64, kr + 64) - bias); } }
        m1 = wave_max(m1); m2 = wave_max(m2);
        float l1 = 0.f, l2 = 0.f;
        for (int s0 = 0; s0 <= t; s0 += 64) { const int s = s0 + lane; if (s <= t) { const bf16_t* kr = kb + (size_t)s * NB; const float bias = slope * (float)(t - s);
            l1 += exp2f(dot64(qs, kr) - bias - m1); l2 += exp2f(dot64(qs + 64, kr + 64) - bias - m2); } }
        l1 = wave_sum(l1); l2 = wave_sum(l2);
        const float i1 = 1.f / l1, i2 = lam / l2;
        float o0 = 0.f, o1 = 0.f;
        const bf16_t* vb = qkv + (size_t)b0 * NB + 2048 + hd * 128 + lane;
        for (int s0 = 0; s0 <= t; s0 += 64) { const int s = s0 + lane; float wv = 0.f;
            if (s <= t) { const bf16_t* kr = kb + (size_t)s * NB; const float bias = slope * (float)(t - s);
                wv = exp2f(dot64(qs, kr) - bias - m1) * i1 - exp2f(dot64(qs + 64, kr + 64) - bias - m2) * i2; }
            wl[lane] = wv; wave_lds_fence();
            const int nj = (t - s0) < 63 ? (t - s0) : 63;
            for (int j = 0; j <= nj; ++j) { const bf16_t* vr = vb + (size_t)(s0 + j) * NB; const float ww = wl[j]; o0 += ww * bf2f(vr[0]); o1 += ww * bf2f(vr[64]); }
            wave_lds_fence(); }
        const float ss = wave_sum(o0 * o0 + o1 * o1) * (1.f / 128.f); const float rs = rsqrtf(ss + EPS) * (1.f - lambda_init);
        o[(size_t)ta * D + hd * 128 + lane] = (bf16_t)f2bf(o0 * rs * subln[lane]);
        o[(size_t)ta * D + hd * 128 + 64 + lane] = (bf16_t)f2bf(o1 * rs * subln[64 + lane]);
    }
}

DEV void attC_naive(const Ctx& c, LAS unsigned char* lds) {
    const int tid_ = opaque_tid(); const int w = tid_ >> 6, lane = tid_ & 63;
    LAS float* qs = (LAS float*)lds + w * 128; LAS float* wl = qs + 64;
    const bf16_t* qkv = (const bf16_t*)(c.ws + WS_QKV); bf16_t* o = (bf16_t*)(c.ws + WS_O);
    for (int item = blockIdx.x * NWAVES + w; item < T * 16; item += c.G * NWAVES) {
        const int ta = item >> 4, hd = item & 15, t = ta & (SEQ - 1), b0 = ta - t;
        qs[lane] = bf2f(qkv[(size_t)ta * NB + hd * 64 + lane]);
        wave_lds_fence();
        const bf16_t* kb = qkv + (size_t)b0 * NB + 1024 + hd * 64; const bf16_t* vb = qkv + (size_t)b0 * NB + 2048 + hd * 64 + lane;
        float R = 0.f, acc = 0.f;
        for (int sh = t - 1; sh >= 0 && R > -120.f; sh -= 64) {
            const int s = sh - lane; const bool valid = s >= 0; float z = 0.f;
            if (valid) z = dot64(qs, kb + (size_t)s * NB) * LN2;
            const float ls = fminf(z, 0.f) - log1pf(__expf(-fabsf(z)));
            const float lr = valid ? (ls - z) : 0.f;
            float inc = lr;
#pragma unroll
            for (int d = 1; d < 64; d <<= 1) { const float v = __shfl_up(inc, d); if (lane >= d) inc += v; }
            const float tail = R + inc - lr;
            wl[lane] = valid ? __expf(ls + tail) : 0.f;
            R += __shfl(inc, 63);
            wave_lds_fence();
            const int nj = sh < 63 ? sh : 63;
            for (int j = 0; j <= nj; ++j) acc += wl[j] * bf2f(vb[(size_t)(sh - j) * NB]);
            wave_lds_fence();
        }
        o[(size_t)ta * D + hd * 64 + lane] = (bf16_t)f2bf(acc);
    }
}

typedef short s16x4 __attribute__((ext_vector_type(4)));
typedef short v4i16_t __attribute__((ext_vector_type(4)));
DEV s16x4 vtr(const LAS unsigned char* p) { return __builtin_bit_cast(s16x4, __builtin_amdgcn_ds_read_tr16_b64_v4i16((LAS v4i16_t*)p)); }
DEV void glds16(const void* g, LAS unsigned char* l) { __builtin_amdgcn_global_load_lds((const unsigned*)g, (LAS unsigned*)l, 16, 0, 0); }
DEV float xhalf_max(float v) { auto rr = __builtin_amdgcn_permlane32_swap(__float_as_uint(v), __float_as_uint(v), false, false); return fmaxf(__uint_as_float(rr[0]), __uint_as_float(rr[1])); }
DEV float xhalf_sum(float v) { auto rr = __builtin_amdgcn_permlane32_swap(__float_as_uint(v), __float_as_uint(v), false, false); return __uint_as_float(rr[0]) + __uint_as_float(rr[1]); }
DEV bf16x8 pack8(const f32x16& p, int s8) {
    u32x4 w; w.x = cvt_pk_bf16(p[s8], p[s8 + 1]); w.y = cvt_pk_bf16(p[s8 + 2], p[s8 + 3]); w.z = cvt_pk_bf16(p[s8 + 4], p[s8 + 5]); w.w = cvt_pk_bf16(p[s8 + 6], p[s8 + 7]);
    return __builtin_bit_cast(bf16x8, w);
}
#define ATT_WAITV(n) asm volatile("s_waitcnt vmcnt(" #n ")" ::: "memory")
#define ATT_BAR() asm volatile("s_waitcnt lgkmcnt(0)\n\ts_barrier" ::: "memory")
#define MFMA32(a, b, c) __builtin_amdgcn_mfma_f32_32x32x16_bf16((a), (b), (c), 0, 0, 0)

DEV void attB_stage(const bf16_t* kvb, int t, LAS unsigned char* buf, int wid, int lane) {
    if (wid < 4) { const int cc = wid >> 1;
#pragma unroll
        for (int j = 0; j < 4; ++j) { const int kk = (wid & 1) * 4 + j, row = 8 * kk + (lane >> 3), ch = (lane & 7) ^ ((row >> 1) & 7);
            glds16(kvb + (size_t)(64 * t + row) * NB + 1024 + cc * 64 + ch * 8, buf + cc * 8192 + kk * 1024); }
    } else {
#pragma unroll
        for (int j = 0; j < 4; ++j) { const int kk = (wid - 4) * 4 + j, row = 4 * kk + (lane >> 4), ch = (lane & 15) ^ ((row & 3) << 2);
            glds16(kvb + (size_t)(64 * t + row) * NB + 2048 + ch * 8, buf + 16384 + kk * 1024); }
    }
}
DEV void attB_fast(const Ctx& c, float lam, float lambda_init, const float* subln, LAS unsigned char* lds) {
    const int tid = opaque_tid(), wid = __builtin_amdgcn_readfirstlane(tid >> 6), lane = tid & 63, r = lane & 31, hh = lane >> 5;
    const int qt = wid & 3, cc = wid >> 2;
    const bf16_t* qkv = (const bf16_t*)(c.ws + WS_QKV); bf16_t* o = (bf16_t*)(c.ws + WS_O);
    const int vcu = (c.G % 8 == 0) ? ((int)blockIdx.x % 8) * (c.G / 8) + (int)blockIdx.x / 8 : (int)blockIdx.x;
    int koff[4], voff[4];
#pragma unroll
    for (int ds = 0; ds < 4; ++ds) koff[ds] = r * 128 + (((2 * ds + hh) ^ ((r >> 1) & 7)) << 4);
    { const int i16 = lane & 15, qp = i16 >> 2, pp = i16 & 3, blk = (lane >> 4) & 1;
#pragma unroll
      for (int db = 0; db < 4; ++db) voff[db] = (4 * hh + qp) * 256 + 8 * (pp & 1) + ((((db ^ qp) << 2) + 2 * blk + (pp >> 1)) << 4); }
    for (int pu = vcu; pu < 1024; pu += c.G) {
        const int bh = pu >> 4, s = pu & 15, b = bh >> 3, h = bh & 7;
        const float slope2 = exp2f(-(float)(h + 1)) * LOG2E;
        f32x16 Bt;
#pragma unroll
        for (int i = 0; i < 16; ++i) Bt[i] = slope2 * (float)(crow(i, hh) - r);
        const bf16_t* kvb = qkv + (size_t)b * SEQ * NB + h * 128;
        for (int half = 0; half < 2; ++half) {
            const int qb = half ? 31 - s : s, Q0 = qb * 128, Tn = 2 * qb + 2, qrow0 = Q0 + 32 * qt;
            attB_stage(kvb, Tn - 1, lds, wid, lane);
            bf16x8 qf[4];
            { const bf16_t* qp_ = kvb + (size_t)(qrow0 + r) * NB + cc * 64 + 8 * hh;
#pragma unroll
              for (int ds = 0; ds < 4; ++ds) qf[ds] = *(const bf16x8*)(qp_ + 16 * ds); }
            attB_stage(kvb, Tn - 2, lds + 32768, wid, lane);
            f32x16 O[4];
#pragma unroll
            for (int db = 0; db < 4; ++db)
#pragma unroll
                for (int i = 0; i < 16; ++i) O[db][i] = 0.f;
            float m = -1e30f, l = 0.f; int bi = 0;
            for (int t = Tn - 1; t >= 0; --t) {
                ATT_WAITV(0);
                ATT_BAR();
                if (t >= 2) attB_stage(kvb, t - 2, lds + ((bi + 2) % 3) * 32768, wid, lane);
                if (64 * t <= qrow0) {
                    const LAS unsigned char* Kb = lds + bi * 32768 + cc * 8192; const LAS unsigned char* Vb = lds + bi * 32768 + 16384;
                    f32x16 p0 = Bt, p1 = Bt;
#pragma unroll
                    for (int ds = 0; ds < 4; ++ds) { const bf16x8 k0 = *(const LAS bf16x8*)(Kb + koff[ds]), k1 = *(const LAS bf16x8*)(Kb + 4096 + koff[ds]); p0 = MFMA32(k0, qf[ds], p0); p1 = MFMA32(k1, qf[ds], p1); }
                    const float off0 = slope2 * (float)(64 * t - qrow0), off1 = off0 + 32.f * slope2;
                    if (64 * t + 63 > qrow0) {
#pragma unroll
                        for (int i = 0; i < 16; ++i) { const int key = 64 * t + crow(i, hh); if (key > qrow0 + r) p0[i] = -INFINITY; if (key + 32 > qrow0 + r) p1[i] = -INFINITY; } }
                    float mx0 = p0[0], mx1 = p1[0];
#pragma unroll
                    for (int i = 1; i < 16; ++i) { mx0 = fmaxf(mx0, p0[i]); mx1 = fmaxf(mx1, p1[i]); }
                    const float mx = xhalf_max(fmaxf(mx0 + off0, mx1 + off1));
                    if (__any(mx > m + 8.f)) { const float mn = fmaxf(m, mx), f = __builtin_amdgcn_exp2f(m - mn); l *= f; m = mn;
#pragma unroll
                        for (int db = 0; db < 4; ++db)
#pragma unroll
                            for (int i = 0; i < 16; ++i) O[db][i] *= f; }
                    const float e0 = off0 - m, e1 = off1 - m; float ls = 0.f;
#pragma unroll
                    for (int i = 0; i < 16; ++i) { p0[i] = __builtin_amdgcn_exp2f(p0[i] + e0); p1[i] = __builtin_amdgcn_exp2f(p1[i] + e1); ls += p0[i] + p1[i]; }
                    l += ls;
                    bf16x8 pa[4]; pa[0] = pack8(p0, 0); pa[1] = pack8(p0, 8); pa[2] = pack8(p1, 0); pa[3] = pack8(p1, 8);
#pragma unroll
                    for (int db = 0; db < 4; ++db) { const unsigned va = (unsigned)(uintptr_t)(Vb + voff[db]); s16x4 lo[4], hi[4];
#pragma unroll
                        for (int ks = 0; ks < 4; ++ks) { asm volatile("ds_read_b64_tr_b16 %0, %1 offset:%c2" : "=&v"(lo[ks]) : "v"(va), "i"(ks * 4096) : "memory");
                                                         asm volatile("ds_read_b64_tr_b16 %0, %1 offset:%c2" : "=&v"(hi[ks]) : "v"(va), "i"(ks * 4096 + 2048) : "memory"); }
                        asm volatile("s_waitcnt lgkmcnt(0)" ::: "memory"); __builtin_amdgcn_sched_barrier(0);
#pragma unroll
                        for (int ks = 0; ks < 4; ++ks) { const bf16x8 vf = (bf16x8){lo[ks][0], lo[ks][1], lo[ks][2], lo[ks][3], hi[ks][0], hi[ks][1], hi[ks][2], hi[ks][3]}; O[db] = MFMA32(vf, pa[ks], O[db]); } }
                }
                bi = (bi + 1) % 3;
            }
            l = xhalf_sum(l);
            ATT_BAR();
            LAS float* X = (LAS float*)(lds + 65536) + qt * 4096;
            if (cc == 1) { const float sc = lam / l;
#pragma unroll
                for (int db = 0; db < 4; ++db)
#pragma unroll
                    for (int i = 0; i < 16; ++i) X[(db * 16 + i) * 64 + lane] = O[db][i] * sc; }
            ATT_BAR();
            if (cc == 0) { const float inv = 1.f / l; float ss = 0.f;
#pragma unroll
                for (int db = 0; db < 4; ++db)
#pragma unroll
                    for (int i = 0; i < 16; ++i) { const float v = O[db][i] * inv - X[(db * 16 + i) * 64 + lane]; O[db][i] = v; ss += v * v; }
                ss = xhalf_sum(ss); const float rs = rsqrtf(ss * (1.f / 128.f) + EPS) * (1.f - lambda_init);
                bf16_t* op = o + (size_t)(b * SEQ + qrow0 + r) * D + h * 128 + 4 * hh;
#pragma unroll
                for (int db = 0; db < 4; ++db)
#pragma unroll
                    for (int g = 0; g < 4; ++g) { const int d = 32 * db + 8 * g; const f32x4 sl = *(const f32x4*)(subln + d + 4 * hh);
                        u32x2 w; w.x = cvt_pk_bf16(O[db][4 * g] * rs * sl[0], O[db][4 * g + 1] * rs * sl[1]); w.y = cvt_pk_bf16(O[db][4 * g + 2] * rs * sl[2], O[db][4 * g + 3] * rs * sl[3]);
                        *(u32x2*)(op + d) = w; } }
        }
    }
    ATT_BAR();
}

DEV void attC_stage(const bf16_t* kvb, int t, LAS unsigned char* buf, int wid, int lane) {
    const int row = 8 * wid + (lane >> 3);
    glds16(kvb + (size_t)(64 * t + row) * NB + 1024 + (((lane & 7) ^ ((row >> 1) & 7)) << 3), buf + wid * 1024);
    glds16(kvb + (size_t)(64 * t + row) * NB + 2048 + (((lane & 7) ^ (((row >> 1) & 1) << 2)) << 3), buf + 8192 + wid * 1024);
}
DEV float sb_scan(const f32x16& w, f32x16& a, float Rin, int hh) {
    float ex[16], gp[4], gq[4];
#pragma unroll
    for (int g = 0; g < 4; ++g) { const float t23 = w[4 * g + 2] * w[4 * g + 3], s0 = w[4 * g + 1] * t23; gp[g] = w[4 * g] * s0; ex[4 * g] = s0; ex[4 * g + 1] = t23; ex[4 * g + 2] = w[4 * g + 3]; ex[4 * g + 3] = 1.f; }
    float pp[4];
#pragma unroll
    for (int g = 0; g < 4; ++g) { auto rr = __builtin_amdgcn_permlane32_swap(__float_as_uint(gp[g]), __float_as_uint(gp[g]), false, false);
        const float lo = __uint_as_float(rr[0]), hi = __uint_as_float(rr[1]); pp[g] = lo * hi; gq[g] = hh ? 1.f : hi; }
    float Q[4]; Q[3] = 1.f; Q[2] = pp[3]; Q[1] = pp[2] * Q[2]; Q[0] = pp[1] * Q[1];
    const float tot = pp[0] * Q[0];
#pragma unroll
    for (int g = 0; g < 4; ++g) { const float base = Rin * Q[g] * gq[g];
#pragma unroll
        for (int j = 0; j < 4; ++j) a[4 * g + j] = a[4 * g + j] * (base * ex[4 * g + j]); }
    return tot;
}
DEV void attC_fast(const Ctx& c, LAS unsigned char* lds) {
    const int tid = opaque_tid(), wid = __builtin_amdgcn_readfirstlane(tid >> 6), lane = tid & 63, r = lane & 31, hh = lane >> 5;
    const bf16_t* qkv = (const bf16_t*)(c.ws + WS_QKV); bf16_t* o = (bf16_t*)(c.ws + WS_O);
    const int vcu = (c.G % 8 == 0) ? ((int)blockIdx.x % 8) * (c.G / 8) + (int)blockIdx.x / 8 : (int)blockIdx.x;
    LAS unsigned* flags = (LAS unsigned*)(lds + 49152);
    int koff[4], voff[2];
#pragma unroll
    for (int ds = 0; ds < 4; ++ds) koff[ds] = r * 128 + (((2 * ds + hh) ^ ((r >> 1) & 7)) << 4);
    { const int i16 = lane & 15, qp = i16 >> 2, pp = i16 & 3, blk = (lane >> 4) & 1;
#pragma unroll
      for (int db = 0; db < 2; ++db) voff[db] = (4 * hh + qp) * 128 + 8 * (pp & 1) + (((4 * (db ^ (qp >> 1))) + 2 * blk + (pp >> 1)) << 4); }
    for (int un = vcu; un < 2048; un += c.G) {
        const int bh = un >> 4, qb = un & 15, b = bh >> 4, h = bh & 15;
        const bf16_t* kvb = qkv + (size_t)b * SEQ * NB + h * 64;
        const int Q0 = qb * 256, qrow0 = Q0 + 32 * wid, T1 = Q0 / 64 + 3;
        attC_stage(kvb, T1, lds, wid, lane);
        bf16x8 qf[4];
        { const bf16_t* qp_ = kvb + (size_t)(qrow0 + r) * NB + 8 * hh;
#pragma unroll
          for (int ds = 0; ds < 4; ++ds) qf[ds] = *(const bf16x8*)(qp_ + 16 * ds); }
        attC_stage(kvb, T1 - 1, lds + 16384, wid, lane);
        f32x16 O[2];
#pragma unroll
        for (int db = 0; db < 2; ++db)
#pragma unroll
            for (int i = 0; i < 16; ++i) O[db][i] = 0.f;
        float R = 1.f; int bi = 0, par = 0;
        if (lane == 0) { flags[wid] = 1u; flags[8 + wid] = 1u; }
        for (int t = T1; t >= 0; --t) {
            ATT_WAITV(0);
            ATT_BAR();
            { unsigned al = 0u;
#pragma unroll
              for (int k = 0; k < 8; ++k) al |= flags[par * 8 + k];
              if (__builtin_amdgcn_readfirstlane(al) == 0u) break; }
            if (t >= 2) attC_stage(kvb, t - 2, lds + ((bi + 2) % 3) * 16384, wid, lane);
            if (64 * t < qrow0 + 31) {
                const LAS unsigned char* Kb = lds + bi * 16384; const LAS unsigned char* Vb = Kb + 8192;
                f32x16 p0, p1;
#pragma unroll
                for (int i = 0; i < 16; ++i) { p0[i] = 0.f; p1[i] = 0.f; }
#pragma unroll
                for (int ds = 0; ds < 4; ++ds) { const bf16x8 k0 = *(const LAS bf16x8*)(Kb + koff[ds]), k1 = *(const LAS bf16x8*)(Kb + 4096 + koff[ds]); p0 = MFMA32(k0, qf[ds], p0); p1 = MFMA32(k1, qf[ds], p1); }
                const bool diag = 64 * t + 63 >= qrow0;
                f32x16 w0, w1;
#pragma unroll
                for (int i = 0; i < 16; ++i) {
                    const float E0 = __builtin_amdgcn_exp2f(fminf(p0[i], 60.f)), E1 = __builtin_amdgcn_exp2f(fminf(p1[i], 60.f));
                    float v0 = __builtin_amdgcn_rcpf(1.f + E0), v1 = __builtin_amdgcn_rcpf(1.f + E1); float b0 = E0 * v0, b1 = E1 * v1;
                    if (diag) { const int key = 64 * t + crow(i, hh); if (key >= qrow0 + r) { v0 = 1.f; b0 = 0.f; } if (key + 32 >= qrow0 + r) { v1 = 1.f; b1 = 0.f; } }
                    w0[i] = v0; w1[i] = v1; p0[i] = b0; p1[i] = b1; }
                const float tot1 = sb_scan(w1, p1, R, hh);
                const float R1 = R * tot1;
                const float tot0 = sb_scan(w0, p0, R1, hh);
                R = R1 * tot0;
                bf16x8 pa[4]; pa[0] = pack8(p0, 0); pa[1] = pack8(p0, 8); pa[2] = pack8(p1, 0); pa[3] = pack8(p1, 8);
#pragma unroll
                for (int db = 0; db < 2; ++db) { const unsigned va = (unsigned)(uintptr_t)(Vb + voff[db]); s16x4 lo[4], hi[4];
#pragma unroll
                    for (int ks = 0; ks < 4; ++ks) { asm volatile("ds_read_b64_tr_b16 %0, %1 offset:%c2" : "=&v"(lo[ks]) : "v"(va), "i"(ks * 2048) : "memory");
                                                     asm volatile("ds_read_b64_tr_b16 %0, %1 offset:%c2" : "=&v"(hi[ks]) : "v"(va), "i"(ks * 2048 + 1024) : "memory"); }
                    asm volatile("s_waitcnt lgkmcnt(0)" ::: "memory"); __builtin_amdgcn_sched_barrier(0);
#pragma unroll
                    for (int ks = 0; ks < 4; ++ks) { const bf16x8 vf = (bf16x8){lo[ks][0], lo[ks][1], lo[ks][2], lo[ks][3], hi[ks][0], hi[ks][1], hi[ks][2], hi[ks][3]}; O[db] = MFMA32(vf, pa[ks], O[db]); } }
            }
            par ^= 1;
            { const bool alive = __any(R > 8.6736174e-19f); if (lane == 0) flags[par * 8 + wid] = alive ? 1u : 0u; }
            bi = (bi + 1) % 3;
        }
        ATT_WAITV(0);
        bf16_t* op = o + (size_t)(b * SEQ + qrow0 + r) * D + h * 64 + 4 * hh;
#pragma unroll
        for (int db = 0; db < 2; ++db)
#pragma unroll
            for (int g = 0; g < 4; ++g) { u32x2 wv; wv.x = cvt_pk_bf16(O[db][4 * g], O[db][4 * g + 1]); wv.y = cvt_pk_bf16(O[db][4 * g + 2], O[db][4 * g + 3]); *(u32x2*)(op + 32 * db + 8 * g) = wv; }
        ATT_BAR();
    }
}

DEV void attA_fast(const Ctx& c, LAS unsigned char* lds) {
    const int tid = opaque_tid(), wid = __builtin_amdgcn_readfirstlane(tid >> 6), lane = tid & 63, r = lane & 31, hh = lane >> 5;
    const bf16_t* qkv = (const bf16_t*)(c.ws + WS_QKV); bf16_t* og = (bf16_t*)(c.ws + WS_OG); float* lse = (float*)(c.ws + WS_LSE);
    const int vcu = (c.G % 8 == 0) ? ((int)blockIdx.x % 8) * (c.G / 8) + (int)blockIdx.x / 8 : (int)blockIdx.x;
    int koff[4], voff[2];
#pragma unroll
    for (int ds = 0; ds < 4; ++ds) koff[ds] = r * 128 + (((2 * ds + hh) ^ ((r >> 1) & 7)) << 4);
    { const int i16 = lane & 15, qp = i16 >> 2, pp = i16 & 3, blk = (lane >> 4) & 1;
#pragma unroll
      for (int db = 0; db < 2; ++db) voff[db] = (4 * hh + qp) * 128 + 8 * (pp & 1) + (((4 * (db ^ (qp >> 1))) + 2 * blk + (pp >> 1)) << 4); }
    LAS unsigned char* const Kb = lds; LAS unsigned char* const Vb = lds + 49152;
    for (int un = vcu; un < 6144; un += c.G) {
        const int bh = un / 48, j = un % 48, b = bh >> 4, h = bh & 15;
        int g, cres, m;
        if (j < 16) { g = 0; cres = 0; m = j; } else if (j < 32) { g = 1; cres = (j - 16) >> 2; m = (j - 16) & 3; } else { g = 2; cres = j - 32; m = 0; }
        const int rr = (g == 0) ? 1 : (g == 1 ? 4 : 16), i0 = m * 256;
        const bf16_t* base = qkv + (size_t)b * SEQ * NA + g * 3072 + h * 64;
#pragma unroll
        for (int k = 0; k < 6; ++k) { const int row = 8 * (6 * wid + k) + (lane >> 3); int ik = i0 - 128 + row; ik = ik < 0 ? 0 : ik; const bf16_t* src = base + (size_t)(ik * rr + cres) * NA;
            glds16(src + 1024 + (((lane & 7) ^ ((row >> 1) & 7)) << 3), Kb + (6 * wid + k) * 1024);
            glds16(src + 2048 + (((lane & 7) ^ (((row >> 1) & 1) << 2)) << 3), Vb + (6 * wid + k) * 1024); }
        const int iq = i0 + 32 * wid + r, tokq = b * SEQ + iq * rr + cres;
        bf16x8 qf[4];
        { const bf16_t* qp_ = qkv + (size_t)tokq * NA + g * 3072 + h * 64 + 8 * hh;
#pragma unroll
          for (int ds = 0; ds < 4; ++ds) qf[ds] = *(const bf16x8*)(qp_ + 16 * ds); }
        const float sr = exp2f(-0.5f * (float)(h + 1)) * LOG2E * (float)rr;
        f32x16 Bt;
#pragma unroll
        for (int i = 0; i < 16; ++i) Bt[i] = sr * (float)(crow(i, hh) - r);
        f32x16 O[2];
#pragma unroll
        for (int db = 0; db < 2; ++db)
#pragma unroll
            for (int i = 0; i < 16; ++i) O[db][i] = 0.f;
        float mrun = -1e30f, l = 0.f;
        ATT_WAITV(0);
        ATT_BAR();
#pragma unroll
        for (int sidx = 0; sidx < 5; ++sidx) {
            if (i0 + 32 * wid - 128 + 32 * sidx >= 0) {
                const LAS unsigned char* kb = Kb + (32 * (wid + sidx)) * 128;
                f32x16 p = Bt;
#pragma unroll
                for (int ds = 0; ds < 4; ++ds) { const bf16x8 kf = *(const LAS bf16x8*)(kb + koff[ds]); p = MFMA32(kf, qf[ds], p); }
                const float off = sr * (float)(32 * sidx - 128);
                if (sidx == 0) {
#pragma unroll
                    for (int i = 0; i < 16; ++i) if (crow(i, hh) < r) p[i] = -INFINITY; }
                if (sidx == 4) {
#pragma unroll
                    for (int i = 0; i < 16; ++i) if (crow(i, hh) > r) p[i] = -INFINITY; }
                float mx = p[0];
#pragma unroll
                for (int i = 1; i < 16; ++i) mx = fmaxf(mx, p[i]);
                mx = xhalf_max(mx + off);
                if (__any(mx > mrun + 8.f)) { const float mn = fmaxf(mrun, mx), f = __builtin_amdgcn_exp2f(mrun - mn); l *= f; mrun = mn;
#pragma unroll
                    for (int db = 0; db < 2; ++db)
#pragma unroll
                        for (int i = 0; i < 16; ++i) O[db][i] *= f; }
                const float e = off - mrun; float ls = 0.f;
#pragma unroll
                for (int i = 0; i < 16; ++i) { p[i] = __builtin_amdgcn_exp2f(p[i] + e); ls += p[i]; }
                l += ls;
                bf16x8 pa[2]; pa[0] = pack8(p, 0); pa[1] = pack8(p, 8);
#pragma unroll
                for (int db = 0; db < 2; ++db) { const unsigned va = (unsigned)(uintptr_t)(Vb + (32 * (wid + sidx)) * 128 + voff[db]); s16x4 lo[2], hi[2];
#pragma unroll
                    for (int ks = 0; ks < 2; ++ks) { asm volatile("ds_read_b64_tr_b16 %0, %1 offset:%c2" : "=&v"(lo[ks]) : "v"(va), "i"(ks * 2048) : "memory");
                                                     asm volatile("ds_read_b64_tr_b16 %0, %1 offset:%c2" : "=&v"(hi[ks]) : "v"(va), "i"(ks * 2048 + 1024) : "memory"); }
                    asm volatile("s_waitcnt lgkmcnt(0)" ::: "memory"); __builtin_amdgcn_sched_barrier(0);
#pragma unroll
                    for (int ks = 0; ks < 2; ++ks) { const bf16x8 vf = (bf16x8){lo[ks][0], lo[ks][1], lo[ks][2], lo[ks][3], hi[ks][0], hi[ks][1], hi[ks][2], hi[ks][3]}; O[db] = MFMA32(vf, pa[ks], O[db]); } }
            }
        }
        l = xhalf_sum(l);
        const float inv = 1.f / l;
        bf16_t* op = og + (size_t)g * T * D + (size_t)tokq * D + h * 64 + 4 * hh;
#pragma unroll
        for (int db = 0; db < 2; ++db)
#pragma unroll
            for (int q4 = 0; q4 < 4; ++q4) { u32x2 wv; wv.x = cvt_pk_bf16(O[db][4 * q4] * inv, O[db][4 * q4 + 1] * inv); wv.y = cvt_pk_bf16(O[db][4 * q4 + 2] * inv, O[db][4 * q4 + 3] * inv); *(u32x2*)(op + 32 * db + 8 * q4) = wv; }
        if (hh == 0) lse[(size_t)g * T * 16 + (size_t)tokq * 16 + h] = mrun + __builtin_amdgcn_logf(l);
        ATT_BAR();
    }
}
DEV void attA_merge(const Ctx& c) {
    const int tid_ = opaque_tid(); const int w = tid_ >> 6, lane = tid_ & 63;
    const bf16_t* og = (const bf16_t*)(c.ws + WS_OG); const float* lse = (const float*)(c.ws + WS_LSE); bf16_t* o = (bf16_t*)(c.ws + WS_O);
    for (int tok = blockIdx.x * NWAVES + w; tok < T; tok += c.G * NWAVES) {
        const int hd = lane >> 2;
        const float l0 = lse[(size_t)tok * 16 + hd], l1 = lse[(size_t)T * 16 + (size_t)tok * 16 + hd], l2 = lse[(size_t)2 * T * 16 + (size_t)tok * 16 + hd];
        const float mx = fmaxf(l0, fmaxf(l1, l2)); const float e0 = exp2f(l0 - mx), e1 = exp2f(l1 - mx), e2 = exp2f(l2 - mx); const float inv = 1.f / (e0 + e1 + e2);
        const float w0 = e0 * inv, w1 = e1 * inv, w2 = e2 * inv;
        const uint4* a0 = (const uint4*)(og + (size_t)tok * D + lane * 16); const uint4* a1 = (const uint4*)(og + (size_t)T * D + (size_t)tok * D + lane * 16); const uint4* a2 = (const uint4*)(og + (size_t)2 * T * D + (size_t)tok * D + lane * 16);
        uint4* od = (uint4*)(o + (size_t)tok * D + lane * 16);
#pragma unroll
        for (int hlf = 0; hlf < 2; ++hlf) { const uint4 x = a0[hlf], y = a1[hlf], z = a2[hlf]; uint4 res;
            const unsigned xs[4] = {x.x, x.y, x.z, x.w}, ys[4] = {y.x, y.y, y.z, y.w}, zs[4] = {z.x, z.y, z.z, z.w}; unsigned rs_[4];
#pragma unroll
            for (int k = 0; k < 4; ++k) { const float lo = w0 * bf2f(xs[k] & 0xffffu) + w1 * bf2f(ys[k] & 0xffffu) + w2 * bf2f(zs[k] & 0xffffu), hi = w0 * bf2f(xs[k] >> 16) + w1 * bf2f(ys[k] >> 16) + w2 * bf2f(zs[k] >> 16); rs_[k] = pk2(lo, hi); }
            res.x = rs_[0]; res.y = rs_[1]; res.z = rs_[2]; res.w = rs_[3]; od[hlf] = res; }
    }
}

template <int L> DEV void phase_router(const Ctx& c, LAS unsigned char* lds) {
    const int tid_ = opaque_tid(); const int w = tid_ >> 6, lane = tid_ & 63;
    LAS float* xs = (LAS float*)lds + w * 4096;
    LAS float* lg = (LAS float*)(lds + 131072) + w * 320;
    const float* h = (const float*)(c.ws + WS_H); const float* g = c.norm_ffn + L * D;
    const float* wc = c.w_coarse + (size_t)L * D * 8; const float* wf = c.w_fine + (size_t)L * D * 64;
    float* tok_gate = (float*)(c.ws + WS_TOK); int* tok_e = (int*)(c.ws + WS_TOK + 262144); int* tok_slot = (int*)(c.ws + WS_TOK + 524288); float* rs_ffn = (float*)(c.ws + WS_TOK + 786432);
    int* list = (int*)(c.ws + WS_LIST); float* list_rs = (float*)(c.ws + WS_LRS); float* list_gate = (float*)(c.ws + WS_LGATE); unsigned* cnt = ctl(c) + CW_CNT + L * 64;
    for (int grp = blockIdx.x * NWAVES + w; grp < T / 4; grp += c.G * NWAVES) {
        float rsv[4];
#pragma unroll
        for (int tk = 0; tk < 4; ++tk) { const int tok = grp * 4 + tk; const f32x4* hr = (const f32x4*)(h + (size_t)tok * D) + lane; f32x4 v[4]; float s = 0.f;
#pragma unroll
            for (int j = 0; j < 4; ++j) { v[j] = hr[64 * j]; s += (v[j].x * v[j].x + v[j].y * v[j].y) + (v[j].z * v[j].z + v[j].w * v[j].w); }
            const float rs = rsqrtf(wave_sum(s) * (1.f / D) + EPS); rsv[tk] = rs;
#pragma unroll
            for (int j = 0; j < 4; ++j) { const f32x4 gg = ((const f32x4*)g)[64 * j + lane]; f32x4 xv; xv.x = v[j].x * rs * gg.x; xv.y = v[j].y * rs * gg.y; xv.z = v[j].z * rs * gg.z; xv.w = v[j].w * rs * gg.w;
                ((LAS f32x4*)(xs + tk * 1024))[64 * j + lane] = xv; } }
        wave_lds_fence();
        float af[4] = {0.f, 0.f, 0.f, 0.f}, ac[4] = {0.f, 0.f, 0.f, 0.f};
        for (int k = 0; k < D; k += 4) {
            float wfv[4], wcv[4];
#pragma unroll
            for (int j = 0; j < 4; ++j) { wfv[j] = wf[(size_t)(k + j) * 64 + lane]; wcv[j] = wc[(size_t)(k + j) * 8 + (lane & 7)]; }
#pragma unroll
            for (int tk = 0; tk < 4; ++tk) { const f32x4 xv = *(const LAS f32x4*)(xs + tk * 1024 + k);
                af[tk] += xv.x * wfv[0]; af[tk] += xv.y * wfv[1]; af[tk] += xv.z * wfv[2]; af[tk] += xv.w * wfv[3];
                ac[tk] += xv.x * wcv[0]; ac[tk] += xv.y * wcv[1]; ac[tk] += xv.z * wcv[2]; ac[tk] += xv.w * wcv[3]; }
        }
#pragma unroll
        for (int tk = 0; tk < 4; ++tk) { lg[tk * 80 + 8 + lane] = af[tk] + c.b_fine[L * 64 + lane]; if (lane < 8) lg[tk * 80 + lane] = ac[tk] + c.b_coarse[L * 8 + lane]; }
        wave_lds_fence();
        if (lane < 4) { const int tok = grp * 4 + lane; const LAS float* l = lg + lane * 80;
            int gi = 0; float gm = l[0];
            for (int j = 1; j < 8; ++j) if (l[j] > gm) { gm = l[j]; gi = j; }
            float gs = 0.f; for (int j = 0; j < 8; ++j) gs += __expf(l[j] - gm);
            const float gp = 1.f / gs;
            const LAS float* f = l + 8 + gi * 8;
            int i1 = 0; float f1 = f[0]; for (int j = 1; j < 8; ++j) if (f[j] > f1) { f1 = f[j]; i1 = j; }
            int i2 = (i1 == 0) ? 1 : 0; float f2 = f[i2]; for (int j = 0; j < 8; ++j) if (j != i1 && f[j] > f2) { f2 = f[j]; i2 = j; }
            const float e2 = __expf(f2 - f1); const float p1 = 1.f / (1.f + e2), p2 = e2 / (1.f + e2);
            float rs = 0.f; for (int tk = 0; tk < 4; ++tk) if (tk == lane) rs = rsv[tk];
            rs_ffn[tok] = rs;
            const int e1 = gi * 8 + i1, e2i = gi * 8 + i2;
            const int s1 = (int)atomicAdd(cnt + e1, 1u), s2 = (int)atomicAdd(cnt + e2i, 1u);
            list[(size_t)e1 * T + s1] = tok * 2; list[(size_t)e2i * T + s2] = tok * 2 + 1; list_rs[(size_t)e1 * T + s1] = rs; list_rs[(size_t)e2i * T + s2] = rs; list_gate[(size_t)e1 * T + s1] = gp * p1; list_gate[(size_t)e2i * T + s2] = gp * p2;
            tok_e[tok * 2] = e1; tok_e[tok * 2 + 1] = e2i; tok_slot[tok * 2] = s1; tok_slot[tok * 2 + 1] = s2; tok_gate[tok * 2] = gp * p1; tok_gate[tok * 2 + 1] = gp * p2; }
        wave_lds_fence();
    }
}

template <int L> DEV void phase_combine(const Ctx& c, LAS unsigned char* lds) {
    const int tid_ = opaque_tid(); const int w = tid_ >> 6, lane = tid_ & 63;
    LAS int* tpre = (LAS int*)(lds + TBL_TPRE);
    moe_prefix((const int*)(ctl(c) + CW_CNT + L * 64), tpre);
    float* h = (float*)(c.ws + WS_H); bf16_t* hb = (bf16_t*)(c.ws + WS_HB + (size_t)(L & 1) * 64 * MiB); float* ssq = (float*)(c.ws + WS_SSQ + (size_t)(L & 1) * 2 * MiB); const bf16_t* y = (const bf16_t*)(c.ws + WS_Y);
    const int* tok_e = (const int*)(c.ws + WS_TOK + 262144); const int* tok_slot = (const int*)(c.ws + WS_TOK + 524288);
    for (int tok = blockIdx.x * NWAVES + w; tok < T; tok += c.G * NWAVES) {
        const size_t p0 = (size_t)tpre[tok_e[tok * 2]] * 256 + tok_slot[tok * 2], p1 = (size_t)tpre[tok_e[tok * 2 + 1]] * 256 + tok_slot[tok * 2 + 1];
        f32x4* hr = (f32x4*)(h + (size_t)tok * D) + lane; const uint2* y0 = (const uint2*)(y + p0 * D) + lane; const uint2* y1 = (const uint2*)(y + p1 * D) + lane; uint2* o = (uint2*)(hb + (size_t)tok * D) + lane;
        float s = 0.f;
#pragma unroll
        for (int j = 0; j < 4; ++j) { f32x4 v = hr[64 * j]; const uint2 a = y0[64 * j], b = y1[64 * j];
            v.x += bf2f(a.x & 0xffffu) + bf2f(b.x & 0xffffu); v.y += bf2f(a.x >> 16) + bf2f(b.x >> 16); v.z += bf2f(a.y & 0xffffu) + bf2f(b.y & 0xffffu); v.w += bf2f(a.y >> 16) + bf2f(b.y >> 16);
            hr[64 * j] = v; o[64 * j] = make_uint2(pk2(v.x, v.y), pk2(v.z, v.w)); s += (v.x * v.x + v.y * v.y) + (v.z * v.z + v.w * v.w); }
        s = wave_sum(s); if (lane < 16) ssq[(size_t)tok * 16 + lane] = (lane == 0) ? s : 0.f;
    }
}

DEV void phase_final(const Ctx& c) {
    const int tid_ = opaque_tid(); const int w = tid_ >> 6, lane = tid_ & 63;
    const float* h = (const float*)(c.ws + WS_H); const float* ssq = (const float*)(c.ws + WS_SSQ);
    for (int tok = blockIdx.x * NWAVES + w; tok < T; tok += c.G * NWAVES) {
        float a = (lane < 16) ? ssq[(size_t)tok * 16 + lane] : 0.f; a = wave_sum(a); const float rs = rsqrtf(a * (1.f / D) + EPS);
        const f32x4* hr = (const f32x4*)(h + (size_t)tok * D) + lane; f32x4* o = (f32x4*)(c.out + (size_t)tok * D) + lane;
#pragma unroll
        for (int j = 0; j < 4; ++j) { const f32x4 v = hr[64 * j]; const f32x4 g = ((const f32x4*)c.norm_final)[64 * j + lane]; f32x4 r; r.x = v.x * rs * g.x; r.y = v.y * rs * g.y; r.z = v.z * rs * g.z; r.w = v.w * rs * g.w; o[64 * j] = r; }
    }
}

template <int PH> DEV void run_phase(const Ctx& c, LAS unsigned char* lds) {
    unsigned char* ws = c.ws;
    if constexpr (PH == 0) { phase_prologue(c, lds); }
    else if constexpr (PH == 41) { phase_final(c); }
    else {
        constexpr int L = (PH - 1) / 10, S = (PH - 1) % 10, KIND = L % 3, J = L / 3;
        constexpr size_t HBC = WS_HB + (size_t)(L & 1) * 64 * MiB, HBN = WS_HB + (size_t)((L + 1) & 1) * 64 * MiB, SQC = WS_SSQ + (size_t)(L & 1) * 2 * MiB, SQN = WS_SSQ + (size_t)((L + 1) & 1) * 2 * MiB;
        if constexpr (S == 0) {
            Prob<0> p; p.A = (const bf16_t*)(ws + HBC); p.lda = D; p.K = D; p.out = (bf16_t*)(ws + WS_QKV); p.ssq = (const float*)(ws + SQC);
            if (KIND == 0) { p.Bt = (const bf16_t*)(ws + WS_WAIN) + (size_t)J * NA * D; p.N = NA; } else if (KIND == 1) { p.Bt = (const bf16_t*)(ws + WS_WBIN); p.N = NB; } else { p.Bt = (const bf16_t*)(ws + WS_WCIN); p.N = NB; }
            p.S.init(T, p.N, c.G, blockIdx.x);
            gemm_phase(p, lds);
        } else if constexpr (S == 1) {
            if constexpr (KIND == 0) { if (FAST_ATT_A) attA_fast(c, lds); else attA_naive(c, lds); }
            else if constexpr (KIND == 1) {
                const float lambda_init = 0.8f - 0.6f * expf(-0.3f * (float)L);
                float s1 = 0.f, s2 = 0.f; for (int i = 0; i < 64; ++i) { s1 += c.lq1[J * 64 + i] * c.lk1[J * 64 + i]; s2 += c.lq2[J * 64 + i] * c.lk2[J * 64 + i]; }
                const float lam = expf(s1) - expf(s2) + lambda_init;
                if (FAST_ATT_B) attB_fast(c, lam, lambda_init, c.subln + J * 128, lds); else attB_naive(c, lam, lambda_init, c.subln + J * 128, lds);
            } else { if (FAST_ATT_C) attC_fast(c, lds); else attC_naive(c, lds); }
        } else if constexpr (S == 2) {
            if constexpr (KIND == 0) { if (FAST_ATT_A) attA_merge(c); }
        } else if constexpr (S == 3) {
            Prob<1> p; p.A = (const bf16_t*)(ws + WS_O); p.lda = D; p.K = D; p.N = D;
            p.Bt = (KIND == 0) ? (const bf16_t*)(ws + WS_WAOUT) + (size_t)J * D * D : (KIND == 1) ? (const bf16_t*)(ws + WS_WBOUT) : (const bf16_t*)(ws + WS_WCOUT);
            p.hin = (L == 0) ? c.x : (const float*)(ws + WS_H); p.h = (float*)(ws + WS_H); p.hb = (bf16_t*)(ws + HBC); p.ssq = (float*)(ws + SQC);
            p.S.init(T, D, c.G, blockIdx.x);
            gemm_phase(p, lds);
        } else if constexpr (S == 4) {
            phase_router<L>(c, lds);
        } else if constexpr (S == 5) {
            LAS int* tpre = (LAS int*)(lds + TBL_TPRE); const int* cnt = (const int*)(ctl(c) + CW_CNT + L * 64);
            moe_prefix(cnt, tpre);
            Prob<2> p; p.A = (const bf16_t*)(ws + HBC); p.lda = D; p.K = D; p.Bt = (const bf16_t*)(ws + WS_WGU) + (size_t)L * NE * 1024 * D; p.act = (bf16_t*)(ws + WS_ACT);
            p.list = (const int*)(ws + WS_LIST); p.list_rs = (const float*)(ws + WS_LRS); p.S.init(tpre, cnt, c.G, blockIdx.x, 4);
            gemm_phase(p, lds);
        } else if constexpr (S == 6) {
            LAS int* tpre = (LAS int*)(lds + TBL_TPRE); const int* cnt = (const int*)(ctl(c) + CW_CNT + L * 64);
            moe_prefix(cnt, tpre);
            Prob<3> p; p.A = (const bf16_t*)(ws + WS_ACT); p.lda = FE; p.K = FE; p.Bt = (const bf16_t*)(ws + WS_WDN) + (size_t)L * NE * D * FE; p.y = (bf16_t*)(ws + WS_Y);
            p.list_gate = (const float*)(ws + WS_LGATE); p.S.init(tpre, cnt, c.G, blockIdx.x, 4);
            gemm_phase(p, lds);
        } else if constexpr (S == 7) {
            phase_combine<L>(c, lds);
            __syncthreads();
            Prob<0> p; p.ssq = nullptr; p.A = (const bf16_t*)(ws + WS_PB) + (size_t)L * T * PLE; p.lda = PLE; p.K = PLE; p.N = D; p.Bt = (const bf16_t*)(ws + WS_WPP) + (size_t)L * D * PLE; p.out = (bf16_t*)(ws + WS_PROJ);
            p.S.init(T, D, c.G, blockIdx.x);
            gemm_phase(p, lds);
        } else if constexpr (S == 8) {
            Prob<5> p; p.A = (const bf16_t*)(ws + HBC); p.lda = D; p.K = D; p.N = D; p.Bt = (const bf16_t*)(ws + WS_WPG) + (size_t)L * D * D; p.proj = (const bf16_t*)(ws + WS_PROJ);
            p.h = (float*)(ws + WS_H); p.hb = (bf16_t*)(ws + HBN); p.ssq_in = (const float*)(ws + SQC); p.ssq_out = (float*)(ws + SQN);
            p.S.init(T, D, c.G, blockIdx.x);
            gemm_phase(p, lds);
        }
    }
}

#define XB_TMO      128
#define XB_XCNT(j)  (256  + 64 * (j))
#define XB_XSUB(j)  (1280 + 64 * (j))
#define XB_XGEN(j)  (2304 + 64 * (j))
#define XB_TOP      3328
#define XB_TOPGEN   3392
#define XCD_BAR_WORDS 3456
#define XB_SPIN_CAP (1u << 18)
__device__ __forceinline__ unsigned xb_ld(unsigned* p)              { return __hip_atomic_load(p, __ATOMIC_RELAXED, __HIP_MEMORY_SCOPE_AGENT); }
__device__ __forceinline__ unsigned xb_add(unsigned* p, unsigned v) { return __hip_atomic_fetch_add(p, v, __ATOMIC_RELAXED, __HIP_MEMORY_SCOPE_AGENT); }
__device__ __forceinline__ unsigned xb_xcc_id() { return (unsigned)__builtin_amdgcn_s_getreg((3 << 11) | 20) & 0xFu; }
#define XB_SPIN(cond, bar) do { unsigned _sp = 0; while (cond) { __builtin_amdgcn_s_sleep(1); \
    if ((++_sp & 255u) == 0u) { if (xb_ld(&(bar)[XB_TMO])) break; if (_sp > XB_SPIN_CAP) { atomicAdd(&(bar)[XB_TMO], 1u); break; } } } } while (0)
struct XcdBarrier {
    unsigned* bar; unsigned x;
    volatile LAS unsigned* st;
};
__device__ __forceinline__ XcdBarrier xcd_barrier_post(unsigned* bar, volatile LAS unsigned* st) {
    XcdBarrier b; b.bar = bar; b.x = xb_xcc_id(); b.st = st;
    if (threadIdx.x == 0) (void)xb_add(&bar[XB_XCNT(b.x)], 1u);
    return b;
}
__device__ __forceinline__ void xcd_barrier_complete(unsigned* bar, unsigned x, unsigned& nloc, unsigned& nx) {
    const unsigned G = gridDim.x * gridDim.y * gridDim.z;
    unsigned sum, cnt, mine, sp = 0u;
    for (;;) {
        sum = 0u; cnt = 0u; mine = 0u;
#pragma unroll
        for (unsigned j = 0; j < 16; ++j) { const unsigned c = xb_ld(&bar[XB_XCNT(j)]); sum += c; cnt += (c > 0u) ? 1u : 0u; mine = (j == x) ? c : mine; }
        if (sum == G) break;
        __builtin_amdgcn_s_sleep(1);
        if ((++sp & 255u) == 0u) { if (xb_ld(&bar[XB_TMO])) break; if (sp > XB_SPIN_CAP) { atomicAdd(&bar[XB_TMO], 1u); break; } }
    }
    nloc = mine > 0u ? mine : 1u; nx = cnt > 0u ? cnt : 1u;
}
__device__ __forceinline__ void xcd_barrier(const XcdBarrier& b) {
    asm volatile("s_waitcnt vmcnt(0)" ::: "memory");
    __syncthreads();
    if (threadIdx.x == 0) {
        unsigned* bar = b.bar;
        __builtin_amdgcn_s_waitcnt(0);
        unsigned nloc = b.st[0], nx = b.st[1];
        if (nloc == 0u) { xcd_barrier_complete(bar, b.x, nloc, nx); b.st[0] = nloc; b.st[1] = nx; }
        const unsigned old = xb_add(&bar[XB_XSUB(b.x)], 1u);
        const unsigned gen = old / nloc;
        if (old + 1u == (gen + 1u) * nloc) {
            __builtin_amdgcn_fence(__ATOMIC_RELEASE, "agent");
            asm volatile("s_waitcnt vmcnt(0)" ::: "memory");
            const unsigned og = xb_add(&bar[XB_TOP], 1u);
            const unsigned tg = og / nx;
            if (og + 1u == (tg + 1u) * nx) xb_add(&bar[XB_TOPGEN], 1u);
            else XB_SPIN(xb_ld(&bar[XB_TOPGEN]) == tg, bar);
            __builtin_amdgcn_fence(__ATOMIC_ACQUIRE, "agent");
            xb_add(&bar[XB_XGEN(b.x)], 1u);
            asm volatile("s_waitcnt vmcnt(0)" ::: "memory");
        } else {
            XB_SPIN(xb_ld(&bar[XB_XGEN(b.x)]) == gen, bar);
            __builtin_amdgcn_fence(__ATOMIC_ACQUIRE, "agent");
            asm volatile("s_waitcnt vmcnt(0)" ::: "memory");
        }
    }
    __syncthreads();
}

constexpr int CW_BAR = 4096;
constexpr int LDS_BARW = 143360;

#ifndef MK_MULTI
#define MK_MULTI 0
#endif
#if MK_MULTI
template <int PH> __global__ void __launch_bounds__(NTHR, 2) k_phase(Ctx c) {
    extern __shared__ __attribute__((aligned(16))) unsigned char lds_raw[];
    run_phase<PH>(c, (LAS unsigned char*)lds_raw);
}
template <int PH> static void launch_phase(const Ctx& c, hipStream_t stream) {
    static bool attr = false;
    if (!attr) { (void)hipFuncSetAttribute((const void*)k_phase<PH>, hipFuncAttributeMaxDynamicSharedMemorySize, LDS_BYTES); attr = true; }
    hipLaunchKernelGGL(k_phase<PH>, dim3(c.G), dim3(NTHR), LDS_BYTES, stream, c);
}
template <int L> static void launch_layer(const Ctx& c, hipStream_t s) {
    launch_phase<1 + 10 * L + 0>(c, s); launch_phase<1 + 10 * L + 1>(c, s); launch_phase<1 + 10 * L + 3>(c, s); launch_phase<1 + 10 * L + 4>(c, s);
    launch_phase<1 + 10 * L + 5>(c, s); launch_phase<1 + 10 * L + 6>(c, s); launch_phase<1 + 10 * L + 7>(c, s); launch_phase<1 + 10 * L + 8>(c, s);
}
static void launch_all(const Ctx& c, hipStream_t stream) {
    launch_all(c, stream);
}
#else
template <int L> DEV void run_layer(const Ctx& c, LAS unsigned char* lds, const XcdBarrier& bar) {
    run_phase<1 + 10 * L + 0>(c, lds); xcd_barrier(bar);
    run_phase<1 + 10 * L + 1>(c, lds); xcd_barrier(bar);
    if constexpr (L % 3 == 0 && FAST_ATT_A) { run_phase<1 + 10 * L + 2>(c, lds); xcd_barrier(bar); }
    run_phase<1 + 10 * L + 3>(c, lds); xcd_barrier(bar);
    run_phase<1 + 10 * L + 4>(c, lds); xcd_barrier(bar);
    run_phase<1 + 10 * L + 5>(c, lds); xcd_barrier(bar);
    run_phase<1 + 10 * L + 6>(c, lds); xcd_barrier(bar);
    run_phase<1 + 10 * L + 7>(c, lds); xcd_barrier(bar);
    run_phase<1 + 10 * L + 8>(c, lds); xcd_barrier(bar);
}
__global__ void __launch_bounds__(NTHR, 2) mega_fwd(Ctx c) {
    extern __shared__ __attribute__((aligned(16))) unsigned char lds_raw[];
    LAS unsigned char* lds = (LAS unsigned char*)lds_raw;
    if (threadIdx.x < 4) ((LAS unsigned*)(lds + LDS_BARW))[threadIdx.x] = 0u;
    __syncthreads();
    const XcdBarrier bar = xcd_barrier_post(ctl(c) + CW_BAR, (volatile LAS unsigned*)(lds + LDS_BARW));
    run_phase<0>(c, lds); xcd_barrier(bar);
    run_layer<0>(c, lds, bar); run_layer<1>(c, lds, bar); run_layer<2>(c, lds, bar); run_layer<3>(c, lds, bar);
    run_phase<41>(c, lds);
}
static void launch_all(const Ctx& c, hipStream_t stream) {
    static bool attr = false;
    if (!attr) { (void)hipFuncSetAttribute((const void*)mega_fwd, hipFuncAttributeMaxDynamicSharedMemorySize, LDS_BYTES);
        int per_cu = 0; if (hipOccupancyMaxActiveBlocksPerMultiprocessor(&per_cu, (const void*)mega_fwd, NTHR, LDS_BYTES) != hipSuccess || per_cu < 1) fprintf(stderr, "kernel_launch: occupancy query reports %d blocks per CU\n", per_cu);
        (void)hipGetLastError(); attr = true; }
    hipLaunchKernelGGL(mega_fwd, dim3(c.G), dim3(NTHR), LDS_BYTES, stream, c);
}
#endif

extern "C" void kernel_launch(void* const* d_in, const int* in_sizes, int n_in, void* d_out, int out_size, void* d_ws, size_t ws_size, hipStream_t stream) {
    if (n_in != 25 || ws_size < WS_END) { fprintf(stderr, "kernel_launch: unexpected n_in %d or ws_size %zu (< %zu)\n", n_in, ws_size, (size_t)WS_END); return; }
    static int grid = 0;
    if (!grid) { int dev = 0, cus = 0; (void)hipGetDevice(&dev); (void)hipDeviceGetAttribute(&cus, hipDeviceAttributeMultiprocessorCount, dev); grid = cus > 0 ? cus : 256; }
    Ctx c{};
    const float* const* in = (const float* const*)d_in;
    c.x = in[0]; c.p = in[1]; c.norm_mix = in[2]; c.norm_ffn = in[3]; c.norm_ple = in[4]; c.norm_final = in[5];
    c.a_w_in = in[6]; c.a_w_out = in[7]; c.b_w_in = in[8]; c.b_w_out = in[9]; c.lq1 = in[10]; c.lk1 = in[11]; c.lq2 = in[12]; c.lk2 = in[13]; c.subln = in[14];
    c.c_w_in = in[15]; c.c_w_out = in[16]; c.w_coarse = in[17]; c.b_coarse = in[18]; c.w_fine = in[19]; c.b_fine = in[20]; c.w_gu = in[21]; c.w_dn = in[22]; c.w_pp = in[23]; c.w_pg = in[24];
    c.out = (float*)d_out; c.ws = (unsigned char*)d_ws; c.G = grid; c.pad = 0;
    (void)hipMemsetAsync((char*)d_ws + WS_CTL, 0, CTL_BYTES, stream);
    launch_all(c, stream);
}
```

```cpp
#include <hip/hip_runtime.h>
#include <cstdint>
#include <cstdio>

#define DEV __device__ __forceinline__
#define LAS __attribute__((address_space(3)))
typedef unsigned short bf16_t;
typedef short bf16x8 __attribute__((ext_vector_type(8)));
typedef float f32x16 __attribute__((ext_vector_type(16)));
typedef float f32x4 __attribute__((ext_vector_type(4)));

constexpr int D = 1024, BATCH = 8, SEQ = 4096, T = BATCH * SEQ, DEPTH = 4;
constexpr int NE = 64, FE = 512, PLE = 256;
constexpr int NA = 9216, NB = 3072;
constexpr float EPS = 1e-6f;
constexpr float LOG2E = 1.4426950408889634f, LN2 = 0.6931471805599453f;
constexpr float QSCALE = 0.125f * LOG2E;
constexpr int PMAX = 2 * T + NE * 256;
constexpr int NWAVES = 8, NTHR = 512;

constexpr size_t MiB = 1ull << 20;
constexpr size_t WS_CTL = 0;
constexpr size_t WS_WAIN = 1 * MiB;
constexpr size_t WS_WBIN = WS_WAIN + 36 * MiB;
constexpr size_t WS_WCIN = WS_WBIN + 6 * MiB;
constexpr size_t WS_WAOUT = WS_WCIN + 6 * MiB;
constexpr size_t WS_WBOUT = WS_WAOUT + 4 * MiB;
constexpr size_t WS_WCOUT = WS_WBOUT + 2 * MiB;
constexpr size_t WS_WGU = WS_WCOUT + 2 * MiB;
constexpr size_t WS_WDN = WS_WGU + 512 * MiB;
constexpr size_t WS_WPG = WS_WDN + 256 * MiB;
constexpr size_t WS_WPP = WS_WPG + 8 * MiB;
constexpr size_t WS_PB = WS_WPP + 2 * MiB;
constexpr size_t WS_H = WS_PB + 64 * MiB;
constexpr size_t WS_HB = WS_H + 128 * MiB;
constexpr size_t WS_SSQ = WS_HB + 128 * MiB;
constexpr size_t WS_QKV = WS_SSQ + 4 * MiB;
constexpr size_t WS_OG = WS_QKV + 576 * MiB;
constexpr size_t WS_LSE = WS_OG + 192 * MiB;
constexpr size_t WS_O = WS_LSE + 6 * MiB;
constexpr size_t WS_TOK = WS_O + 64 * MiB;
constexpr size_t WS_LIST = WS_TOK + 2 * MiB;
constexpr size_t WS_LRS = WS_LIST + 8 * MiB;
constexpr size_t WS_LGATE = WS_LRS + 8 * MiB;
constexpr size_t WS_ACT = WS_LGATE + 8 * MiB;
constexpr size_t WS_Y = WS_ACT + 80 * MiB;
constexpr size_t WS_PROJ = WS_Y + 160 * MiB;
constexpr size_t WS_WR = WS_PROJ + 64 * MiB;
constexpr size_t WS_KMAX = WS_WR + 2 * MiB;
constexpr size_t WS_END = WS_KMAX + 1 * MiB;
constexpr int CW_CNT = 16384;
constexpr size_t CTL_BYTES = 1 * MiB;

constexpr int LDS_BYTES = 147456;

DEV unsigned f2bf(float f) { unsigned u = __float_as_uint(f); return (u + 0x7fffu + ((u >> 16) & 1u)) >> 16; }
DEV float bf2f(unsigned b) { return __uint_as_float(b << 16); }
DEV unsigned pk2(float lo, float hi) { return f2bf(lo) | (f2bf(hi) << 16); }
DEV float wave_sum(float v) {
#pragma unroll
    for (int o = 1; o < 64; o <<= 1) v += __shfl_xor(v, o);
    return v;
}
DEV float wave_max(float v) {
#pragma unroll
    for (int o = 1; o < 64; o <<= 1) v = fmaxf(v, __shfl_xor(v, o));
    return v;
}
DEV void wave_lds_fence() { asm volatile("s_waitcnt lgkmcnt(0)" ::: "memory"); __builtin_amdgcn_wave_barrier(); }
DEV int opaque_tid() { int t = threadIdx.x; asm volatile("" : "+v"(t)); return t; }
DEV size_t hm(int plane, int token) { return ((size_t)plane * T + (size_t)token) * 64; }
DEV int crow(int i, int hh) { return (i & 3) + 8 * (i >> 2) + 4 * hh; }

struct Ctx {
    const float *x, *p, *norm_mix, *norm_ffn, *norm_ple, *norm_final;
    const float *a_w_in, *a_w_out, *b_w_in, *b_w_out, *lq1, *lk1, *lq2, *lk2, *subln, *c_w_in, *c_w_out;
    const float *w_coarse, *b_coarse, *w_fine, *b_fine, *w_gu, *w_dn, *w_pp, *w_pg;
    float* out;
    unsigned char* ws;
    int G;
    int pad;
};
DEV unsigned* ctl(const Ctx& c) { return (unsigned*)(c.ws + WS_CTL); }

struct Unit { int pm, pn, e, rows, lbase, orow; };

struct StaticOrder {
    int nM, nN, nwg, G, c;
    DEV void init(int M, int N, int G_, int c_) { nM = M / 256; nN = N / 256; nwg = nM * nN; G = G_; c = c_; }
    DEV bool next(int i, Unit& u) const {
        const long L = (long)i * G + c; if (L >= nwg) return false;
        int wgid = (int)L; { const int q = nwg / 8, r = nwg % 8, xcd = wgid % 8, off = wgid / 8; wgid = (xcd < r ? xcd * (q + 1) : r * (q + 1) + (xcd - r) * q) + off; }
        const int nig = 8 * nN, gid = wgid / nig, fm = gid * 8, gsz = (nM - fm) < 8 ? (nM - fm) : 8;
        u.pm = fm + ((wgid % nig) % gsz); u.pn = (wgid % nig) / gsz; u.e = 0; u.rows = 256; u.lbase = 0; u.orow = u.pm * 256; return true;
    }
};
struct MoeOrder {
    int tlo, thi, cn, ntile; int G, c, npn;
    DEV void init(const LAS int* tpre, const int* cnt, int G_, int c_, int npn_) { const int lane = threadIdx.x & 63; tlo = tpre[lane]; thi = tpre[lane + 1]; cn = cnt[lane]; ntile = tpre[64]; G = G_; c = c_; npn = npn_; }
    DEV bool next(int i, Unit& u) const {
        const int id = i * G + c;
        if (id >= ntile * npn) return false;
        const int ti = id / npn; u.pn = id % npn;
        const unsigned long long bal = __ballot(tlo <= ti && ti < thi);
        const int e = (int)__builtin_ctzll(bal | (1ull << 63));
        u.e = e; const int ch = ti - __builtin_amdgcn_readlane(tlo, e); const int n = __builtin_amdgcn_readlane(cn, e);
        u.rows = (n - ch * 256) < 256 ? (n - ch * 256) : 256; u.lbase = e * T + ch * 256; u.pm = ti; u.orow = ti * 256; return true;
    }
};
DEV void moe_prefix(const int* cnt, LAS int* tpre) {
    if (threadIdx.x == 0) { int s = 0; for (int e = 0; e < 64; ++e) { tpre[e] = s; s += (cnt[e] + 255) >> 8; } tpre[64] = s; }
    __syncthreads();
}

constexpr int TBL_OFF = 131072;
constexpr int TBL_RED = TBL_OFF + 8192;
constexpr int TBL_TPRE = TBL_OFF + 12288 + 256;
typedef unsigned u32x4 __attribute__((ext_vector_type(4)));
typedef unsigned u32x2 __attribute__((ext_vector_type(2)));
DEV unsigned cvt_pk_bf16(float lo, float hi) { unsigned r; asm volatile("v_cvt_pk_bf16_f32 %0, %1, %2" : "=v"(r) : "v"(lo), "v"(hi)); return r; }
DEV float sigmoidf_(float x) { return 1.f / (1.f + __expf(-x)); }
typedef f32x4 AccT[2][2][4][2];

template <int KIND> struct Prob;

DEV void ssq_tbl_dma(const float* ssq, int orow, LAS unsigned char* slot, int wid, int lane) {
    if (wid < 4) __builtin_amdgcn_global_load_lds((const unsigned*)(ssq + (size_t)(orow + 64 * wid + lane) * 4), (LAS unsigned*)(slot + 1024 * wid), 16, 0, 0);
}
DEV float rs_of(const LAS unsigned char* slot, int rt) { const f32x4 p = *(const LAS f32x4*)(slot + rt * 16); return rsqrtf(((p[0] + p[1]) + (p[2] + p[3])) * (1.0f / D) + EPS); }
DEV void ssq_reduce_store(float* ssq, const Unit& u, LAS unsigned char* red, int tid) {
    asm volatile("s_waitcnt lgkmcnt(0)" ::: "memory"); __builtin_amdgcn_s_barrier(); asm volatile("" ::: "memory");
    if (tid < 256) { const f32x4 p = *(const LAS f32x4*)(red + tid * 16); ssq[(size_t)(u.orow + tid) * 4 + u.pn] = (p[0] + p[1]) + (p[2] + p[3]); }
}

template <> struct Prob<0> {
    static constexpr bool HAS_TBL = true;
    const bf16_t* A; int lda; const bf16_t* Bt; int N, K; bf16_t* out; const float* ssq; int headmajor; StaticOrder S;
    DEV bool next(int i, Unit& u) const { return S.next(i, u); }
    DEV void tbl_dma(const Unit& u, LAS unsigned char* slot, int wid, int lane) const { if (ssq) ssq_tbl_dma(ssq, u.orow, slot, wid, lane); }
    DEV unsigned arow(const Unit& u, int r, const LAS unsigned char*) const { return (unsigned)(u.orow + r); }
    DEV const bf16_t* b_base(const Unit& u) const { return Bt + (size_t)u.pn * 256 * K; }
    DEV void epi_fast(const AccT& acc, const Unit& u, int wr, int wc, int fr, int fq, const LAS unsigned char* slot, LAS unsigned char*, int) const {
        asm volatile("" : "+v"(fr), "+v"(fq));
#pragma unroll
        for (int ai = 0; ai < 2; ++ai)
#pragma unroll
            for (int m = 0; m < 4; ++m) { const int rt = 128 * ai + 64 * wr + 16 * m + fr; const float rs = ssq ? rs_of(slot, rt) : 1.f;
                bf16_t* rowp = headmajor ? out + hm(u.pn * 4 + (wc >> 1), u.orow + rt) + 32 * (wc & 1) + 8 * fq : out + (size_t)(u.orow + rt) * N + u.pn * 256 + 32 * wc + 8 * fq;
                const size_t bjs = headmajor ? (size_t)2 * T * 64 : (size_t)128;
#pragma unroll
                for (int bj = 0; bj < 2; ++bj) { const f32x4 v0 = acc[ai][bj][m][0] * rs, v1 = acc[ai][bj][m][1] * rs; u32x4 w;
                    w.x = cvt_pk_bf16(v0[0], v0[1]); w.y = cvt_pk_bf16(v0[2], v0[3]); w.z = cvt_pk_bf16(v1[0], v1[1]); w.w = cvt_pk_bf16(v1[2], v1[3]);
                    *(u32x4*)(rowp + bjs * bj) = w; } }
    }
};
template <> struct Prob<1> {
    static constexpr bool HAS_TBL = false;
    const bf16_t* A; int lda; const bf16_t* Bt; int N, K; const float* hin; float* h; bf16_t* hb; float* ssq; StaticOrder S;
    DEV bool next(int i, Unit& u) const { return S.next(i, u); }
    DEV void tbl_dma(const Unit&, LAS unsigned char*, int, int) const {}
    DEV unsigned arow(const Unit& u, int r, const LAS unsigned char*) const { return (unsigned)(u.orow + r); }
    DEV const bf16_t* b_base(const Unit& u) const { return Bt + (size_t)u.pn * 256 * K; }
    DEV void epi_fast(const AccT& acc, const Unit& u, int wr, int wc, int fr, int fq, const LAS unsigned char*, LAS unsigned char* red, int tid) const {
        asm volatile("" : "+v"(fr), "+v"(fq));
#pragma unroll
        for (int ai = 0; ai < 2; ++ai)
#pragma unroll
            for (int m = 0; m < 4; ++m) { const int rt = 128 * ai + 64 * wr + 16 * m + fr; const size_t o = (size_t)(u.orow + rt) * D + u.pn * 256 + 32 * wc + 8 * fq; float q = 0.f;
#pragma unroll
                for (int bj = 0; bj < 2; ++bj) { const f32x4 h0 = *(const f32x4*)(hin + o + 128 * bj), h1 = *(const f32x4*)(hin + o + 128 * bj + 4);
                    const f32x4 v0 = h0 + acc[ai][bj][m][0], v1 = h1 + acc[ai][bj][m][1];
                    *(f32x4*)(h + o + 128 * bj) = v0; *(f32x4*)(h + o + 128 * bj + 4) = v1; u32x4 w;
                    w.x = cvt_pk_bf16(v0[0], v0[1]); w.y = cvt_pk_bf16(v0[2], v0[3]); w.z = cvt_pk_bf16(v1[0], v1[1]); w.w = cvt_pk_bf16(v1[2], v1[3]);
                    *(u32x4*)(hb + o + 128 * bj) = w;
                    q += (v0[0] * v0[0] + v0[1] * v0[1]) + (v0[2] * v0[2] + v0[3] * v0[3]) + (v1[0] * v1[0] + v1[1] * v1[1]) + (v1[2] * v1[2] + v1[3] * v1[3]); }
                q += __shfl_xor(q, 16); q += __shfl_xor(q, 32);
                if (fq == 0) ((LAS float*)red)[rt * 4 + wc] = q; }
        ssq_reduce_store(ssq, u, red, tid);
    }
};
template <> struct Prob<2> {
    static constexpr bool HAS_TBL = true;
    const bf16_t* A; int lda; const bf16_t* Bt; int K; bf16_t* act; const int* list; const float* list_rs; MoeOrder S;
    DEV bool next(int i, Unit& u) const { return S.next(i, u); }
    DEV void tbl_dma(const Unit& u, LAS unsigned char* slot, int wid, int lane) const {
        const unsigned* src = (wid < 4) ? (const unsigned*)list + u.lbase + 64 * wid + lane : (const unsigned*)list_rs + u.lbase + 64 * (wid - 4) + lane;
        __builtin_amdgcn_global_load_lds(src, (LAS unsigned*)(slot + 256 * wid), 4, 0, 0); }
    DEV unsigned arow(const Unit& u, int r, const LAS unsigned char* slot) const { const unsigned e = ((const LAS unsigned*)slot)[r]; return (r < u.rows) ? (e >> 1) : 0u; }
    DEV const bf16_t* b_base(const Unit& u) const { return Bt + ((size_t)u.e * 1024 + u.pn * 256) * K; }
    DEV void epi_fast(const AccT& acc, const Unit& u, int wr, int wc, int fr, int fq, const LAS unsigned char* slot, LAS unsigned char*, int) const {
        asm volatile("" : "+v"(fr), "+v"(fq));
        const LAS float* tf = (const LAS float*)(slot + 1024);
#pragma unroll
        for (int ai = 0; ai < 2; ++ai)
#pragma unroll
            for (int m = 0; m < 4; ++m) { const int rt = 128 * ai + 64 * wr + 16 * m + fr; const float rs = tf[rt];
                float o[8];
#pragma unroll
                for (int n = 0; n < 2; ++n)
#pragma unroll
                    for (int j = 0; j < 4; ++j) { const float g = acc[ai][0][m][n][j] * rs, up = acc[ai][1][m][n][j] * rs; o[4 * n + j] = g * sigmoidf_(g) * up; }
                u32x4 w; w.x = cvt_pk_bf16(o[0], o[1]); w.y = cvt_pk_bf16(o[2], o[3]); w.z = cvt_pk_bf16(o[4], o[5]); w.w = cvt_pk_bf16(o[6], o[7]);
                if (rt < u.rows) *(u32x4*)(act + (size_t)(u.orow + rt) * FE + u.pn * 128 + 32 * wc + 8 * fq) = w; }
    }
};
template <> struct Prob<3> {
    static constexpr bool HAS_TBL = true;
    const bf16_t* A; int lda; const bf16_t* Bt; int K; bf16_t* y; const float* list_gate; MoeOrder S;
    DEV bool next(int i, Unit& u) const { return S.next(i, u); }
    DEV void tbl_dma(const Unit& u, LAS unsigned char* slot, int wid, int lane) const {
        if (wid < 4) __builtin_amdgcn_global_load_lds((const unsigned*)list_gate + u.lbase + 64 * wid + lane, (LAS unsigned*)(slot + 1024 + 256 * wid), 4, 0, 0); }
    DEV unsigned arow(const Unit& u, int r, const LAS unsigned char*) const { return (unsigned)(u.orow + r); }
    DEV const bf16_t* b_base(const Unit& u) const { return Bt + ((size_t)u.e * 1024 + u.pn * 256) * K; }
    DEV void epi_fast(const AccT& acc, const Unit& u, int wr, int wc, int fr, int fq, const LAS unsigned char* slot, LAS unsigned char*, int) const {
        asm volatile("" : "+v"(fr), "+v"(fq));
        const LAS float* tf = (const LAS float*)(slot + 1024);
#pragma unroll
        for (int ai = 0; ai < 2; ++ai)
#pragma unroll
            for (int m = 0; m < 4; ++m) { const int rt = 128 * ai + 64 * wr + 16 * m + fr; const float gs = tf[rt];
                bf16_t* rowp = y + (size_t)(u.orow + rt) * D + u.pn * 256 + 32 * wc + 8 * fq;
#pragma unroll
                for (int bj = 0; bj < 2; ++bj) { const f32x4 v0 = acc[ai][bj][m][0] * gs, v1 = acc[ai][bj][m][1] * gs; u32x4 w;
                    w.x = cvt_pk_bf16(v0[0], v0[1]); w.y = cvt_pk_bf16(v0[2], v0[3]); w.z = cvt_pk_bf16(v1[0], v1[1]); w.w = cvt_pk_bf16(v1[2], v1[3]);
                    if (rt < u.rows) *(u32x4*)(rowp + 128 * bj) = w; } }
    }
};
template <> struct Prob<5> {
    static constexpr bool HAS_TBL = true;
    const bf16_t* A; int lda; const bf16_t* Bt; int N, K; const bf16_t* proj; float* h; bf16_t* hb; const float* ssq_in; float* ssq_out; StaticOrder S;
    DEV bool next(int i, Unit& u) const { return S.next(i, u); }
    DEV void tbl_dma(const Unit& u, LAS unsigned char* slot, int wid, int lane) const { ssq_tbl_dma(ssq_in, u.orow, slot, wid, lane); }
    DEV unsigned arow(const Unit& u, int r, const LAS unsigned char*) const { return (unsigned)(u.orow + r); }
    DEV const bf16_t* b_base(const Unit& u) const { return Bt + (size_t)u.pn * 256 * K; }
    DEV void epi_fast(const AccT& acc, const Unit& u, int wr, int wc, int fr, int fq, const LAS unsigned char* slot, LAS unsigned char* red, int tid) const {
        asm volatile("" : "+v"(fr), "+v"(fq));
#pragma unroll
        for (int ai = 0; ai < 2; ++ai)
#pragma unroll
            for (int m = 0; m < 4; ++m) { const int rt = 128 * ai + 64 * wr + 16 * m + fr; const float rs = rs_of(slot, rt); const size_t o = (size_t)(u.orow + rt) * D + u.pn * 256 + 32 * wc + 8 * fq; float q = 0.f;
#pragma unroll
                for (int bj = 0; bj < 2; ++bj) { const f32x4 h0 = *(const f32x4*)(h + o + 128 * bj), h1 = *(const f32x4*)(h + o + 128 * bj + 4); const u32x4 pj = *(const u32x4*)(proj + o + 128 * bj);
                    const f32x4 a0 = acc[ai][bj][m][0] * rs, a1 = acc[ai][bj][m][1] * rs; f32x4 v0, v1;
                    v0[0] = h0[0] + bf2f(pj.x & 0xffffu) * sigmoidf_(a0[0]); v0[1] = h0[1] + bf2f(pj.x >> 16) * sigmoidf_(a0[1]); v0[2] = h0[2] + bf2f(pj.y & 0xffffu) * sigmoidf_(a0[2]); v0[3] = h0[3] + bf2f(pj.y >> 16) * sigmoidf_(a0[3]);
                    v1[0] = h1[0] + bf2f(pj.z & 0xffffu) * sigmoidf_(a1[0]); v1[1] = h1[1] + bf2f(pj.z >> 16) * sigmoidf_(a1[1]); v1[2] = h1[2] + bf2f(pj.w & 0xffffu) * sigmoidf_(a1[2]); v1[3] = h1[3] + bf2f(pj.w >> 16) * sigmoidf_(a1[3]);
                    *(f32x4*)(h + o + 128 * bj) = v0; *(f32x4*)(h + o + 128 * bj + 4) = v1; u32x4 w;
                    w.x = cvt_pk_bf16(v0[0], v0[1]); w.y = cvt_pk_bf16(v0[2], v0[3]); w.z = cvt_pk_bf16(v1[0], v1[1]); w.w = cvt_pk_bf16(v1[2], v1[3]);
                    *(u32x4*)(hb + o + 128 * bj) = w;
                    q += (v0[0] * v0[0] + v0[1] * v0[1]) + (v0[2] * v0[2] + v0[3] * v0[3]) + (v1[0] * v1[0] + v1[1] * v1[1]) + (v1[2] * v1[2] + v1[3] * v1[3]); }
                q += __shfl_xor(q, 16); q += __shfl_xor(q, 32);
                if (fq == 0) ((LAS float*)red)[rt * 4 + wc] = q; }
        ssq_reduce_store(ssq_out, u, red, tid);
    }
};

namespace fg {
constexpr int BK = 64, HALF = 128, HTB = HALF * BK * 2;
DEV int lds_byte(int r, int c) { const int st = (r >> 4) * 2 + (c >> 5), rr = r & 15, cc = c & 31, ob = rr * 64 + cc * 2; return st * 1024 + (ob ^ (((ob >> 9) & 1) << 5)); }
DEV void stage_rc(int b, int& R, int& C) { const int st = b / 1024, sb = b % 1024, swz = sb ^ (((sb >> 9) & 1) << 5); R = (st >> 1) * 16 + swz / 64; C = (st & 1) * 32 + (swz % 64) / 2; }
DEV int perm32(int rho) { const int n = rho >> 4, i = rho & 15; return 8 * (i >> 2) + 4 * n + (i & 3); }
}
template <class P> DEV void gemm_phase_fast(const P& p, LAS unsigned char* lds) {
    using namespace fg;
    const int tid = opaque_tid(), wid = __builtin_amdgcn_readfirstlane(tid >> 6), lane = tid & 63, wr = wid >> 2, wc = wid & 3, fr = lane & 15, fq = lane >> 4;
    const int K = p.K, nt = K / BK, lda = p.lda;
    unsigned voffB[2];
#pragma unroll
    for (int i = 0; i < 2; ++i) { int R, C; stage_rc(tid * 16 + i * 8192, R, C); const int Rb = (R & ~31) + perm32(R & 31); voffB[i] = (unsigned)(Rb * K + C) * 2u; }
    const size_t kstep = (size_t)(BK * 2);
    const size_t hstepB = (size_t)HALF * K * 2;
    const unsigned ldsw = (unsigned)wid * 1024u;
    const int aoffl = lds_byte(wr * 64 + fr, fq * 8), boffl = lds_byte(wc * 32 + fr, fq * 8);
#define PG8_SA(b, h) (((b) * 2 + (h)) * HTB)
#define PG8_SB(b, h) ((4 + (b) * 2 + (h)) * HTB)
#define PG8_STAGE(bufoff, gbase, voff) do { _Pragma("unroll") for (int _i = 0; _i < 2; ++_i) \
        __builtin_amdgcn_global_load_lds((const unsigned*)((const char*)(gbase) + (voff)[_i]), (LAS unsigned*)(lds + (bufoff) + ldsw + _i * 8192), 16, 0, 0); } while (0)
#define PG8_LDA(dst, b, h) do { _Pragma("unroll") for (int m = 0; m < 4; ++m) _Pragma("unroll") for (int k = 0; k < 2; ++k) dst[m][k] = *(const LAS bf16x8*)(lds + PG8_SA(b, h) + aoffl + m * 2048 + k * 1024); } while (0)
#define PG8_LDB(dst, b, h) do { _Pragma("unroll") for (int n = 0; n < 2; ++n) _Pragma("unroll") for (int k = 0; k < 2; ++k) dst[n][k] = *(const LAS bf16x8*)(lds + PG8_SB(b, h) + boffl + n * 2048 + k * 1024); } while (0)
#define PG8_MMA(ai, bj, At, Bt) do { __builtin_amdgcn_s_setprio(1); _Pragma("unroll") for (int m = 0; m < 4; ++m) _Pragma("unroll") for (int n = 0; n < 2; ++n) _Pragma("unroll") for (int k = 0; k < 2; ++k) \
        acc[ai][bj][m][n] = __builtin_amdgcn_mfma_f32_16x16x32_bf16(Bt[n][k], At[m][k], acc[ai][bj][m][n], 0, 0, 0); __builtin_amdgcn_s_setprio(0); } while (0)
#define PG8_WAIT_V(n) asm volatile("s_waitcnt vmcnt(" #n ")" ::: "memory")
#define PG8_WAIT_L(n) asm volatile("s_waitcnt lgkmcnt(" #n ")" ::: "memory")
#define PG8_BAR __builtin_amdgcn_s_barrier()
#define PG8_SCHED __builtin_amdgcn_sched_barrier(0)
#define PG8_AOFF(dst, un, slotp) do { _Pragma("unroll") for (int _i = 0; _i < 2; ++_i) { int _R, _C; stage_rc(tid * 16 + _i * 8192, _R, _C); _Pragma("unroll") for (int _h = 0; _h < 2; ++_h) \
        dst[_h][_i] = (p.arow(un, 128 * _h + _R, slotp) * (unsigned)lda + (unsigned)_C) * 2u; } } while (0)
    Unit cur, nxt; int ui = 0;
    if (!p.next(0, cur)) return;
    LAS unsigned char* const tbl = lds + TBL_OFF;
    if constexpr (P::HAS_TBL) { p.tbl_dma(cur, tbl, wid, lane); asm volatile("s_waitcnt vmcnt(0)" ::: "memory"); }
    __syncthreads();
    AccT acc;
#pragma unroll
    for (int a = 0; a < 2; ++a)
#pragma unroll
        for (int b = 0; b < 2; ++b)
#pragma unroll
            for (int m = 0; m < 4; ++m)
#pragma unroll
                for (int n = 0; n < 2; ++n) acc[a][b][m][n] = (f32x4){0.f, 0.f, 0.f, 0.f};
    bf16x8 At[4][2], B0[2][2], B1[2][2];
    unsigned ao[2][2];
    PG8_AOFF(ao, cur, tbl);
    const char* const Ab = (const char*)p.A;
    const char* cB = (const char*)p.b_base(cur);
    PG8_STAGE(PG8_SB(0, 0), cB, voffB); PG8_STAGE(PG8_SB(0, 1), cB + hstepB, voffB); PG8_STAGE(PG8_SA(0, 0), Ab, ao[0]); PG8_STAGE(PG8_SA(0, 1), Ab, ao[1]);
    if (wr == 1) PG8_BAR;
    PG8_WAIT_V(2); PG8_BAR;
    PG8_STAGE(PG8_SB(1, 0), cB + kstep, voffB); PG8_STAGE(PG8_SA(1, 0), Ab + kstep, ao[0]); PG8_STAGE(PG8_SB(1, 1), cB + hstepB + kstep, voffB);
    PG8_WAIT_V(6); PG8_BAR;
    for (;;) {
        const bool has_next = p.next(ui + 1, nxt);
        const char* nB = has_next ? (const char*)p.b_base(nxt) : cB;
        LAS unsigned char* const nslot = tbl + ((ui + 1) & 1) * 4096;
        for (int t = 0; t < nt; t += 2) {
            const bool last = (t == nt - 2);
            if constexpr (P::HAS_TBL) { if ((t == 2) && has_next && !last) p.tbl_dma(nxt, nslot, wid, lane); }
            const char* a1 = Ab + (size_t)(t + 1) * kstep;
            const char* a2 = last ? Ab : Ab + (size_t)(t + 2) * kstep; const char* b2 = last ? nB : cB + (size_t)(t + 2) * kstep;
            const char* a3 = a2 + kstep; const char* b3 = b2 + kstep;
            PG8_LDB(B0, 0, 0); PG8_LDB(B1, 0, 1); PG8_SCHED; PG8_LDA(At, 0, 0); PG8_STAGE(PG8_SA(1, 1), a1, ao[1]);
            if (last && has_next) { PG8_AOFF(ao, nxt, nslot); }
            PG8_WAIT_V(8); PG8_WAIT_L(0); PG8_BAR; PG8_MMA(0, 0, At, B0); PG8_MMA(0, 1, At, B1); PG8_BAR; PG8_SCHED;
            PG8_LDA(At, 0, 1); PG8_STAGE(PG8_SB(0, 0), b2, voffB); PG8_STAGE(PG8_SB(0, 1), b2 + hstepB, voffB); PG8_STAGE(PG8_SA(0, 0), a2, ao[0]);
            PG8_WAIT_V(8); PG8_WAIT_L(0); PG8_BAR; PG8_MMA(1, 0, At, B0); PG8_MMA(1, 1, At, B1); PG8_BAR; PG8_SCHED;
            PG8_LDB(B0, 1, 0); PG8_LDB(B1, 1, 1); PG8_SCHED; PG8_LDA(At, 1, 0); PG8_STAGE(PG8_SA(0, 1), a2, ao[1]);
            PG8_WAIT_V(8); PG8_WAIT_L(0); PG8_BAR; PG8_MMA(0, 0, At, B0); PG8_MMA(0, 1, At, B1); PG8_BAR; PG8_SCHED;
            PG8_LDA(At, 1, 1); PG8_STAGE(PG8_SB(1, 0), b3, voffB); PG8_STAGE(PG8_SB(1, 1), b3 + hstepB, voffB); PG8_STAGE(PG8_SA(1, 0), a3, ao[0]);
            PG8_WAIT_V(8); PG8_WAIT_L(0); PG8_BAR; PG8_MMA(1, 0, At, B0); PG8_MMA(1, 1, At, B1); PG8_BAR; PG8_SCHED;
        }
        if (wr == 0) PG8_BAR;
        p.epi_fast(acc, cur, wr, wc, fr, fq, tbl + (ui & 1) * 4096, lds + TBL_RED, tid);
        if (!has_next) break;
#pragma unroll
        for (int a = 0; a < 2; ++a)
#pragma unroll
            for (int b = 0; b < 2; ++b)
#pragma unroll
                for (int m = 0; m < 4; ++m)
#pragma unroll
                    for (int n = 0; n < 2; ++n) acc[a][b][m][n] = (f32x4){0.f, 0.f, 0.f, 0.f};
        cur = nxt; cB = nB; ++ui;
        if (wr == 1) PG8_BAR;
    }
    PG8_WAIT_V(0);
    PG8_BAR;
#undef PG8_SA
#undef PG8_SB
#undef PG8_STAGE
#undef PG8_LDA
#undef PG8_LDB
#undef PG8_MMA
#undef PG8_WAIT_V
#undef PG8_WAIT_L
#undef PG8_BAR
#undef PG8_SCHED
#undef PG8_AOFF
}
#ifndef FAST_ROUTER
#define FAST_ROUTER 1
#endif
#ifndef FAST_ATT_A
#define FAST_ATT_A 1
#endif
#ifndef FAST_ATT_C
#define FAST_ATT_C 1
#endif
#ifndef FAST_ATT_B
#define FAST_ATT_B 1
#endif
#ifndef FAST_GEMM
#define FAST_GEMM 1
#endif
template <class P> DEV void gemm_phase(const P& p, LAS unsigned char* lds) {
#if FAST_GEMM
    gemm_phase_fast(p, lds);
#else
    gemm_phase(p, lds);
#endif
}

DEV void cvt_weight(const float* src, bf16_t* dst, int K, int N, int nbatch, int mode, const float* gbase, LAS unsigned char*, int G) {
    const int tid = opaque_tid(), half = tid >> 8, t = tid & 255, l = t & 63, kq = l & 7, n4 = (l >> 3) + 8 * (t >> 6);
    const int tn = N / 128, tpm = (K / 64) * tn, total = tpm * nbatch;
    for (int id = blockIdx.x * 2 + half; id < total; id += G * 2) {
        const int b = id / tpm, rem = id % tpm, k0 = (rem / tn) * 64 + 8 * kq, n = (rem % tn) * 128 + 4 * n4;
        const float* g = nullptr;
        if (mode == 1) g = gbase + (size_t)(3 * b) * D; else if (mode == 2) g = gbase; else if (mode == 3) g = gbase + (size_t)(b / 64) * D; else if (mode == 4) g = gbase + (size_t)b * D;
        float cs = 1.f;
        if (mode == 1) cs = ((n % 3072) < 1024) ? QSCALE : 1.f; else if (mode == 2) cs = (n < 1024) ? QSCALE : 1.f;
        const float* sp = src + (size_t)b * K * N + (size_t)k0 * N + n;
        f32x4 v0 = *(const f32x4*)(sp), v1 = *(const f32x4*)(sp + (size_t)N), v2 = *(const f32x4*)(sp + (size_t)2 * N), v3 = *(const f32x4*)(sp + (size_t)3 * N),
              v4 = *(const f32x4*)(sp + (size_t)4 * N), v5 = *(const f32x4*)(sp + (size_t)5 * N), v6 = *(const f32x4*)(sp + (size_t)6 * N), v7 = *(const f32x4*)(sp + (size_t)7 * N);
        if (g) { const f32x4 ga = *(const f32x4*)(g + k0), gb = *(const f32x4*)(g + k0 + 4); v0 = v0 * (ga[0] * cs); v1 = v1 * (ga[1] * cs); v2 = v2 * (ga[2] * cs); v3 = v3 * (ga[3] * cs); v4 = v4 * (gb[0] * cs); v5 = v5 * (gb[1] * cs); v6 = v6 * (gb[2] * cs); v7 = v7 * (gb[3] * cs); }
        bf16_t* dp = dst + (size_t)b * K * N + k0;
#define CVT_ST(JJ) do { int nn = n + JJ; if (mode == 3) { if (nn < 512) nn = 256 * (nn >> 7) + (nn & 127); else { const int q = nn - 512; nn = 256 * (q >> 7) + 128 + (q & 127); } } \
            u32x4 w; w.x = pk2(v0[JJ], v1[JJ]); w.y = pk2(v2[JJ], v3[JJ]); w.z = pk2(v4[JJ], v5[JJ]); w.w = pk2(v6[JJ], v7[JJ]); *(u32x4*)(dp + (size_t)nn * K) = w; } while (0)
        CVT_ST(0); CVT_ST(1); CVT_ST(2); CVT_ST(3);
#undef CVT_ST
    }
}

DEV void phase_prologue(const Ctx& c, LAS unsigned char* lds) {
    unsigned char* ws = c.ws;
    cvt_weight(c.a_w_in, (bf16_t*)(ws + WS_WAIN), D, NA, 2, 1, c.norm_mix, lds, c.G);
    cvt_weight(c.b_w_in, (bf16_t*)(ws + WS_WBIN), D, NB, 1, 2, c.norm_mix + 1 * D, lds, c.G);
    cvt_weight(c.c_w_in, (bf16_t*)(ws + WS_WCIN), D, NB, 1, 2, c.norm_mix + 2 * D, lds, c.G);
    cvt_weight(c.a_w_out, (bf16_t*)(ws + WS_WAOUT), D, D, 2, 0, nullptr, lds, c.G);
    cvt_weight(c.b_w_out, (bf16_t*)(ws + WS_WBOUT), D, D, 1, 0, nullptr, lds, c.G);
    cvt_weight(c.c_w_out, (bf16_t*)(ws + WS_WCOUT), D, D, 1, 0, nullptr, lds, c.G);
    cvt_weight(c.w_gu, (bf16_t*)(ws + WS_WGU), D, 1024, NE, 3, c.norm_ffn, lds, c.G);
    cvt_weight(c.w_dn, (bf16_t*)(ws + WS_WDN), FE, D, NE, 0, nullptr, lds, c.G);
    cvt_weight(c.w_pg, (bf16_t*)(ws + WS_WPG), D, D, DEPTH, 4, c.norm_ple, lds, c.G);
    cvt_weight(c.w_pp, (bf16_t*)(ws + WS_WPP), PLE, D, DEPTH, 0, nullptr, lds, c.G);
    { float* wr = (float*)(ws + WS_WR);
      for (int i = blockIdx.x * NTHR + threadIdx.x; i < DEPTH * 80 * D; i += c.G * NTHR) { const int k = i & (D - 1), n = (i >> 10) % 80, L = i / (80 * D);
          float v = 0.f; if (n < 8) v = c.w_coarse[((size_t)L * D + k) * 8 + n]; else if (n < 72) v = c.w_fine[((size_t)L * D + k) * 64 + (n - 8)];
          wr[i] = v * c.norm_ffn[L * D + k]; } }
    { const size_t n4 = (size_t)DEPTH * T * PLE / 4; const f32x4* s = (const f32x4*)c.p; uint2* d = (uint2*)(ws + WS_PB);
      for (size_t i = (size_t)blockIdx.x * NTHR + threadIdx.x; i < n4; i += (size_t)c.G * NTHR) { const f32x4 v = s[i]; d[i] = make_uint2(pk2(v.x, v.y), pk2(v.z, v.w)); } }
    { const int tid_ = opaque_tid(); const int w = tid_ >> 6, lane = tid_ & 63; bf16_t* hb = (bf16_t*)(ws + WS_HB); float* ssq = (float*)(ws + WS_SSQ);
      for (int tok = blockIdx.x * NWAVES + w; tok < T; tok += c.G * NWAVES) {
          const f32x4* xr = (const f32x4*)(c.x + (size_t)tok * D) + lane; uint2* o = (uint2*)(hb + (size_t)tok * D) + lane; float s = 0.f;
#pragma unroll
          for (int j = 0; j < 4; ++j) { const f32x4 v = xr[64 * j]; s += (v.x * v.x + v.y * v.y) + (v.z * v.z + v.w * v.w); o[64 * j] = make_uint2(pk2(v.x, v.y), pk2(v.z, v.w)); }
          s = wave_sum(s); if (lane < 4) ssq[(size_t)tok * 4 + lane] = (lane == 0) ? s : 0.f; } }
}

DEV float dot64(const LAS float* q, const bf16_t* k) {
    const uint4* kp = (const uint4*)k; float s = 0.f;
#pragma unroll
    for (int j = 0; j < 8; ++j) { const uint4 v = kp[j]; const LAS float* qq = q + 8 * j;
        s += qq[0] * __uint_as_float(v.x << 16) + qq[1] * __uint_as_float(v.x & 0xffff0000u) + qq[2] * __uint_as_float(v.y << 16) + qq[3] * __uint_as_float(v.y & 0xffff0000u)
           + qq[4] * __uint_as_float(v.z << 16) + qq[5] * __uint_as_float(v.z & 0xffff0000u) + qq[6] * __uint_as_float(v.w << 16) + qq[7] * __uint_as_float(v.w & 0xffff0000u); }
    return s;
}

template <int NL> struct CvtGeo { static constexpr int NT = (NL == 8) ? 32 : 64, PER_LAYER = 64 * 16 * NT + 64 * 8 * NT, KQM = (NL == 8) ? 7 : 15, KQS = (NL == 8) ? 3 : 4; };
struct CvtAddr { const float* sp; bf16_t* dp; const float* g; int N, K, n, perm; };
template <int NL> DEV CvtAddr moe_cvt_addr(const Ctx& c, int L0, int idx, int lane) {
    typedef CvtGeo<NL> G_; CvtAddr a; const int Lc = L0 + idx / G_::PER_LAYER; int t = idx % G_::PER_LAYER; const int kq = lane & G_::KQM, n4 = lane >> G_::KQS;
    if (t < 64 * 16 * G_::NT) { const int e = t / (16 * G_::NT), kt = (t / G_::NT) & 15, nt = t % G_::NT; const int k0 = kt * 64 + NL * kq; a.n = nt * (4 * NL) + 4 * n4; a.N = 1024; a.K = D; a.perm = 1;
        a.sp = c.w_gu + ((size_t)(Lc * NE + e) * D + k0) * 1024 + a.n; a.dp = (bf16_t*)(c.ws + WS_WGU) + (size_t)(Lc * NE + e) * 1024 * D + k0; a.g = c.norm_ffn + Lc * D + k0; }
    else { t -= 64 * 16 * G_::NT; const int e = t / (8 * G_::NT), kt = (t / G_::NT) & 7, nt = t % G_::NT; const int k0 = kt * 64 + NL * kq; a.n = nt * (4 * NL) + 4 * n4; a.N = D; a.K = FE; a.perm = 0;
        a.sp = c.w_dn + ((size_t)(Lc * NE + e) * FE + k0) * D + a.n; a.dp = (bf16_t*)(c.ws + WS_WDN) + (size_t)(Lc * NE + e) * D * FE + k0; a.g = nullptr; }
    return a;
}
template <int NL> DEV void moe_cvt_issue(const Ctx& c, int L0, int idx, int lane, f32x4 (&v)[NL], f32x4 (&gv)[NL / 4]) {
    const CvtAddr a = moe_cvt_addr<NL>(c, L0, idx, lane);
#pragma unroll
    for (int j = 0; j < NL; ++j) v[j] = *(const f32x4*)(a.sp + (size_t)j * a.N);
#pragma unroll
    for (int j = 0; j < NL / 4; ++j) gv[j] = a.g ? *(const f32x4*)(a.g + 4 * j) : (f32x4){1.f, 1.f, 1.f, 1.f};
}
template <int NL> DEV void moe_cvt_finish(const Ctx& c, int L0, int idx, int lane, const f32x4 (&v)[NL], const f32x4 (&gv)[NL / 4]) {
    const CvtAddr a = moe_cvt_addr<NL>(c, L0, idx, lane);
#pragma unroll
    for (int jj = 0; jj < 4; ++jj) { int nn = a.n + jj;
        if (a.perm) { if (nn < 512) nn = 256 * (nn >> 7) + (nn & 127); else { const int q = nn - 512; nn = 256 * (q >> 7) + 128 + (q & 127); } }
        unsigned w[NL / 2];
#pragma unroll
        for (int j = 0; j < NL / 2; ++j) w[j] = cvt_pk_bf16(v[2 * j][jj] * gv[(2 * j) >> 2][(2 * j) & 3], v[2 * j + 1][jj] * gv[(2 * j + 1) >> 2][(2 * j + 1) & 3]);
        if constexpr (NL == 8) { u32x4 ww; ww.x = w[0]; ww.y = w[1]; ww.z = w[2]; ww.w = w[3]; *(u32x4*)(a.dp + (size_t)nn * a.K) = ww; }
        else { u32x2 ww; ww.x = w[0]; ww.y = w[1]; *(u32x2*)(a.dp + (size_t)nn * a.K) = ww; } }
}
struct CvtHost { int nxt, pend, step, total, L0; };
#define CVT_TICK(NL, H, c, lane, v, gv) do { if ((H).pend >= 0) { moe_cvt_finish<NL>(c, (H).L0, (H).pend, lane, v, gv); (H).pend = -1; } \
        if ((H).nxt < (H).total) { moe_cvt_issue<NL>(c, (H).L0, (H).nxt, lane, v, gv); (H).pend = (H).nxt; (H).nxt += (H).step; } } while (0)
#define CVT_DRAIN(NL, H, c, lane, v, gv) do { while ((H).pend >= 0 || (H).nxt < (H).total) { asm volatile("s_waitcnt vmcnt(0)" ::: "memory"); CVT_TICK(NL, H, c, lane, v, gv); } } while (0)

typedef short s16x4 __attribute__((ext_vector_type(4)));
typedef short v4i16_t __attribute__((ext_vector_type(4)));
DEV s16x4 vtr(const LAS unsigned char* p) { return __builtin_bit_cast(s16x4, __builtin_amdgcn_ds_read_tr16_b64_v4i16((LAS v4i16_t*)p)); }
DEV void glds16(const void* g, LAS unsigned char* l) { __builtin_amdgcn_global_load_lds((const unsigned*)g, (LAS unsigned*)l, 16, 0, 0); }
DEV float xhalf_max(float v) { auto rr = __builtin_amdgcn_permlane32_swap(__float_as_uint(v), __float_as_uint(v), false, false); return fmaxf(__uint_as_float(rr[0]), __uint_as_float(rr[1])); }
DEV float xhalf_sum(float v) { auto rr = __builtin_amdgcn_permlane32_swap(__float_as_uint(v), __float_as_uint(v), false, false); return __uint_as_float(rr[0]) + __uint_as_float(rr[1]); }
DEV bf16x8 pack8(const f32x16& p, int s8) {
    u32x4 w; w.x = cvt_pk_bf16(p[s8], p[s8 + 1]); w.y = cvt_pk_bf16(p[s8 + 2], p[s8 + 3]); w.z = cvt_pk_bf16(p[s8 + 4], p[s8 + 5]); w.w = cvt_pk_bf16(p[s8 + 6], p[s8 + 7]);
    return __builtin_bit_cast(bf16x8, w);
}
#define ATT_WAITV(n) asm volatile("s_waitcnt vmcnt(" #n ")" ::: "memory")
#define ATT_BAR() asm volatile("s_waitcnt lgkmcnt(0)\n\ts_barrier" ::: "memory")
#define MFMA32(a, b, c) __builtin_amdgcn_mfma_f32_32x32x16_bf16((a), (b), (c), 0, 0, 0)

DEV void attB_stage(const bf16_t* kvb, int t, LAS unsigned char* buf, int wid, int lane) {
    if (wid < 4) { const int cc = wid >> 1;
#pragma unroll
        for (int j = 0; j < 4; ++j) { const int kk = (wid & 1) * 4 + j, row = 8 * kk + (lane >> 3), ch = (lane & 7) ^ ((row >> 1) & 7);
            glds16(kvb + hm(16 + cc, 64 * t + row) + ch * 8, buf + cc * 8192 + kk * 1024); }
    } else {
#pragma unroll
        for (int j = 0; j < 4; ++j) { const int kk = (wid - 4) * 4 + j, row = 4 * kk + (lane >> 4), ch = (lane & 15) ^ ((row & 3) << 2);
            glds16(kvb + hm(32 + (ch >> 3), 64 * t + row) + (ch & 7) * 8, buf + 16384 + kk * 1024); }
    }
}
DEV void attB_kmax(const Ctx& c) {
    const int tid_ = opaque_tid(); const int w = tid_ >> 6, lane = tid_ & 63;
    const bf16_t* qkv = (const bf16_t*)(c.ws + WS_QKV); float* km = (float*)(c.ws + WS_KMAX);
    for (int it = blockIdx.x * NWAVES + w; it < 8 * 8 * 2 * 64; it += c.G * NWAVES) {
        const int t = it & 63, cc = (it >> 6) & 1, h = (it >> 7) & 7, b = it >> 10;
        const uint4* kp = (const uint4*)(qkv + hm(16 + 2 * h + cc, b * SEQ + 64 * t + lane)); float s = 0.f;
#pragma unroll
        for (int j = 0; j < 8; ++j) { const uint4 v = kp[j]; const unsigned ws_[4] = {v.x, v.y, v.z, v.w};
#pragma unroll
            for (int k = 0; k < 4; ++k) { const float a = bf2f(ws_[k] & 0xffffu), bq = bf2f(ws_[k] >> 16); s += a * a + bq * bq; } }
        s = wave_max(s);
        if (lane == 0) km[it] = sqrtf(s) * 1.01f;
    }
}
DEV void attB_fast(const Ctx& c, float lam, float lambda_init, const float* subln, LAS unsigned char* lds) {
    const int tid = opaque_tid(), wid = __builtin_amdgcn_readfirstlane(tid >> 6), lane = tid & 63, r = lane & 31, hh = lane >> 5;
    const int qt = wid & 3, cc = wid >> 2;
    const bf16_t* qkv = (const bf16_t*)(c.ws + WS_QKV); bf16_t* o = (bf16_t*)(c.ws + WS_O);
    const int vcu = (c.G % 8 == 0) ? ((int)blockIdx.x % 8) * (c.G / 8) + (int)blockIdx.x / 8 : (int)blockIdx.x;
    int koff[4], voff[4];
#pragma unroll
    for (int ds = 0; ds < 4; ++ds) koff[ds] = r * 128 + (((2 * ds + hh) ^ ((r >> 1) & 7)) << 4);
    { const int i16 = lane & 15, qp = i16 >> 2, pp = i16 & 3, blk = (lane >> 4) & 1;
#pragma unroll
      for (int db = 0; db < 4; ++db) voff[db] = (4 * hh + qp) * 256 + 8 * (pp & 1) + ((((db ^ qp) << 2) + 2 * blk + (pp >> 1)) << 4); }
    CvtHost H; H.L0 = 1; H.total = 2 * CvtGeo<4>::PER_LAYER; H.step = c.G * NWAVES; H.nxt = (int)blockIdx.x * NWAVES + wid; H.pend = -1; f32x4 cv[4], cg[1];
    LAS unsigned* flags = (LAS unsigned*)(lds + TBL_RED);
    const float* kmaxp = (const float*)(c.ws + WS_KMAX);
    for (int pu = vcu; pu < 1024; pu += c.G) {
        const int iu = pu / c.G, g16 = (vcu >> 4) & 15, s = vcu & 15, b = g16 >> 1;
        const int h = (g16 & 1) ? ((iu == 0) ? 6 : (iu == 1) ? 1 : (iu == 2) ? 2 : 5) : ((iu == 0) ? 7 : (iu == 1) ? 0 : (iu == 2) ? 3 : 4);
        float kms = kmaxp[((b * 8 + h) * 2 + cc) * 64 + lane];
#pragma unroll
        for (int d = 1; d < 64; d <<= 1) { const float v = __shfl_up(kms, d); if (lane >= d) kms = fmaxf(kms, v); }
        const float slope2 = exp2f(-(float)(h + 1)) * LOG2E;
        f32x16 Bt;
#pragma unroll
        for (int i = 0; i < 16; ++i) Bt[i] = slope2 * (float)(crow(i, hh) - r);
        const bf16_t* kvb = qkv + hm(2 * h, b * SEQ);
        for (int half = 0; half < 2; ++half) {
            const int qb = half ? 31 - s : s, Q0 = qb * 128, Tn = 2 * qb + 2, qrow0 = Q0 + 32 * qt;
            attB_stage(kvb, Tn - 1, lds, wid, lane);
            ATT_BAR();
            float qn = 0.f;
            LAS unsigned char* const qlds = lds + 98304 + wid * 4096 + lane * 16;
            { const bf16_t* qp_ = kvb + hm(cc, qrow0 + r) + 8 * hh;
#pragma unroll
              for (int ds = 0; ds < 4; ++ds) { const bf16x8 qv = *(const bf16x8*)(qp_ + 16 * ds); *(LAS bf16x8*)(qlds + ds * 1024) = qv;
#pragma unroll
                  for (int j = 0; j < 8; ++j) { const float v = bf2f((unsigned)(unsigned short)qv[j]); qn += v * v; } } }
            attB_stage(kvb, Tn - 2, lds + 32768, wid, lane);
            qn = sqrtf(xhalf_sum(qn)) * 1.01f;
            if (lane == 0) { flags[wid] = 1u; flags[8 + wid] = 1u; }
            int par = 0;
            f32x16 O[4];
#pragma unroll
            for (int db = 0; db < 4; ++db)
#pragma unroll
                for (int i = 0; i < 16; ++i) O[db][i] = 0.f;
            float m = -1e30f, l = 0.f; int bi = 0;
            for (int t = Tn - 1; t >= 0; --t) {
                ATT_WAITV(0);
                ATT_BAR();
                { unsigned al = 0u;
#pragma unroll
                  for (int k = 0; k < 8; ++k) al |= flags[par * 8 + k];
                  if (__builtin_amdgcn_readfirstlane(al) == 0u) break; }
                CVT_TICK(4, H, c, lane, cv, cg);
                if (t >= 2) attB_stage(kvb, t - 2, lds + ((bi + 2) % 3) * 32768, wid, lane);
                if (64 * t <= qrow0) {
                    const LAS unsigned char* Kb = lds + bi * 32768 + cc * 8192; const LAS unsigned char* Vb = lds + bi * 32768 + 16384;
                    f32x16 p0 = Bt, p1 = Bt;
#pragma unroll
                    for (int ds = 0; ds < 4; ++ds) { const bf16x8 k0 = *(const LAS bf16x8*)(Kb + koff[ds]), k1 = *(const LAS bf16x8*)(Kb + 4096 + koff[ds]), qv = *(const LAS bf16x8*)(qlds + ds * 1024); p0 = MFMA32(k0, qv, p0); p1 = MFMA32(k1, qv, p1); }
                    const float off0 = slope2 * (float)(64 * t - qrow0), off1 = off0 + 32.f * slope2;
                    if (64 * t + 63 > qrow0) {
#pragma unroll
                        for (int i = 0; i < 16; ++i) { const int key = 64 * t + crow(i, hh); if (key > qrow0 + r) p0[i] = -INFINITY; if (key + 32 > qrow0 + r) p1[i] = -INFINITY; } }
                    float mx0 = p0[0], mx1 = p1[0];
#pragma unroll
                    for (int i = 1; i < 16; ++i) { mx0 = fmaxf(mx0, p0[i]); mx1 = fmaxf(mx1, p1[i]); }
                    const float mx = xhalf_max(fmaxf(mx0 + off0, mx1 + off1));
                    if (__any(mx > m + 8.f)) { const float mn = fmaxf(m, mx), f = __builtin_amdgcn_exp2f(m - mn); l *= f; m = mn;
#pragma unroll
                        for (int db = 0; db < 4; ++db)
#pragma unroll
                            for (int i = 0; i < 16; ++i) O[db][i] *= f; }
                    const float e0 = off0 - m, e1 = off1 - m; float ls = 0.f;
#pragma unroll
                    for (int i = 0; i < 16; ++i) { p0[i] = __builtin_amdgcn_exp2f(p0[i] + e0); p1[i] = __builtin_amdgcn_exp2f(p1[i] + e1); ls += p0[i] + p1[i]; }
                    l += ls;
                    bf16x8 pa[4]; pa[0] = pack8(p0, 0); pa[1] = pack8(p0, 8); pa[2] = pack8(p1, 0); pa[3] = pack8(p1, 8);
#pragma unroll
                    for (int db = 0; db < 4; ++db) { const unsigned va = (unsigned)(uintptr_t)(Vb + voff[db]); s16x4 lo[4], hi[4];
#pragma unroll
                        for (int ks = 0; ks < 4; ++ks) { asm volatile("ds_read_b64_tr_b16 %0, %1 offset:%c2" : "=&v"(lo[ks]) : "v"(va), "i"(ks * 4096) : "memory");
                                                         asm volatile("ds_read_b64_tr_b16 %0, %1 offset:%c2" : "=&v"(hi[ks]) : "v"(va), "i"(ks * 4096 + 2048) : "memory"); }
                        asm volatile("s_waitcnt lgkmcnt(0)" ::: "memory"); __builtin_amdgcn_sched_barrier(0);
#pragma unroll
                        for (int ks = 0; ks < 4; ++ks) { const bf16x8 vf = (bf16x8){lo[ks][0], lo[ks][1], lo[ks][2], lo[ks][3], hi[ks][0], hi[ks][1], hi[ks][2], hi[ks][3]}; O[db] = MFMA32(vf, pa[ks], O[db]); } }
                }
                bi = (bi + 1) % 3; par ^= 1;
                if (t >= 1) { const float kb = __builtin_amdgcn_readlane(kms, t - 1);
                    const float ub = qn * kb + slope2 * (float)(64 * (t - 1) + 63 - (qrow0 + r)) - m;
                    const bool alive = __any(ub > -50.f); if (lane == 0) flags[par * 8 + wid] = alive ? 1u : 0u; }
            }
            ATT_WAITV(0);
            l = xhalf_sum(l);
            ATT_BAR();
            LAS float* X = (LAS float*)(lds + 65536) + qt * 4096;
            if (cc == 1) { const float sc = lam / l;
#pragma unroll
                for (int db = 0; db < 4; ++db)
#pragma unroll
                    for (int i = 0; i < 16; ++i) X[(db * 16 + i) * 64 + lane] = O[db][i] * sc; }
            ATT_BAR();
            if (cc == 0) { const float inv = 1.f / l; float ss = 0.f;
#pragma unroll
                for (int db = 0; db < 4; ++db)
#pragma unroll
                    for (int i = 0; i < 16; ++i) { const float v = O[db][i] * inv - X[(db * 16 + i) * 64 + lane]; O[db][i] = v; ss += v * v; }
                ss = xhalf_sum(ss); const float rs = rsqrtf(ss * (1.f / 128.f) + EPS) * (1.f - lambda_init);
                bf16_t* op = o + (size_t)(b * SEQ + qrow0 + r) * D + h * 128 + 4 * hh;
#pragma unroll
                for (int db = 0; db < 4; ++db)
#pragma unroll
                    for (int g = 0; g < 4; ++g) { const int d = 32 * db + 8 * g; const f32x4 sl = *(const f32x4*)(subln + d + 4 * hh);
                        u32x2 w; w.x = cvt_pk_bf16(O[db][4 * g] * rs * sl[0], O[db][4 * g + 1] * rs * sl[1]); w.y = cvt_pk_bf16(O[db][4 * g + 2] * rs * sl[2], O[db][4 * g + 3] * rs * sl[3]);
                        *(u32x2*)(op + d) = w; } }
        }
    }
    CVT_DRAIN(4, H, c, lane, cv, cg);
    ATT_WAITV(0);
    ATT_BAR();
}

DEV void attC_stage(const bf16_t* kvb, int t, LAS unsigned char* buf, int wid, int lane) {
    const int row = 8 * wid + (lane >> 3);
    glds16(kvb + hm(16, 64 * t + row) + (((lane & 7) ^ ((row >> 1) & 7)) << 3), buf + wid * 1024);
    glds16(kvb + hm(32, 64 * t + row) + (((lane & 7) ^ (((row >> 1) & 1) << 2)) << 3), buf + 8192 + wid * 1024);
}
DEV float sb_scan(const f32x16& w, f32x16& a, float Rin, int hh) {
    float ex[16], gp[4], gq[4];
#pragma unroll
    for (int g = 0; g < 4; ++g) { const float t23 = w[4 * g + 2] * w[4 * g + 3], s0 = w[4 * g + 1] * t23; gp[g] = w[4 * g] * s0; ex[4 * g] = s0; ex[4 * g + 1] = t23; ex[4 * g + 2] = w[4 * g + 3]; ex[4 * g + 3] = 1.f; }
    float pp[4];
#pragma unroll
    for (int g = 0; g < 4; ++g) { auto rr = __builtin_amdgcn_permlane32_swap(__float_as_uint(gp[g]), __float_as_uint(gp[g]), false, false);
        const float lo = __uint_as_float(rr[0]), hi = __uint_as_float(rr[1]); pp[g] = lo * hi; gq[g] = hh ? 1.f : hi; }
    float Q[4]; Q[3] = 1.f; Q[2] = pp[3]; Q[1] = pp[2] * Q[2]; Q[0] = pp[1] * Q[1];
    const float tot = pp[0] * Q[0];
#pragma unroll
    for (int g = 0; g < 4; ++g) { const float base = Rin * Q[g] * gq[g];
#pragma unroll
        for (int j = 0; j < 4; ++j) a[4 * g + j] = a[4 * g + j] * (base * ex[4 * g + j]); }
    return tot;
}
DEV void attC_fast(const Ctx& c, LAS unsigned char* lds) {
    const int tid = opaque_tid(), wid = __builtin_amdgcn_readfirstlane(tid >> 6), lane = tid & 63, r = lane & 31, hh = lane >> 5;
    const bf16_t* qkv = (const bf16_t*)(c.ws + WS_QKV); bf16_t* o = (bf16_t*)(c.ws + WS_O);
    const int vcu = (c.G % 8 == 0) ? ((int)blockIdx.x % 8) * (c.G / 8) + (int)blockIdx.x / 8 : (int)blockIdx.x;
    CvtHost H; H.L0 = 3; H.total = CvtGeo<8>::PER_LAYER; H.step = c.G * NWAVES; H.nxt = (int)blockIdx.x * NWAVES + wid; H.pend = -1; f32x4 cv[8], cg[2];
    LAS unsigned* flags = (LAS unsigned*)(lds + 49152);
    int koff[4], voff[2];
#pragma unroll
    for (int ds = 0; ds < 4; ++ds) koff[ds] = r * 128 + (((2 * ds + hh) ^ ((r >> 1) & 7)) << 4);
    { const int i16 = lane & 15, qp = i16 >> 2, pp = i16 & 3, blk = (lane >> 4) & 1;
#pragma unroll
      for (int db = 0; db < 2; ++db) voff[db] = (4 * hh + qp) * 128 + 8 * (pp & 1) + (((4 * (db ^ (qp >> 1))) + 2 * blk + (pp >> 1)) << 4); }
    for (int un = vcu; un < 2048; un += c.G) {
        const int bh = un >> 4, qb = un & 15, b = bh >> 4, h = bh & 15;
        const bf16_t* kvb = qkv + hm(h, b * SEQ);
        const int Q0 = qb * 256, qrow0 = Q0 + 32 * wid, T1 = Q0 / 64 + 3;
        attC_stage(kvb, T1, lds, wid, lane);
        bf16x8 qf[4];
        { const bf16_t* qp_ = kvb + hm(0, qrow0 + r) + 8 * hh;
#pragma unroll
          for (int ds = 0; ds < 4; ++ds) qf[ds] = *(const bf16x8*)(qp_ + 16 * ds); }
        attC_stage(kvb, T1 - 1, lds + 16384, wid, lane);
        f32x16 O[2];
#pragma unroll
        for (int db = 0; db < 2; ++db)
#pragma unroll
            for (int i = 0; i < 16; ++i) O[db][i] = 0.f;
        float R = 1.f; int bi = 0, par = 0;
        if (lane == 0) { flags[wid] = 1u; flags[8 + wid] = 1u; }
        for (int t = T1; t >= 0; --t) {
            ATT_WAITV(0);
            ATT_BAR();
            { unsigned al = 0u;
#pragma unroll
              for (int k = 0; k < 8; ++k) al |= flags[par * 8 + k];
              if (__builtin_amdgcn_readfirstlane(al) == 0u) break; }
            CVT_TICK(8, H, c, lane, cv, cg);
            if (t >= 2) attC_stage(kvb, t - 2, lds + ((bi + 2) % 3) * 16384, wid, lane);
            if (64 * t < qrow0 + 31) {
                const LAS unsigned char* Kb = lds + bi * 16384; const LAS unsigned char* Vb = Kb + 8192;
                f32x16 p0, p1;
#pragma unroll
                for (int i = 0; i < 16; ++i) { p0[i] = 0.f; p1[i] = 0.f; }
#pragma unroll
                for (int ds = 0; ds < 4; ++ds) { const bf16x8 k0 = *(const LAS bf16x8*)(Kb + koff[ds]), k1 = *(const LAS bf16x8*)(Kb + 4096 + koff[ds]); p0 = MFMA32(k0, qf[ds], p0); p1 = MFMA32(k1, qf[ds], p1); }
                const bool diag = 64 * t + 63 >= qrow0;
                f32x16 w0, w1;
#pragma unroll
                for (int i = 0; i < 16; ++i) {
                    const float E0 = __builtin_amdgcn_exp2f(fminf(p0[i], 60.f)), E1 = __builtin_amdgcn_exp2f(fminf(p1[i], 60.f));
                    float v0 = __builtin_amdgcn_rcpf(1.f + E0), v1 = __builtin_amdgcn_rcpf(1.f + E1); float b0 = E0 * v0, b1 = E1 * v1;
                    if (diag) { const int key = 64 * t + crow(i, hh); if (key >= qrow0 + r) { v0 = 1.f; b0 = 0.f; } if (key + 32 >= qrow0 + r) { v1 = 1.f; b1 = 0.f; } }
                    w0[i] = v0; w1[i] = v1; p0[i] = b0; p1[i] = b1; }
                const float tot1 = sb_scan(w1, p1, R, hh);
                const float R1 = R * tot1;
                const float tot0 = sb_scan(w0, p0, R1, hh);
                R = R1 * tot0;
                bf16x8 pa[4]; pa[0] = pack8(p0, 0); pa[1] = pack8(p0, 8); pa[2] = pack8(p1, 0); pa[3] = pack8(p1, 8);
#pragma unroll
                for (int db = 0; db < 2; ++db) { const unsigned va = (unsigned)(uintptr_t)(Vb + voff[db]); s16x4 lo[4], hi[4];
#pragma unroll
                    for (int ks = 0; ks < 4; ++ks) { asm volatile("ds_read_b64_tr_b16 %0, %1 offset:%c2" : "=&v"(lo[ks]) : "v"(va), "i"(ks * 2048) : "memory");
                                                     asm volatile("ds_read_b64_tr_b16 %0, %1 offset:%c2" : "=&v"(hi[ks]) : "v"(va), "i"(ks * 2048 + 1024) : "memory"); }
                    asm volatile("s_waitcnt lgkmcnt(0)" ::: "memory"); __builtin_amdgcn_sched_barrier(0);
#pragma unroll
                    for (int ks = 0; ks < 4; ++ks) { const bf16x8 vf = (bf16x8){lo[ks][0], lo[ks][1], lo[ks][2], lo[ks][3], hi[ks][0], hi[ks][1], hi[ks][2], hi[ks][3]}; O[db] = MFMA32(vf, pa[ks], O[db]); } }
            }
            par ^= 1;
            { const bool alive = __any(R > 8.6736174e-19f); if (lane == 0) flags[par * 8 + wid] = alive ? 1u : 0u; }
            bi = (bi + 1) % 3;
        }
        ATT_WAITV(0);
        bf16_t* op = o + (size_t)(b * SEQ + qrow0 + r) * D + h * 64 + 4 * hh;
#pragma unroll
        for (int db = 0; db < 2; ++db)
#pragma unroll
            for (int g = 0; g < 4; ++g) { u32x2 wv; wv.x = cvt_pk_bf16(O[db][4 * g], O[db][4 * g + 1]); wv.y = cvt_pk_bf16(O[db][4 * g + 2], O[db][4 * g + 3]); *(u32x2*)(op + 32 * db + 8 * g) = wv; }
        ATT_BAR();
    }
    CVT_DRAIN(8, H, c, lane, cv, cg);
    ATT_WAITV(0);
}

struct AUnit { int b, h, g, cres, rr, i0; };
DEV AUnit attA_unit(int un, int g) {
    AUnit u; const int bh = un >> 4, j = un & 15; u.b = bh >> 4; u.h = bh & 15; u.g = g;
    int m; if (g == 0) { u.cres = 0; m = j; } else if (g == 1) { u.cres = j >> 2; m = j & 3; } else { u.cres = j; m = 0; }
    u.rr = (g == 0) ? 1 : (g == 1 ? 4 : 16); u.i0 = m * 256; return u;
}
DEV void attA_fast(const Ctx& c, int grp, LAS unsigned char* lds) {
    const int tid = opaque_tid(), wid = __builtin_amdgcn_readfirstlane(tid >> 6), lane = tid & 63, r = lane & 31, hh = lane >> 5;
    const bf16_t* qkv = (const bf16_t*)(c.ws + WS_QKV); bf16_t* og = (bf16_t*)(c.ws + WS_OG); float* lse = (float*)(c.ws + WS_LSE);
    const int vcu = (c.G % 8 == 0) ? ((int)blockIdx.x % 8) * (c.G / 8) + (int)blockIdx.x / 8 : (int)blockIdx.x;
    int koff[4], voff[2];
#pragma unroll
    for (int ds = 0; ds < 4; ++ds) koff[ds] = r * 128 + (((2 * ds + hh) ^ ((r >> 1) & 7)) << 4);
    { const int i16 = lane & 15, qp = i16 >> 2, pp = i16 & 3, blk = (lane >> 4) & 1;
#pragma unroll
      for (int db = 0; db < 2; ++db) voff[db] = (4 * hh + qp) * 128 + 8 * (pp & 1) + (((4 * (db ^ (qp >> 1))) + 2 * blk + (pp >> 1)) << 4); }
    LAS unsigned char* const Kb = lds; LAS unsigned char* const Vb = lds + 49152;
    LAS unsigned char* const Qw = lds + 98304 + wid * 4096;
#define ATTA_LOAD_KQ(U) do { const bf16_t* base_ = qkv + hm((U).h, (U).b * SEQ); \
        _Pragma("unroll") for (int k = 0; k < 6; ++k) { const int row = 8 * (6 * wid + k) + (lane >> 3); int ik = (U).i0 - 128 + row; ik = ik < 0 ? 0 : ik; \
            glds16(base_ + hm(16, ik * (U).rr + (U).cres) + (((lane & 7) ^ ((row >> 1) & 7)) << 3), Kb + (6 * wid + k) * 1024); } \
        } while (0)
#define ATTA_LOAD_Q(U) do { const bf16_t* qp_ = qkv + hm((U).h, (U).b * SEQ) + hm(0, ((U).i0 + 32 * wid + r) * (U).rr + (U).cres) + 8 * hh; \
        _Pragma("unroll") for (int ds = 0; ds < 4; ++ds) glds16(qp_ + 16 * ds, Qw + ds * 1024); } while (0)
    int un = vcu;
    AUnit u = attA_unit(un < 2048 ? un : 0, grp);
    if (un < 2048) { ATTA_LOAD_KQ(u); ATTA_LOAD_Q(u); }
    for (; un < 2048; un += c.G) {
        const int unn = un + c.G; const AUnit nu = attA_unit(unn < 2048 ? unn : 0, grp);
        const bf16_t* base = qkv + hm(u.h, u.b * SEQ);
        ATT_WAITV(0);
        ATT_BAR();
#pragma unroll
        for (int k = 0; k < 6; ++k) { const int row = 8 * (6 * wid + k) + (lane >> 3); int ik = u.i0 - 128 + row; ik = ik < 0 ? 0 : ik;
            glds16(base + hm(32, ik * u.rr + u.cres) + (((lane & 7) ^ (((row >> 1) & 1) << 2)) << 3), Vb + (6 * wid + k) * 1024); }
        const int tokq = u.b * SEQ + (u.i0 + 32 * wid + r) * u.rr + u.cres;
        const float sr = exp2f(-0.5f * (float)(u.h + 1)) * LOG2E * (float)u.rr;
        f32x16 S[5];
#pragma unroll
        for (int sidx = 0; sidx < 5; ++sidx) {
#pragma unroll
            for (int i = 0; i < 16; ++i) S[sidx][i] = sr * (float)(crow(i, hh) - r + 32 * sidx - 128);
            if (u.i0 + 32 * wid - 128 + 32 * sidx >= 0) {
                const LAS unsigned char* kb = Kb + (32 * (wid + sidx)) * 128;
#pragma unroll
                for (int ds = 0; ds < 4; ++ds) { const bf16x8 kf = *(const LAS bf16x8*)(kb + koff[ds]), qv = *(const LAS bf16x8*)(Qw + ds * 1024 + lane * 16); S[sidx] = MFMA32(kf, qv, S[sidx]); }
                if (sidx == 0) {
#pragma unroll
                    for (int i = 0; i < 16; ++i) if (crow(i, hh) < r) S[sidx][i] = -INFINITY; }
                if (sidx == 4) {
#pragma unroll
                    for (int i = 0; i < 16; ++i) if (crow(i, hh) > r) S[sidx][i] = -INFINITY; }
            } else {
#pragma unroll
                for (int i = 0; i < 16; ++i) S[sidx][i] = -INFINITY; }
        }
        float mx = S[0][0];
#pragma unroll
        for (int sidx = 0; sidx < 5; ++sidx)
#pragma unroll
            for (int i = 0; i < 16; ++i) mx = fmaxf(mx, S[sidx][i]);
        mx = xhalf_max(mx);
        float l = 0.f; bf16x8 pa[5][2];
#pragma unroll
        for (int sidx = 0; sidx < 5; ++sidx) {
#pragma unroll
            for (int i = 0; i < 16; ++i) { S[sidx][i] = __builtin_amdgcn_exp2f(S[sidx][i] - mx); l += S[sidx][i]; }
            pa[sidx][0] = pack8(S[sidx], 0); pa[sidx][1] = pack8(S[sidx], 8); }
        l = xhalf_sum(l);
        ATT_WAITV(0);
        ATT_BAR();
        if (unn < 2048) ATTA_LOAD_KQ(nu);
        f32x16 O[2];
#pragma unroll
        for (int db = 0; db < 2; ++db)
#pragma unroll
            for (int i = 0; i < 16; ++i) O[db][i] = 0.f;
#pragma unroll
        for (int sidx = 0; sidx < 5; ++sidx) {
            if (u.i0 + 32 * wid - 128 + 32 * sidx >= 0) {
#pragma unroll
                for (int db = 0; db < 2; ++db) { const unsigned va = (unsigned)(uintptr_t)(Vb + (32 * (wid + sidx)) * 128 + voff[db]); s16x4 lo[2], hi[2];
#pragma unroll
                    for (int ks = 0; ks < 2; ++ks) { asm volatile("ds_read_b64_tr_b16 %0, %1 offset:%c2" : "=&v"(lo[ks]) : "v"(va), "i"(ks * 2048) : "memory");
                                                     asm volatile("ds_read_b64_tr_b16 %0, %1 offset:%c2" : "=&v"(hi[ks]) : "v"(va), "i"(ks * 2048 + 1024) : "memory"); }
                    asm volatile("s_waitcnt lgkmcnt(0)" ::: "memory"); __builtin_amdgcn_sched_barrier(0);
#pragma unroll
                    for (int ks = 0; ks < 2; ++ks) { const bf16x8 vf = (bf16x8){lo[ks][0], lo[ks][1], lo[ks][2], lo[ks][3], hi[ks][0], hi[ks][1], hi[ks][2], hi[ks][3]}; O[db] = MFMA32(vf, pa[sidx][ks], O[db]); } }
            }
        }
        const float inv = 1.f / l;
#pragma unroll
        for (int db = 0; db < 2; ++db)
#pragma unroll
            for (int q4 = 0; q4 < 4; ++q4) { u32x2 wv; wv.x = cvt_pk_bf16(O[db][4 * q4] * inv, O[db][4 * q4 + 1] * inv); wv.y = cvt_pk_bf16(O[db][4 * q4 + 2] * inv, O[db][4 * q4 + 3] * inv);
                *(LAS u32x2*)(Qw + r * 128 + (((4 * db + q4) ^ (r & 7)) << 4) + 8 * hh) = wv; }
        asm volatile("s_waitcnt lgkmcnt(0)" ::: "memory");
#pragma unroll
        for (int ps = 0; ps < 4; ++ps) { const int row = (lane >> 3) + 8 * ps; const u32x4 vv = *(const LAS u32x4*)(Qw + row * 128 + (((lane & 7) ^ (row & 7)) << 4));
            const int tk = u.b * SEQ + (u.i0 + 32 * wid + row) * u.rr + u.cres; *(u32x4*)(og + (size_t)u.g * T * D + (size_t)tk * D + u.h * 64 + (lane & 7) * 8) = vv; }
        asm volatile("s_waitcnt lgkmcnt(0)" ::: "memory");
        if (unn < 2048) ATTA_LOAD_Q(nu);
        if (hh == 0) lse[(size_t)u.g * T * 16 + (size_t)tokq * 16 + u.h] = mx + __builtin_amdgcn_logf(l);
        u = nu;
    }
#undef ATTA_LOAD_KQ
#undef ATTA_LOAD_Q
    ATT_WAITV(0);
    ATT_BAR();
}
DEV void attA_merge(const Ctx& c) {
    const int tid_ = opaque_tid(); const int w = tid_ >> 6, lane = tid_ & 63;
    const bf16_t* og = (const bf16_t*)(c.ws + WS_OG); const float* lse = (const float*)(c.ws + WS_LSE); bf16_t* o = (bf16_t*)(c.ws + WS_O);
    for (int tok = blockIdx.x * NWAVES + w; tok < T; tok += c.G * NWAVES) {
        const int hd = lane >> 2;
        const float l0 = lse[(size_t)tok * 16 + hd], l1 = lse[(size_t)T * 16 + (size_t)tok * 16 + hd], l2 = lse[(size_t)2 * T * 16 + (size_t)tok * 16 + hd];
        const float mx = fmaxf(l0, fmaxf(l1, l2)); const float e0 = exp2f(l0 - mx), e1 = exp2f(l1 - mx), e2 = exp2f(l2 - mx); const float inv = 1.f / (e0 + e1 + e2);
        const float w0 = e0 * inv, w1 = e1 * inv, w2 = e2 * inv;
        const uint4* a0 = (const uint4*)(og + (size_t)tok * D + lane * 16); const uint4* a1 = (const uint4*)(og + (size_t)T * D + (size_t)tok * D + lane * 16); const uint4* a2 = (const uint4*)(og + (size_t)2 * T * D + (size_t)tok * D + lane * 16);
        uint4* od = (uint4*)(o + (size_t)tok * D + lane * 16);
#pragma unroll
        for (int hlf = 0; hlf < 2; ++hlf) { const uint4 x = a0[hlf], y = a1[hlf], z = a2[hlf]; uint4 res;
            const unsigned xs[4] = {x.x, x.y, x.z, x.w}, ys[4] = {y.x, y.y, y.z, y.w}, zs[4] = {z.x, z.y, z.z, z.w}; unsigned rs_[4];
#pragma unroll
            for (int k = 0; k < 4; ++k) { const float lo = w0 * bf2f(xs[k] & 0xffffu) + w1 * bf2f(ys[k] & 0xffffu) + w2 * bf2f(zs[k] & 0xffffu), hi = w0 * bf2f(xs[k] >> 16) + w1 * bf2f(ys[k] >> 16) + w2 * bf2f(zs[k] >> 16); rs_[k] = pk2(lo, hi); }
            res.x = rs_[0]; res.y = rs_[1]; res.z = rs_[2]; res.w = rs_[3]; od[hlf] = res; }
    }
}

template <int L> DEV void phase_router(const Ctx& c, LAS unsigned char* lds) {
    const int tid_ = opaque_tid(); const int w = tid_ >> 6, lane = tid_ & 63;
    LAS float* xs = (LAS float*)lds + w * 4096;
    LAS float* lg = (LAS float*)(lds + 131072) + w * 320;
    const float* h = (const float*)(c.ws + WS_H); const float* g = c.norm_ffn + L * D;
    const float* wc = c.w_coarse + (size_t)L * D * 8; const float* wf = c.w_fine + (size_t)L * D * 64;
    float* tok_gate = (float*)(c.ws + WS_TOK); int* tok_e = (int*)(c.ws + WS_TOK + 262144); int* tok_slot = (int*)(c.ws + WS_TOK + 524288); float* rs_ffn = (float*)(c.ws + WS_TOK + 786432);
    int* list = (int*)(c.ws + WS_LIST); float* list_rs = (float*)(c.ws + WS_LRS); float* list_gate = (float*)(c.ws + WS_LGATE); unsigned* cnt = ctl(c) + CW_CNT + L * 64;
    for (int grp = blockIdx.x * NWAVES + w; grp < T / 4; grp += c.G * NWAVES) {
        float rsv[4];
#pragma unroll
        for (int tk = 0; tk < 4; ++tk) { const int tok = grp * 4 + tk; const f32x4* hr = (const f32x4*)(h + (size_t)tok * D) + lane; f32x4 v[4]; float s = 0.f;
#pragma unroll
            for (int j = 0; j < 4; ++j) { v[j] = hr[64 * j]; s += (v[j].x * v[j].x + v[j].y * v[j].y) + (v[j].z * v[j].z + v[j].w * v[j].w); }
            const float rs = rsqrtf(wave_sum(s) * (1.f / D) + EPS); rsv[tk] = rs;
#pragma unroll
            for (int j = 0; j < 4; ++j) { const f32x4 gg = ((const f32x4*)g)[64 * j + lane]; f32x4 xv; xv.x = v[j].x * rs * gg.x; xv.y = v[j].y * rs * gg.y; xv.z = v[j].z * rs * gg.z; xv.w = v[j].w * rs * gg.w;
                ((LAS f32x4*)(xs + tk * 1024))[64 * j + lane] = xv; } }
        wave_lds_fence();
        float af[4] = {0.f, 0.f, 0.f, 0.f}, ac[4] = {0.f, 0.f, 0.f, 0.f};
        for (int k = 0; k < D; k += 4) {
            float wfv[4], wcv[4];
#pragma unroll
            for (int j = 0; j < 4; ++j) { wfv[j] = wf[(size_t)(k + j) * 64 + lane]; wcv[j] = wc[(size_t)(k + j) * 8 + (lane & 7)]; }
#pragma unroll
            for (int tk = 0; tk < 4; ++tk) { const f32x4 xv = *(const LAS f32x4*)(xs + tk * 1024 + k);
                af[tk] += xv.x * wfv[0]; af[tk] += xv.y * wfv[1]; af[tk] += xv.z * wfv[2]; af[tk] += xv.w * wfv[3];
                ac[tk] += xv.x * wcv[0]; ac[tk] += xv.y * wcv[1]; ac[tk] += xv.z * wcv[2]; ac[tk] += xv.w * wcv[3]; }
        }
#pragma unroll
        for (int tk = 0; tk < 4; ++tk) { lg[tk * 80 + 8 + lane] = af[tk] + c.b_fine[L * 64 + lane]; if (lane < 8) lg[tk * 80 + lane] = ac[tk] + c.b_coarse[L * 8 + lane]; }
        wave_lds_fence();
        if (lane < 4) { const int tok = grp * 4 + lane; const LAS float* l = lg + lane * 80;
            int gi = 0; float gm = l[0];
            for (int j = 1; j < 8; ++j) if (l[j] > gm) { gm = l[j]; gi = j; }
            float gs = 0.f; for (int j = 0; j < 8; ++j) gs += __expf(l[j] - gm);
            const float gp = 1.f / gs;
            const LAS float* f = l + 8 + gi * 8;
            int i1 = 0; float f1 = f[0]; for (int j = 1; j < 8; ++j) if (f[j] > f1) { f1 = f[j]; i1 = j; }
            int i2 = (i1 == 0) ? 1 : 0; float f2 = f[i2]; for (int j = 0; j < 8; ++j) if (j != i1 && f[j] > f2) { f2 = f[j]; i2 = j; }
            const float e2 = __expf(f2 - f1); const float p1 = 1.f / (1.f + e2), p2 = e2 / (1.f + e2);
            float rs = 0.f; for (int tk = 0; tk < 4; ++tk) if (tk == lane) rs = rsv[tk];
            rs_ffn[tok] = rs;
            const int e1 = gi * 8 + i1, e2i = gi * 8 + i2;
            const int s1 = (int)atomicAdd(cnt + e1, 1u), s2 = (int)atomicAdd(cnt + e2i, 1u);
            list[(size_t)e1 * T + s1] = tok * 2; list[(size_t)e2i * T + s2] = tok * 2 + 1; list_rs[(size_t)e1 * T + s1] = rs; list_rs[(size_t)e2i * T + s2] = rs; list_gate[(size_t)e1 * T + s1] = gp * p1; list_gate[(size_t)e2i * T + s2] = gp * p2;
            tok_e[tok * 2] = e1; tok_e[tok * 2 + 1] = e2i; tok_slot[tok * 2] = s1; tok_slot[tok * 2 + 1] = s2; tok_gate[tok * 2] = gp * p1; tok_gate[tok * 2 + 1] = gp * p2; }
        wave_lds_fence();
    }
}

template <int L> DEV void phase_router_fast(const Ctx& c, LAS unsigned char* lds) {
    const int tid = opaque_tid(), wid = __builtin_amdgcn_readfirstlane(tid >> 6), lane = tid & 63, fr = lane & 15, fq = lane >> 4;
    LAS float* lg = (LAS float*)lds + wid * 1344;
    const float* h = (const float*)(c.ws + WS_H); const float* wr = (const float*)(c.ws + WS_WR) + (size_t)L * 80 * D;
    float* tok_gate = (float*)(c.ws + WS_TOK); int* tok_e = (int*)(c.ws + WS_TOK + 262144); int* tok_slot = (int*)(c.ws + WS_TOK + 524288);
    int* list = (int*)(c.ws + WS_LIST); float* list_rs = (float*)(c.ws + WS_LRS); float* list_gate = (float*)(c.ws + WS_LGATE); unsigned* cnt = ctl(c) + CW_CNT + L * 64;
    for (int wt = blockIdx.x * NWAVES + wid; wt < T / 16; wt += c.G * NWAVES) {
        const int tok0 = wt * 16;
        const f32x4* ap = (const f32x4*)(h + (size_t)(tok0 + fr) * D + 4 * fq);
        const f32x4* bp = (const f32x4*)(wr + (size_t)fr * D + 4 * fq);
        f32x4 acc[5];
#pragma unroll
        for (int nt = 0; nt < 5; ++nt) acc[nt] = (f32x4){0.f, 0.f, 0.f, 0.f};
        float ssq = 0.f;
#pragma unroll 2
        for (int kb = 0; kb < 64; ++kb) {
            const f32x4 a = ap[kb * 4]; ssq += (a[0] * a[0] + a[1] * a[1]) + (a[2] * a[2] + a[3] * a[3]);
            f32x4 bv[5];
#pragma unroll
            for (int nt = 0; nt < 5; ++nt) bv[nt] = bp[(size_t)nt * 16 * (D / 4) + kb * 4];
#pragma unroll
            for (int nt = 0; nt < 5; ++nt)
#pragma unroll
                for (int j = 0; j < 4; ++j) acc[nt] = __builtin_amdgcn_mfma_f32_16x16x4f32(a[j], bv[nt][j], acc[nt], 0, 0, 0);
        }
        ssq += __shfl_xor(ssq, 16); ssq += __shfl_xor(ssq, 32);
        const float rs = rsqrtf(ssq * (1.f / D) + EPS);
        if (fq == 0) lg[1280 + fr] = rs;
#pragma unroll
        for (int nt = 0; nt < 5; ++nt)
#pragma unroll
            for (int i = 0; i < 4; ++i) lg[(4 * fq + i) * 80 + 16 * nt + fr] = acc[nt][i];
        wave_lds_fence();
        if (lane < 16) { const int tok = tok0 + lane; const LAS float* l = lg + lane * 80; const float rsv = lg[1280 + lane];
            float lc[8]; int gi = 0; float gm = -INFINITY;
#pragma unroll
            for (int j = 0; j < 8; ++j) { lc[j] = l[j] * rsv + c.b_coarse[L * 8 + j]; if (lc[j] > gm) { gm = lc[j]; gi = j; } }
            float gs = 0.f;
#pragma unroll
            for (int j = 0; j < 8; ++j) gs += __expf(lc[j] - gm);
            const float gp = 1.f / gs;
            float f[8];
#pragma unroll
            for (int j = 0; j < 8; ++j) f[j] = l[8 + gi * 8 + j] * rsv + c.b_fine[L * 64 + gi * 8 + j];
            int i1 = 0; float f1 = f[0];
#pragma unroll
            for (int j = 1; j < 8; ++j) if (f[j] > f1) { f1 = f[j]; i1 = j; }
            int i2 = (i1 == 0) ? 1 : 0; float f2 = -INFINITY;
#pragma unroll
            for (int j = 0; j < 8; ++j) if (j != i1 && f[j] > f2) { f2 = f[j]; i2 = j; }
            const float e2 = __expf(f2 - f1); const float p1 = 1.f / (1.f + e2), p2 = e2 / (1.f + e2);
            const int e1 = gi * 8 + i1, e2i = gi * 8 + i2;
            const int s1 = (int)atomicAdd(cnt + e1, 1u), s2 = (int)atomicAdd(cnt + e2i, 1u);
            list[(size_t)e1 * T + s1] = tok * 2; list[(size_t)e2i * T + s2] = tok * 2 + 1; list_rs[(size_t)e1 * T + s1] = rsv; list_rs[(size_t)e2i * T + s2] = rsv; list_gate[(size_t)e1 * T + s1] = gp * p1; list_gate[(size_t)e2i * T + s2] = gp * p2;
            tok_e[tok * 2] = e1; tok_e[tok * 2 + 1] = e2i; tok_slot[tok * 2] = s1; tok_slot[tok * 2 + 1] = s2; tok_gate[tok * 2] = gp * p1; tok_gate[tok * 2 + 1] = gp * p2; }
        wave_lds_fence();
    }
}

template <int L> DEV void phase_combine(const Ctx& c, LAS unsigned char* lds) {
    const int tid_ = opaque_tid(); const int w = tid_ >> 6, lane = tid_ & 63;
    LAS int* tpre = (LAS int*)(lds + TBL_TPRE);
    moe_prefix((const int*)(ctl(c) + CW_CNT + L * 64), tpre);
    float* h = (float*)(c.ws + WS_H); bf16_t* hb = (bf16_t*)(c.ws + WS_HB + (size_t)(L & 1) * 64 * MiB); float* ssq = (float*)(c.ws + WS_SSQ + (size_t)(L & 1) * 2 * MiB); const bf16_t* y = (const bf16_t*)(c.ws + WS_Y);
    const int* tok_e = (const int*)(c.ws + WS_TOK + 262144); const int* tok_slot = (const int*)(c.ws + WS_TOK + 524288);
    for (int tok = blockIdx.x * NWAVES + w; tok < T; tok += c.G * NWAVES) {
        const size_t p0 = (size_t)tpre[tok_e[tok * 2]] * 256 + tok_slot[tok * 2], p1 = (size_t)tpre[tok_e[tok * 2 + 1]] * 256 + tok_slot[tok * 2 + 1];
        f32x4* hr = (f32x4*)(h + (size_t)tok * D) + lane; const uint2* y0 = (const uint2*)(y + p0 * D) + lane; const uint2* y1 = (const uint2*)(y + p1 * D) + lane; uint2* o = (uint2*)(hb + (size_t)tok * D) + lane;
        float s = 0.f;
#pragma unroll
        for (int j = 0; j < 4; ++j) { f32x4 v = hr[64 * j]; const uint2 a = y0[64 * j], b = y1[64 * j];
            v.x += bf2f(a.x & 0xffffu) + bf2f(b.x & 0xffffu); v.y += bf2f(a.x >> 16) + bf2f(b.x >> 16); v.z += bf2f(a.y & 0xffffu) + bf2f(b.y & 0xffffu); v.w += bf2f(a.y >> 16) + bf2f(b.y >> 16);
            hr[64 * j] = v; o[64 * j] = make_uint2(pk2(v.x, v.y), pk2(v.z, v.w)); s += (v.x * v.x + v.y * v.y) + (v.z * v.z + v.w * v.w); }
        s = wave_sum(s); if (lane < 4) ssq[(size_t)tok * 4 + lane] = (lane == 0) ? s : 0.f;
    }
}

DEV void phase_final(const Ctx& c) {
    const int tid_ = opaque_tid(); const int w = tid_ >> 6, lane = tid_ & 63;
    const float* h = (const float*)(c.ws + WS_H); const float* ssq = (const float*)(c.ws + WS_SSQ);
    for (int tok = blockIdx.x * NWAVES + w; tok < T; tok += c.G * NWAVES) {
        const f32x4 pq = *(const f32x4*)(ssq + (size_t)tok * 4); const float a = (pq[0] + pq[1]) + (pq[2] + pq[3]); const float rs = rsqrtf(a * (1.f / D) + EPS);
        const f32x4* hr = (const f32x4*)(h + (size_t)tok * D) + lane; f32x4* o = (f32x4*)(c.out + (size_t)tok * D) + lane;
#pragma unroll
        for (int j = 0; j < 4; ++j) { const f32x4 v = hr[64 * j]; const f32x4 g = ((const f32x4*)c.norm_final)[64 * j + lane]; f32x4 r; r.x = v.x * rs * g.x; r.y = v.y * rs * g.y; r.z = v.z * rs * g.z; r.w = v.w * rs * g.w; o[64 * j] = r; }
    }
}

template <int PH, int SUB = 0> DEV void run_phase(const Ctx& c, LAS unsigned char* lds) {
    unsigned char* ws = c.ws;
    if constexpr (PH == 0) { phase_prologue(c, lds); }
    else if constexpr (PH == 41) { phase_final(c); }
    else {
        constexpr int L = (PH - 1) / 10, S = (PH - 1) % 10, KIND = L % 3, J = L / 3;
        constexpr size_t HBC = WS_HB + (size_t)(L & 1) * 64 * MiB, HBN = WS_HB + (size_t)((L + 1) & 1) * 64 * MiB, SQC = WS_SSQ + (size_t)(L & 1) * 2 * MiB, SQN = WS_SSQ + (size_t)((L + 1) & 1) * 2 * MiB;
        if constexpr (S == 0) {
            Prob<0> p; p.headmajor = 1; p.A = (const bf16_t*)(ws + HBC); p.lda = D; p.K = D; p.out = (bf16_t*)(ws + WS_QKV); p.ssq = (const float*)(ws + SQC);
            if (KIND == 0) { p.Bt = (const bf16_t*)(ws + WS_WAIN) + (size_t)J * NA * D + (size_t)SUB * NB * D; p.N = NB; }   else if (KIND == 1) { p.Bt = (const bf16_t*)(ws + WS_WBIN); p.N = NB; } else { p.Bt = (const bf16_t*)(ws + WS_WCIN); p.N = NB; }
            p.S.init(T, p.N, c.G, blockIdx.x);
            gemm_phase(p, lds);
        } else if constexpr (S == 1) {
            if constexpr (KIND == 0) { attA_fast(c, SUB, lds); }
            else if constexpr (KIND == 1) {
                const float lambda_init = 0.8f - 0.6f * expf(-0.3f * (float)L);
                float s1 = 0.f, s2 = 0.f; for (int i = 0; i < 64; ++i) { s1 += c.lq1[J * 64 + i] * c.lk1[J * 64 + i]; s2 += c.lq2[J * 64 + i] * c.lk2[J * 64 + i]; }
                const float lam = expf(s1) - expf(s2) + lambda_init;
                attB_fast(c, lam, lambda_init, c.subln + J * 128, lds);
            } else { attC_fast(c, lds); }
        } else if constexpr (S == 2) {
            if constexpr (KIND == 0) { if (FAST_ATT_A) attA_merge(c); }
        } else if constexpr (S == 3) {
            Prob<1> p; p.A = (const bf16_t*)(ws + WS_O); p.lda = D; p.K = D; p.N = D;
            p.Bt = (KIND == 0) ? (const bf16_t*)(ws + WS_WAOUT) + (size_t)J * D * D : (KIND == 1) ? (const bf16_t*)(ws + WS_WBOUT) : (const bf16_t*)(ws + WS_WCOUT);
            p.hin = (L == 0) ? c.x : (const float*)(ws + WS_H); p.h = (float*)(ws + WS_H); p.hb = (bf16_t*)(ws + HBC); p.ssq = (float*)(ws + SQC);
            p.S.init(T, D, c.G, blockIdx.x);
            gemm_phase(p, lds);
        } else if constexpr (S == 4) {
            if (FAST_ROUTER) phase_router_fast<L>(c, lds); else phase_router<L>(c, lds);
        } else if constexpr (S == 5) {
            LAS int* tpre = (LAS int*)(lds + TBL_TPRE); const int* cnt = (const int*)(ctl(c) + CW_CNT + L * 64);
            moe_prefix(cnt, tpre);
            Prob<2> p; p.A = (const bf16_t*)(ws + HBC); p.lda = D; p.K = D; p.Bt = (const bf16_t*)(ws + WS_WGU) + (size_t)L * NE * 1024 * D; p.act = (bf16_t*)(ws + WS_ACT);
            p.list = (const int*)(ws + WS_LIST); p.list_rs = (const float*)(ws + WS_LRS); p.S.init(tpre, cnt, c.G, blockIdx.x, 4);
            gemm_phase(p, lds);
        } else if constexpr (S == 6) {
            LAS int* tpre = (LAS int*)(lds + TBL_TPRE); const int* cnt = (const int*)(ctl(c) + CW_CNT + L * 64);
            moe_prefix(cnt, tpre);
            Prob<3> p; p.A = (const bf16_t*)(ws + WS_ACT); p.lda = FE; p.K = FE; p.Bt = (const bf16_t*)(ws + WS_WDN) + (size_t)L * NE * D * FE; p.y = (bf16_t*)(ws + WS_Y);
            p.list_gate = (const float*)(ws + WS_LGATE); p.S.init(tpre, cnt, c.G, blockIdx.x, 4);
            gemm_phase(p, lds);
        } else if constexpr (S == 7) {
            phase_combine<L>(c, lds);
            __syncthreads();
            Prob<0> p; p.headmajor = 0; p.ssq = nullptr; p.A = (const bf16_t*)(ws + WS_PB) + (size_t)L * T * PLE; p.lda = PLE; p.K = PLE; p.N = D; p.Bt = (const bf16_t*)(ws + WS_WPP) + (size_t)L * D * PLE; p.out = (bf16_t*)(ws + WS_PROJ);
            p.S.init(T, D, c.G, blockIdx.x);
            gemm_phase(p, lds);
        } else if constexpr (S == 9) {
            if constexpr (KIND == 1) attB_kmax(c);
        } else if constexpr (S == 8) {
            Prob<5> p; p.A = (const bf16_t*)(ws + HBC); p.lda = D; p.K = D; p.N = D; p.Bt = (const bf16_t*)(ws + WS_WPG) + (size_t)L * D * D; p.proj = (const bf16_t*)(ws + WS_PROJ);
            p.h = (float*)(ws + WS_H); p.hb = (bf16_t*)(ws + HBN); p.ssq_in = (const float*)(ws + SQC); p.ssq_out = (float*)(ws + SQN);
            p.S.init(T, D, c.G, blockIdx.x);
            gemm_phase(p, lds);
        }
    }
}

#define XB_TMO      128
#define XB_XCNT(j)  (256  + 64 * (j))
#define XB_XSUB(j)  (1280 + 64 * (j))
#define XB_XGEN(j)  (2304 + 64 * (j))
#define XB_TOP      3328
#define XB_TOPGEN   3392
#define XCD_BAR_WORDS 3456
#define XB_SPIN_CAP (1u << 18)
__device__ __forceinline__ unsigned xb_ld(unsigned* p)              { return __hip_atomic_load(p, __ATOMIC_RELAXED, __HIP_MEMORY_SCOPE_AGENT); }
__device__ __forceinline__ unsigned xb_add(unsigned* p, unsigned v) { return __hip_atomic_fetch_add(p, v, __ATOMIC_RELAXED, __HIP_MEMORY_SCOPE_AGENT); }
__device__ __forceinline__ unsigned xb_xcc_id() { return (unsigned)__builtin_amdgcn_s_getreg((3 << 11) | 20) & 0xFu; }
#define XB_SPIN(cond, bar) do { unsigned _sp = 0; while (cond) { __builtin_amdgcn_s_sleep(1); \
    if ((++_sp & 255u) == 0u) { if (xb_ld(&(bar)[XB_TMO])) break; if (_sp > XB_SPIN_CAP) { atomicAdd(&(bar)[XB_TMO], 1u); break; } } } } while (0)
struct XcdBarrier {
    unsigned* bar; unsigned x;
    volatile LAS unsigned* st;
};
__device__ __forceinline__ XcdBarrier xcd_barrier_post(unsigned* bar, volatile LAS unsigned* st) {
    XcdBarrier b; b.bar = bar; b.x = xb_xcc_id(); b.st = st;
    if (threadIdx.x == 0) (void)xb_add(&bar[XB_XCNT(b.x)], 1u);
    return b;
}
__device__ __forceinline__ void xcd_barrier_complete(unsigned* bar, unsigned x, unsigned& nloc, unsigned& nx) {
    const unsigned G = gridDim.x * gridDim.y * gridDim.z;
    unsigned sum, cnt, mine, sp = 0u;
    for (;;) {
        sum = 0u; cnt = 0u; mine = 0u;
#pragma unroll
        for (unsigned j = 0; j < 16; ++j) { const unsigned c = xb_ld(&bar[XB_XCNT(j)]); sum += c; cnt += (c > 0u) ? 1u : 0u; mine = (j == x) ? c : mine; }
        if (sum == G) break;
        __builtin_amdgcn_s_sleep(1);
        if ((++sp & 255u) == 0u) { if (xb_ld(&bar[XB_TMO])) break; if (sp > XB_SPIN_CAP) { atomicAdd(&bar[XB_TMO], 1u); break; } }
    }
    nloc = mine > 0u ? mine : 1u; nx = cnt > 0u ? cnt : 1u;
}
__device__ __forceinline__ void xcd_barrier(const XcdBarrier& b) {
    asm volatile("s_waitcnt vmcnt(0)" ::: "memory");
    __syncthreads();
    if (threadIdx.x == 0) {
        unsigned* bar = b.bar;
        __builtin_amdgcn_s_waitcnt(0);
        unsigned nloc = b.st[0], nx = b.st[1];
        if (nloc == 0u) { xcd_barrier_complete(bar, b.x, nloc, nx); b.st[0] = nloc; b.st[1] = nx; }
        const unsigned old = xb_add(&bar[XB_XSUB(b.x)], 1u);
        const unsigned gen = old / nloc;
        if (old + 1u == (gen + 1u) * nloc) {
            __builtin_amdgcn_fence(__ATOMIC_RELEASE, "agent");
            asm volatile("s_waitcnt vmcnt(0)" ::: "memory");
            const unsigned og = xb_add(&bar[XB_TOP], 1u);
            const unsigned tg = og / nx;
            if (og + 1u == (tg + 1u) * nx) xb_add(&bar[XB_TOPGEN], 1u);
            else XB_SPIN(xb_ld(&bar[XB_TOPGEN]) == tg, bar);
            __builtin_amdgcn_fence(__ATOMIC_ACQUIRE, "agent");
            xb_add(&bar[XB_XGEN(b.x)], 1u);
            asm volatile("s_waitcnt vmcnt(0)" ::: "memory");
        } else {
            XB_SPIN(xb_ld(&bar[XB_XGEN(b.x)]) == gen, bar);
            __builtin_amdgcn_fence(__ATOMIC_ACQUIRE, "agent");
            asm volatile("s_waitcnt vmcnt(0)" ::: "memory");
        }
    }
    __syncthreads();
}

constexpr int CW_BAR = 4096;
constexpr int LDS_BARW = 143360;

#ifndef MK_MULTI
#define MK_MULTI 0
#endif
#if MK_MULTI
template <int PH> __global__ void __launch_bounds__(NTHR, 2) k_phase(Ctx c) {
    extern __shared__ __attribute__((aligned(16))) unsigned char lds_raw[];
    run_phase<PH>(c, (LAS unsigned char*)lds_raw);
}
template <int PH> static void launch_phase(const Ctx& c, hipStream_t stream) {
    static bool attr = false;
    if (!attr) { (void)hipFuncSetAttribute((const void*)k_phase<PH>, hipFuncAttributeMaxDynamicSharedMemorySize, LDS_BYTES); attr = true; }
    hipLaunchKernelGGL(k_phase<PH>, dim3(c.G), dim3(NTHR), LDS_BYTES, stream, c);
}
template <int L> static void launch_layer(const Ctx& c, hipStream_t s) {
    launch_phase<1 + 10 * L + 0>(c, s); launch_phase<1 + 10 * L + 1>(c, s); launch_phase<1 + 10 * L + 3>(c, s); launch_phase<1 + 10 * L + 4>(c, s);
    launch_phase<1 + 10 * L + 5>(c, s); launch_phase<1 + 10 * L + 6>(c, s); launch_phase<1 + 10 * L + 7>(c, s); launch_phase<1 + 10 * L + 8>(c, s);
}
static void launch_all(const Ctx& c, hipStream_t stream) {
    launch_all(c, stream);
}
#else
typedef const __attribute__((address_space(4))) Ctx* KCtx;
template <int PH, int SUB = 0> DEV void run_phase_k(KCtx kc, LAS unsigned char* lds) {
#if defined(__HIP_DEVICE_COMPILE__)
    KCtx p = kc; asm volatile("" : "+s"(p));
    const Ctx c = *p;
    run_phase<PH, SUB>(c, lds);
#endif
}
template <int L> DEV void run_layer(KCtx kc, LAS unsigned char* lds, const XcdBarrier& bar) {
    if constexpr (L % 3 == 0) {
        run_phase_k<1 + 10 * L + 0, 0>(kc, lds); xcd_barrier(bar); run_phase_k<1 + 10 * L + 1, 0>(kc, lds); xcd_barrier(bar);
        run_phase_k<1 + 10 * L + 0, 1>(kc, lds); xcd_barrier(bar); run_phase_k<1 + 10 * L + 1, 1>(kc, lds); xcd_barrier(bar);
        run_phase_k<1 + 10 * L + 0, 2>(kc, lds); xcd_barrier(bar); run_phase_k<1 + 10 * L + 1, 2>(kc, lds); xcd_barrier(bar);
        run_phase_k<1 + 10 * L + 2>(kc, lds); xcd_barrier(bar);
    } else {
        run_phase_k<1 + 10 * L + 0>(kc, lds); xcd_barrier(bar);
        if constexpr (L % 3 == 1 && FAST_ATT_B) { run_phase_k<1 + 10 * L + 9>(kc, lds); xcd_barrier(bar); }
        run_phase_k<1 + 10 * L + 1>(kc, lds); xcd_barrier(bar);
    }
    run_phase_k<1 + 10 * L + 3>(kc, lds); xcd_barrier(bar);
    run_phase_k<1 + 10 * L + 4>(kc, lds); xcd_barrier(bar);
    run_phase_k<1 + 10 * L + 5>(kc, lds); xcd_barrier(bar);
    run_phase_k<1 + 10 * L + 6>(kc, lds); xcd_barrier(bar);
    run_phase_k<1 + 10 * L + 7>(kc, lds); xcd_barrier(bar);
    run_phase_k<1 + 10 * L + 8>(kc, lds); xcd_barrier(bar);
}
__global__ void __launch_bounds__(NTHR, 2) mega_fwd(Ctx cin) {
    extern __shared__ __attribute__((aligned(16))) unsigned char lds_raw[];
    LAS unsigned char* lds = (LAS unsigned char*)lds_raw;
    KCtx kc = (KCtx)__builtin_amdgcn_kernarg_segment_ptr();
    if (threadIdx.x < 4) ((LAS unsigned*)(lds + LDS_BARW))[threadIdx.x] = 0u;
    __syncthreads();
    const XcdBarrier bar = xcd_barrier_post((unsigned*)(cin.ws + WS_CTL) + CW_BAR, (volatile LAS unsigned*)(lds + LDS_BARW));
    run_phase_k<0>(kc, lds); xcd_barrier(bar);
    run_layer<0>(kc, lds, bar); run_layer<1>(kc, lds, bar); run_layer<2>(kc, lds, bar); run_layer<3>(kc, lds, bar);
    run_phase_k<41>(kc, lds);
}
static void launch_all(const Ctx& c, hipStream_t stream) {
    static bool attr = false;
    if (!attr) { (void)hipFuncSetAttribute((const void*)mega_fwd, hipFuncAttributeMaxDynamicSharedMemorySize, LDS_BYTES);
        int per_cu = 0; if (hipOccupancyMaxActiveBlocksPerMultiprocessor(&per_cu, (const void*)mega_fwd, NTHR, LDS_BYTES) != hipSuccess || per_cu < 1) fprintf(stderr, "kernel_launch: occupancy query reports %d blocks per CU\n", per_cu);
        (void)hipGetLastError(); attr = true; }
    hipLaunchKernelGGL(mega_fwd, dim3(c.G), dim3(NTHR), LDS_BYTES, stream, c);
}
#endif

extern "C" void kernel_launch(void* const* d_in, const int* in_sizes, int n_in, void* d_out, int out_size, void* d_ws, size_t ws_size, hipStream_t stream) {
    if (n_in != 25 || ws_size < WS_END) { fprintf(stderr, "kernel_launch: unexpected n_in %d or ws_size %zu (< %zu)\n", n_in, ws_size, (size_t)WS_END); return; }
    static int grid = 0;
    if (!grid) { int dev = 0, cus = 0; (void)hipGetDevice(&dev); (void)hipDeviceGetAttribute(&cus, hipDeviceAttributeMultiprocessorCount, dev); grid = cus > 0 ? cus : 256; }
    Ctx c{};
    const float* const* in = (const float* const*)d_in;
    c.x = in[0]; c.p = in[1]; c.norm_mix = in[2]; c.norm_ffn = in[3]; c.norm_ple = in[4]; c.norm_final = in[5];
    c.a_w_in = in[6]; c.a_w_out = in[7]; c.b_w_in = in[8]; c.b_w_out = in[9]; c.lq1 = in[10]; c.lk1 = in[11]; c.lq2 = in[12]; c.lk2 = in[13]; c.subln = in[14];
    c.c_w_in = in[15]; c.c_w_out = in[16]; c.w_coarse = in[17]; c.b_coarse = in[18]; c.w_fine = in[19]; c.b_fine = in[20]; c.w_gu = in[21]; c.w_dn = in[22]; c.w_pp = in[23]; c.w_pg = in[24];
    c.out = (float*)d_out; c.ws = (unsigned char*)d_ws; c.G = grid; c.pad = 0;
    (void)hipMemsetAsync((char*)d_ws + WS_CTL, 0, CTL_BYTES, stream);
    launch_all(c, stream);
}
```

```cpp
#include <hip/hip_runtime.h>
#include <cstdint>
#include <cstdio>

#define DEV __device__ __forceinline__
#define LAS __attribute__((address_space(3)))
typedef unsigned short bf16_t;
typedef short bf16x8 __attribute__((ext_vector_type(8)));
typedef float f32x16 __attribute__((ext_vector_type(16)));
typedef float f32x4 __attribute__((ext_vector_type(4)));

constexpr int D = 1024, BATCH = 8, SEQ = 4096, T = BATCH * SEQ, DEPTH = 4;
constexpr int NE = 64, FE = 512, PLE = 256;
constexpr int NA = 9216, NB = 3072;
constexpr float EPS = 1e-6f;
constexpr float LOG2E = 1.4426950408889634f, LN2 = 0.6931471805599453f;
constexpr float QSCALE = 0.125f * LOG2E;
constexpr int PMAX = 2 * T + NE * 256;
constexpr int NWAVES = 8, NTHR = 512;

constexpr size_t MiB = 1ull << 20;
constexpr size_t WS_CTL = 0;
constexpr size_t WS_WAIN = 1 * MiB;
constexpr size_t WS_WBIN = WS_WAIN + 36 * MiB;
constexpr size_t WS_WCIN = WS_WBIN + 6 * MiB;
constexpr size_t WS_WAOUT = WS_WCIN + 6 * MiB;
constexpr size_t WS_WBOUT = WS_WAOUT + 4 * MiB;
constexpr size_t WS_WCOUT = WS_WBOUT + 2 * MiB;
constexpr size_t WS_WGU = WS_WCOUT + 2 * MiB;
constexpr size_t WS_WDN = WS_WGU + 512 * MiB;
constexpr size_t WS_WPG = WS_WDN + 256 * MiB;
constexpr size_t WS_WPP = WS_WPG + 8 * MiB;
constexpr size_t WS_PB = WS_WPP + 2 * MiB;
constexpr size_t WS_H = WS_PB + 64 * MiB;
constexpr size_t WS_HB = WS_H + 128 * MiB;
constexpr size_t WS_SSQ = WS_HB + 128 * MiB;
constexpr size_t WS_QKV = WS_SSQ + 4 * MiB;
constexpr size_t WS_OG = WS_QKV + 576 * MiB;
constexpr size_t WS_LSE = WS_OG + 192 * MiB;
constexpr size_t WS_O = WS_LSE + 6 * MiB;
constexpr size_t WS_TOK = WS_O + 64 * MiB;
constexpr size_t WS_LIST = WS_TOK + 2 * MiB;
constexpr size_t WS_LRS = WS_LIST + 8 * MiB;
constexpr size_t WS_LGATE = WS_LRS + 8 * MiB;
constexpr size_t WS_ACT = WS_LGATE + 8 * MiB;
constexpr size_t WS_Y = WS_ACT + 80 * MiB;
constexpr size_t WS_PROJ = WS_Y + 160 * MiB;
constexpr size_t WS_WR = WS_PROJ + 64 * MiB;
constexpr size_t WS_WRH = WS_WR + 2 * MiB;
constexpr size_t WS_KMAX = WS_WRH + 2 * MiB;
constexpr size_t WS_STAMP = WS_KMAX + 1 * MiB;
constexpr size_t WS_END = WS_STAMP + 1 * MiB;
constexpr int CW_CNT = 16384;
constexpr int CNT_S = 32;
constexpr size_t CTL_BYTES = 1 * MiB;

constexpr int LDS_BYTES = 147456;

DEV unsigned f2bf(float f) { unsigned u = __float_as_uint(f); return (u + 0x7fffu + ((u >> 16) & 1u)) >> 16; }
DEV float bf2f(unsigned b) { return __uint_as_float(b << 16); }
DEV unsigned pk2(float lo, float hi) { return f2bf(lo) | (f2bf(hi) << 16); }
DEV float wave_sum(float v) {
#pragma unroll
    for (int o = 1; o < 64; o <<= 1) v += __shfl_xor(v, o);
    return v;
}
DEV float wave_max(float v) {
#pragma unroll
    for (int o = 1; o < 64; o <<= 1) v = fmaxf(v, __shfl_xor(v, o));
    return v;
}
DEV void wave_lds_fence() { asm volatile("s_waitcnt lgkmcnt(0)" ::: "memory"); __builtin_amdgcn_wave_barrier(); }
DEV int opaque_tid() { int t = threadIdx.x; asm volatile("" : "+v"(t)); return t; }
DEV size_t hm(int plane, int token) { return ((size_t)plane * T + (size_t)token) * 64; }
DEV int crow(int i, int hh) { return (i & 3) + 8 * (i >> 2) + 4 * hh; }

struct Ctx {
    const float *x, *p, *norm_mix, *norm_ffn, *norm_ple, *norm_final;
    const float *a_w_in, *a_w_out, *b_w_in, *b_w_out, *lq1, *lk1, *lq2, *lk2, *subln, *c_w_in, *c_w_out;
    const float *w_coarse, *b_coarse, *w_fine, *b_fine, *w_gu, *w_dn, *w_pp, *w_pg;
    float* out;
    unsigned char* ws;
    int G;
    int pad;
};
DEV unsigned* ctl(const Ctx& c) { return (unsigned*)(c.ws + WS_CTL); }

struct Unit { int pm, pn, e, rows, lbase, orow; };

struct StaticOrder {
    int nM, nN, nwg, G, c;
    DEV void init(int M, int N, int G_, int c_) { nM = M / 256; nN = N / 256; nwg = nM * nN; G = G_; c = c_; }
    DEV bool next(int i, Unit& u) const {
        const long L = (long)i * G + c; if (L >= nwg) return false;
        int wgid = (int)L; { const int q = nwg / 8, r = nwg % 8, xcd = wgid % 8, off = wgid / 8; wgid = (xcd < r ? xcd * (q + 1) : r * (q + 1) + (xcd - r) * q) + off; }
        const int nig = 8 * nN, gid = wgid / nig, fm = gid * 8, gsz = (nM - fm) < 8 ? (nM - fm) : 8;
        u.pm = fm + ((wgid % nig) % gsz); u.pn = (wgid % nig) / gsz; u.e = 0; u.rows = 256; u.lbase = 0; u.orow = u.pm * 256; return true;
    }
};
struct MoeOrder {
    int tlo, thi, cn, ntile; int G, c, npn;
    DEV void init(const LAS int* tpre, const int* cnt, int G_, int c_, int npn_) { const int lane = threadIdx.x & 63; tlo = tpre[lane]; thi = tpre[lane + 1]; cn = cnt[lane * CNT_S]; ntile = tpre[64]; G = G_; c = c_; npn = npn_; }
    DEV bool next(int i, Unit& u) const {
        const int nwg = ntile * npn; const long L = (long)i * G + c; if (L >= nwg) return false;
        int id = (int)L; { const int q = nwg / 8, r = nwg % 8, xcd = id % 8, off = id / 8; id = (xcd < r ? xcd * (q + 1) : r * (q + 1) + (xcd - r) * q) + off; }
        const int ti = id / npn; u.pn = id % npn;
        const unsigned long long bal = __ballot(tlo <= ti && ti < thi);
        const int e = (int)__builtin_ctzll(bal | (1ull << 63));
        u.e = e; const int ch = ti - __builtin_amdgcn_readlane(tlo, e); const int n = __builtin_amdgcn_readlane(cn, e);
        u.rows = (n - ch * 256) < 256 ? (n - ch * 256) : 256; u.lbase = e * T + ch * 256; u.pm = ti; u.orow = ti * 256; return true;
    }
};
DEV void moe_prefix(const int* cnt, LAS int* tpre) {
    if (threadIdx.x == 0) { int s = 0; for (int e = 0; e < 64; ++e) { tpre[e] = s; s += (cnt[e * CNT_S] + 255) >> 8; } tpre[64] = s; }
    __syncthreads();
}

constexpr int TBL_OFF = 131072;
constexpr int TBL_RED = TBL_OFF + 8192;
constexpr int TBL_TPRE = TBL_OFF + 12288 + 256;
constexpr int TBL_WARM = TBL_OFF + 13312;
typedef unsigned u32x4 __attribute__((ext_vector_type(4)));
typedef unsigned u32x2 __attribute__((ext_vector_type(2)));
DEV unsigned cvt_pk_bf16(float lo, float hi) { unsigned r; asm volatile("v_cvt_pk_bf16_f32 %0, %1, %2" : "=v"(r) : "v"(lo), "v"(hi)); return r; }
DEV float sigmoidf_(float x) { return __builtin_amdgcn_rcpf(1.f + __builtin_amdgcn_exp2f(x * -LOG2E)); }
typedef f32x4 AccT[2][2][4][2];
DEV int xs_mfma(int fr, int fq, int bj) { return (fr >> 3) * 8192 + (fr & 7) * 128 + (((4 * bj + fq) ^ (fr & 7)) << 4); }
DEV int xs_line(int lane, int j) { return j * 8192 + (lane >> 3) * 128 + (((lane & 7) ^ (lane >> 3)) << 4); }

template <int KIND> struct Prob;

DEV void ssq_tbl_dma(const float* ssq, int orow, LAS unsigned char* slot, int wid, int lane) {
    if (wid < 4) __builtin_amdgcn_global_load_lds((const unsigned*)(ssq + (size_t)(orow + 64 * wid + lane) * 4), (LAS unsigned*)(slot + 1024 * wid), 16, 0, 0);
}
DEV float rs_of(const LAS unsigned char* slot, int rt) { const f32x4 p = *(const LAS f32x4*)(slot + rt * 16); return rsqrtf(((p[0] + p[1]) + (p[2] + p[3])) * (1.0f / D) + EPS); }
DEV void ssq_reduce_store(float* ssq, const Unit& u, LAS unsigned char* red, int tid) {
    asm volatile("s_waitcnt lgkmcnt(0)" ::: "memory"); __builtin_amdgcn_s_barrier(); asm volatile("" ::: "memory");
    if (tid < 256) { const f32x4 p = *(const LAS f32x4*)(red + tid * 16); ssq[(size_t)(u.orow + tid) * 4 + u.pn] = (p[0] + p[1]) + (p[2] + p[3]); }
}

template <> struct Prob<0> {
    static constexpr bool HAS_TBL = true, WIDE = true;
    const bf16_t* A; int lda; const bf16_t* Bt; int N, K; bf16_t* out; const float* ssq; int headmajor; StaticOrder S;
    DEV bool next(int i, Unit& u) const { return S.next(i, u); }
    DEV void warm(const Unit&, LAS unsigned char*, int, int) const {}
    DEV void tbl_dma(const Unit& u, LAS unsigned char* slot, int wid, int lane) const { if (ssq) ssq_tbl_dma(ssq, u.orow, slot, wid, lane); }
    DEV unsigned arow(const Unit& u, int r, const LAS unsigned char*) const { return (unsigned)(u.orow + r); }
    DEV const bf16_t* b_base(const Unit& u) const { return Bt + (size_t)u.pn * 256 * K; }
    DEV void epi_fast(const AccT& acc, const Unit& u, int wr, int wc, int fr, int fq, const LAS unsigned char* slot, LAS unsigned char*, int, LAS unsigned char* xs) const {
        asm volatile("" : "+v"(fr), "+v"(fq));
        const int lane = fr + 16 * fq;
#pragma unroll
        for (int ai = 0; ai < 2; ++ai)
#pragma unroll
            for (int m = 0; m < 4; ++m) { const int rb = 128 * ai + 64 * wr + 16 * m; const float rs = ssq ? rs_of(slot, rb + fr) : 1.f;
#pragma unroll
                for (int bj = 0; bj < 2; ++bj) { const f32x4 v0 = acc[ai][bj][m][0] * rs, v1 = acc[ai][bj][m][1] * rs; u32x4 w;
                    w.x = cvt_pk_bf16(v0[0], v0[1]); w.y = cvt_pk_bf16(v0[2], v0[3]); w.z = cvt_pk_bf16(v1[0], v1[1]); w.w = cvt_pk_bf16(v1[2], v1[3]);
                    *(LAS u32x4*)(xs + xs_mfma(fr, fq, bj)) = w; }
                __builtin_amdgcn_wave_barrier();
#pragma unroll
                for (int j = 0; j < 2; ++j) { const u32x4 w = *(const LAS u32x4*)(xs + xs_line(lane, j)); const int row = u.orow + rb + 8 * j + (lane >> 3);
                    bf16_t* dst = headmajor ? out + hm(u.pn * 4 + wc, row) + 8 * (lane & 7) : out + (size_t)row * N + u.pn * 256 + 64 * wc + 8 * (lane & 7);
                    *(u32x4*)dst = w; }
                __builtin_amdgcn_wave_barrier(); }
    }
};
template <> struct Prob<6> {
    static constexpr bool HAS_TBL = false, WIDE = true;
    const bf16_t* A; int lda; const bf16_t* Bt; int N, K; bf16_t* o0; StaticOrder S;
    DEV bool next(int i, Unit& u) const { return S.next(i, u); }
    DEV void warm(const Unit&, LAS unsigned char*, int, int) const {}
    DEV void tbl_dma(const Unit&, LAS unsigned char*, int, int) const {}
    DEV unsigned arow(const Unit& u, int r, const LAS unsigned char*) const { return (unsigned)(u.orow + r); }
    DEV const bf16_t* b_base(const Unit& u) const { return Bt + (size_t)(u.pm / (T / 256)) * D * PLE + (size_t)u.pn * 256 * K; }
    DEV void epi_fast(const AccT& acc, const Unit& u, int wr, int wc, int fr, int fq, const LAS unsigned char*, LAS unsigned char*, int, LAS unsigned char* xs) const {
        asm volatile("" : "+v"(fr), "+v"(fq));
        const int lane = fr + 16 * fq, layer = u.pm / (T / 256);
        const size_t lo = (layer == 2) ? (size_t)(WS_PROJ - WS_H) / 2 : (size_t)layer * (32 * MiB);
        bf16_t* const ob = o0 + lo + (size_t)(u.orow - layer * T) * N + u.pn * 256 + 64 * wc + 8 * (lane & 7);
#pragma unroll
        for (int ai = 0; ai < 2; ++ai)
#pragma unroll
            for (int m = 0; m < 4; ++m) { const int rb = 128 * ai + 64 * wr + 16 * m;
#pragma unroll
                for (int bj = 0; bj < 2; ++bj) { const f32x4 v0 = acc[ai][bj][m][0], v1 = acc[ai][bj][m][1]; u32x4 w;
                    w.x = cvt_pk_bf16(v0[0], v0[1]); w.y = cvt_pk_bf16(v0[2], v0[3]); w.z = cvt_pk_bf16(v1[0], v1[1]); w.w = cvt_pk_bf16(v1[2], v1[3]);
                    *(LAS u32x4*)(xs + xs_mfma(fr, fq, bj)) = w; }
                __builtin_amdgcn_wave_barrier();
#pragma unroll
                for (int j = 0; j < 2; ++j) { const u32x4 w = *(const LAS u32x4*)(xs + xs_line(lane, j)); *(u32x4*)(ob + (size_t)(rb + 8 * j + (lane >> 3)) * N) = w; }
                __builtin_amdgcn_wave_barrier(); }
    }
};
template <> struct Prob<1> {
    static constexpr bool HAS_TBL = false, WIDE = false;
    const bf16_t* A; int lda; const bf16_t* Bt; int N, K; const bf16_t* hin; bf16_t* hb; float* ssq; StaticOrder S;
    DEV bool next(int i, Unit& u) const { return S.next(i, u); }
    DEV void warm(const Unit& u, LAS unsigned char* dz, int wid, int lane) const {
        asm volatile("" : "+v"(lane));
#pragma unroll
        for (int j = 0; j < 2; ++j) { const char* ub = (const char*)(hin + (size_t)(u.orow + (wid * 2 + j) * 16) * D + u.pn * 256);
            __builtin_amdgcn_global_load_lds((const unsigned*)(ub + (unsigned)(((lane >> 2) * D + (lane & 3) * 64) * 2)), (LAS unsigned*)(dz + wid * 256), 4, 0, 0); } }
    DEV void tbl_dma(const Unit&, LAS unsigned char*, int, int) const {}
    DEV unsigned arow(const Unit& u, int r, const LAS unsigned char*) const { return (unsigned)(u.orow + r); }
    DEV const bf16_t* b_base(const Unit& u) const { return Bt + (size_t)u.pn * 256 * K; }
    DEV void epi_fast(const AccT& acc, const Unit& u, int wr, int wc, int fr, int fq, const LAS unsigned char*, LAS unsigned char* red, int tid, LAS unsigned char*) const {
        asm volatile("" : "+v"(fr), "+v"(fq));
        u32x4 hva[2][4][2];
        { const bf16_t* hp = hin + (size_t)(u.orow + 64 * wr + fr) * D + u.pn * 256 + 32 * wc + 8 * fq;
#pragma unroll
        for (int ai = 0; ai < 2; ++ai)
#pragma unroll
            for (int m = 0; m < 4; ++m)
#pragma unroll
                for (int bj = 0; bj < 2; ++bj) hva[ai][m][bj] = *(const u32x4*)(hp + (size_t)(128 * ai + 16 * m) * D + 128 * bj); }
#pragma unroll
        for (int ai = 0; ai < 2; ++ai)
#pragma unroll
            for (int m = 0; m < 4; ++m) { const int rt = 128 * ai + 64 * wr + 16 * m + fr; const size_t o = (size_t)(u.orow + rt) * D + u.pn * 256 + 32 * wc + 8 * fq; float q = 0.f;
#pragma unroll
                for (int bj = 0; bj < 2; ++bj) { const u32x4 hv = hva[ai][m][bj]; f32x4 v0, v1;
                    v0[0] = bf2f(hv.x & 0xffffu) + acc[ai][bj][m][0][0]; v0[1] = bf2f(hv.x >> 16) + acc[ai][bj][m][0][1]; v0[2] = bf2f(hv.y & 0xffffu) + acc[ai][bj][m][0][2]; v0[3] = bf2f(hv.y >> 16) + acc[ai][bj][m][0][3];
                    v1[0] = bf2f(hv.z & 0xffffu) + acc[ai][bj][m][1][0]; v1[1] = bf2f(hv.z >> 16) + acc[ai][bj][m][1][1]; v1[2] = bf2f(hv.w & 0xffffu) + acc[ai][bj][m][1][2]; v1[3] = bf2f(hv.w >> 16) + acc[ai][bj][m][1][3];
                    u32x4 w; w.x = cvt_pk_bf16(v0[0], v0[1]); w.y = cvt_pk_bf16(v0[2], v0[3]); w.z = cvt_pk_bf16(v1[0], v1[1]); w.w = cvt_pk_bf16(v1[2], v1[3]);
                    *(u32x4*)(hb + o + 128 * bj) = w;
                    q += (v0[0] * v0[0] + v0[1] * v0[1]) + (v0[2] * v0[2] + v0[3] * v0[3]) + (v1[0] * v1[0] + v1[1] * v1[1]) + (v1[2] * v1[2] + v1[3] * v1[3]); }
                q += __shfl_xor(q, 16); q += __shfl_xor(q, 32);
                if (fq == 0) ((LAS float*)red)[rt * 4 + wc] = q; }
        ssq_reduce_store(ssq, u, red, tid);
    }
};
template <> struct Prob<2> {
    static constexpr bool HAS_TBL = true, WIDE = false;
    const bf16_t* A; int lda; const bf16_t* Bt; int K; bf16_t* act; const int* list; const float* list_rs; MoeOrder S;
    DEV bool next(int i, Unit& u) const { return S.next(i, u); }
    DEV void warm(const Unit&, LAS unsigned char*, int, int) const {}
    DEV void tbl_dma(const Unit& u, LAS unsigned char* slot, int wid, int lane) const {
        const unsigned* src = (wid < 4) ? (const unsigned*)list + u.lbase + 64 * wid + lane : (const unsigned*)list_rs + u.lbase + 64 * (wid - 4) + lane;
        __builtin_amdgcn_global_load_lds(src, (LAS unsigned*)(slot + 256 * wid), 4, 0, 0); }
    DEV unsigned arow(const Unit& u, int r, const LAS unsigned char* slot) const { const unsigned e = ((const LAS unsigned*)slot)[r]; return (r < u.rows) ? (e >> 1) : 0u; }
    DEV const bf16_t* b_base(const Unit& u) const { return Bt + ((size_t)u.e * 1024 + u.pn * 256) * K; }
    DEV void epi_fast(const AccT& acc, const Unit& u, int wr, int wc, int fr, int fq, const LAS unsigned char* slot, LAS unsigned char*, int, LAS unsigned char*) const {
        asm volatile("" : "+v"(fr), "+v"(fq));
        const LAS float* tf = (const LAS float*)(slot + 1024);
#pragma unroll
        for (int ai = 0; ai < 2; ++ai)
#pragma unroll
            for (int m = 0; m < 4; ++m) { const int rt = 128 * ai + 64 * wr + 16 * m + fr; const float rs = tf[rt];
                float o[8];
#pragma unroll
                for (int n = 0; n < 2; ++n)
#pragma unroll
                    for (int j = 0; j < 4; ++j) { const float g = acc[ai][0][m][n][j] * rs, up = acc[ai][1][m][n][j] * rs; o[4 * n + j] = g * sigmoidf_(g) * up; }
                u32x4 w; w.x = cvt_pk_bf16(o[0], o[1]); w.y = cvt_pk_bf16(o[2], o[3]); w.z = cvt_pk_bf16(o[4], o[5]); w.w = cvt_pk_bf16(o[6], o[7]);
                if (rt < u.rows) *(u32x4*)(act + (size_t)(u.orow + rt) * FE + u.pn * 128 + 32 * wc + 8 * fq) = w; }
    }
};
template <> struct Prob<3> {
    static constexpr bool HAS_TBL = true, WIDE = true;
    const bf16_t* A; int lda; const bf16_t* Bt; int K; bf16_t* y; const float* list_gate; MoeOrder S;
    DEV bool next(int i, Unit& u) const { return S.next(i, u); }
    DEV void warm(const Unit&, LAS unsigned char*, int, int) const {}
    DEV void tbl_dma(const Unit& u, LAS unsigned char* slot, int wid, int lane) const {
        if (wid < 4) __builtin_amdgcn_global_load_lds((const unsigned*)list_gate + u.lbase + 64 * wid + lane, (LAS unsigned*)(slot + 1024 + 256 * wid), 4, 0, 0); }
    DEV unsigned arow(const Unit& u, int r, const LAS unsigned char*) const { return (unsigned)(u.orow + r); }
    DEV const bf16_t* b_base(const Unit& u) const { return Bt + ((size_t)u.e * 1024 + u.pn * 256) * K; }
    DEV void epi_fast(const AccT& acc, const Unit& u, int wr, int wc, int fr, int fq, const LAS unsigned char* slot, LAS unsigned char*, int, LAS unsigned char* xs) const {
        asm volatile("" : "+v"(fr), "+v"(fq));
        const LAS float* tf = (const LAS float*)(slot + 1024);
        const int lane = fr + 16 * fq;
#pragma unroll
        for (int ai = 0; ai < 2; ++ai)
#pragma unroll
            for (int m = 0; m < 4; ++m) { const int rb = 128 * ai + 64 * wr + 16 * m; const float gs = tf[rb + fr];
#pragma unroll
                for (int bj = 0; bj < 2; ++bj) { const f32x4 v0 = acc[ai][bj][m][0] * gs, v1 = acc[ai][bj][m][1] * gs; u32x4 w;
                    w.x = cvt_pk_bf16(v0[0], v0[1]); w.y = cvt_pk_bf16(v0[2], v0[3]); w.z = cvt_pk_bf16(v1[0], v1[1]); w.w = cvt_pk_bf16(v1[2], v1[3]);
                    *(LAS u32x4*)(xs + xs_mfma(fr, fq, bj)) = w; }
                __builtin_amdgcn_wave_barrier();
#pragma unroll
                for (int j = 0; j < 2; ++j) { const u32x4 w = *(const LAS u32x4*)(xs + xs_line(lane, j)); const int rt = rb + 8 * j + (lane >> 3);
                    if (rt < u.rows) *(u32x4*)(y + (size_t)(u.orow + rt) * D + u.pn * 256 + 64 * wc + 8 * (lane & 7)) = w; }
                __builtin_amdgcn_wave_barrier(); }
    }
};
template <> struct Prob<5> {
    static constexpr bool HAS_TBL = true, WIDE = false;
    const bf16_t* A; int lda; const bf16_t* Bt; int N, K; const bf16_t* proj; const bf16_t* hin; bf16_t* hb; const float* ssq_in; float* ssq_out; StaticOrder S;
    DEV bool next(int i, Unit& u) const { return S.next(i, u); }
    DEV void warm(const Unit& u, LAS unsigned char* dz, int wid, int lane) const {
        asm volatile("" : "+v"(lane));
#pragma unroll
        for (int j = 0; j < 2; ++j) { const char* ub = (const char*)(proj + (size_t)(u.orow + (wid * 2 + j) * 16) * D + u.pn * 256);
            __builtin_amdgcn_global_load_lds((const unsigned*)(ub + (unsigned)(((lane >> 2) * D + (lane & 3) * 64) * 2)), (LAS unsigned*)(dz + wid * 256), 4, 0, 0); } }
    DEV void tbl_dma(const Unit& u, LAS unsigned char* slot, int wid, int lane) const { ssq_tbl_dma(ssq_in, u.orow, slot, wid, lane); }
    DEV unsigned arow(const Unit& u, int r, const LAS unsigned char*) const { return (unsigned)(u.orow + r); }
    DEV const bf16_t* b_base(const Unit& u) const { return Bt + (size_t)u.pn * 256 * K; }
    DEV void epi_fast(const AccT& acc, const Unit& u, int wr, int wc, int fr, int fq, const LAS unsigned char* slot, LAS unsigned char* red, int tid, LAS unsigned char*) const {
        asm volatile("" : "+v"(fr), "+v"(fq));
#pragma unroll
        for (int ai = 0; ai < 2; ++ai) {
            u32x4 hva[4][2], pja[4][2];
            { const size_t o0 = (size_t)(u.orow + 128 * ai + 64 * wr + fr) * D + u.pn * 256 + 32 * wc + 8 * fq;
#pragma unroll
            for (int m = 0; m < 4; ++m)
#pragma unroll
                for (int bj = 0; bj < 2; ++bj) { hva[m][bj] = *(const u32x4*)(hin + o0 + (size_t)(16 * m) * D + 128 * bj); pja[m][bj] = *(const u32x4*)(proj + o0 + (size_t)(16 * m) * D + 128 * bj); } }
#pragma unroll
            for (int m = 0; m < 4; ++m) { const int rt = 128 * ai + 64 * wr + 16 * m + fr; const float rs = rs_of(slot, rt); const size_t o = (size_t)(u.orow + rt) * D + u.pn * 256 + 32 * wc + 8 * fq; float q = 0.f;
#pragma unroll
                for (int bj = 0; bj < 2; ++bj) { const u32x4 hv = hva[m][bj]; const u32x4 pj = pja[m][bj];
                    const f32x4 a0 = acc[ai][bj][m][0] * rs, a1 = acc[ai][bj][m][1] * rs; f32x4 v0, v1;
                    v0[0] = bf2f(hv.x & 0xffffu) + bf2f(pj.x & 0xffffu) * sigmoidf_(a0[0]); v0[1] = bf2f(hv.x >> 16) + bf2f(pj.x >> 16) * sigmoidf_(a0[1]); v0[2] = bf2f(hv.y & 0xffffu) + bf2f(pj.y & 0xffffu) * sigmoidf_(a0[2]); v0[3] = bf2f(hv.y >> 16) + bf2f(pj.y >> 16) * sigmoidf_(a0[3]);
                    v1[0] = bf2f(hv.z & 0xffffu) + bf2f(pj.z & 0xffffu) * sigmoidf_(a1[0]); v1[1] = bf2f(hv.z >> 16) + bf2f(pj.z >> 16) * sigmoidf_(a1[1]); v1[2] = bf2f(hv.w & 0xffffu) + bf2f(pj.w & 0xffffu) * sigmoidf_(a1[2]); v1[3] = bf2f(hv.w >> 16) + bf2f(pj.w >> 16) * sigmoidf_(a1[3]);
                    u32x4 w; w.x = cvt_pk_bf16(v0[0], v0[1]); w.y = cvt_pk_bf16(v0[2], v0[3]); w.z = cvt_pk_bf16(v1[0], v1[1]); w.w = cvt_pk_bf16(v1[2], v1[3]);
                    *(u32x4*)(hb + o + 128 * bj) = w;
                    q += (v0[0] * v0[0] + v0[1] * v0[1]) + (v0[2] * v0[2] + v0[3] * v0[3]) + (v1[0] * v1[0] + v1[1] * v1[1]) + (v1[2] * v1[2] + v1[3] * v1[3]); }
                q += __shfl_xor(q, 16); q += __shfl_xor(q, 32);
                if (fq == 0) ((LAS float*)red)[rt * 4 + wc] = q; }
        }
        ssq_reduce_store(ssq_out, u, red, tid);
    }
};

namespace fg {
constexpr int BK = 64, HALF = 128, HTB = HALF * BK * 2;
DEV int lds_byte(int r, int c) { const int st = (r >> 4) * 2 + (c >> 5), rr = r & 15, cc = c & 31, ob = rr * 64 + cc * 2; return st * 1024 + (ob ^ (((ob >> 9) & 1) << 5)); }
DEV void stage_rc(int b, int& R, int& C) { const int st = b / 1024, sb = b % 1024, swz = sb ^ (((sb >> 9) & 1) << 5); R = (st >> 1) * 16 + swz / 64; C = (st & 1) * 32 + (swz % 64) / 2; }
DEV int perm32(int rho) { const int n = rho >> 4, i = rho & 15; return 8 * (i >> 2) + 4 * n + (i & 3); }
}
template <class P> DEV void gemm_phase_fast(const P& p, LAS unsigned char* lds) {
    using namespace fg;
    const int tid = opaque_tid(), wid = __builtin_amdgcn_readfirstlane(tid >> 6), lane = tid & 63, wr = wid >> 2, wc = wid & 3, fr = lane & 15, fq = lane >> 4;
    const int K = p.K, nt = K / BK, lda = p.lda;
    unsigned voffB[2];
#pragma unroll
    for (int i = 0; i < 2; ++i) { int R, C; stage_rc(tid * 16 + i * 8192, R, C); const int Rb = (P::WIDE ? ((R >> 5) << 6) : (R & ~31)) + perm32(R & 31); voffB[i] = (unsigned)(Rb * K + C) * 2u; }
    const size_t kstep = (size_t)(BK * 2);
    const size_t hstepB = (size_t)(P::WIDE ? 32 : HALF) * K * 2;
    const unsigned ldsw = (unsigned)wid * 1024u;
    const int aoffl = lds_byte(wr * 64 + fr, fq * 8), boffl = lds_byte(wc * 32 + fr, fq * 8);
#define PG8_SA(b, h) (((b) * 2 + (h)) * HTB)
#define PG8_SB(b, h) ((4 + (b) * 2 + (h)) * HTB)
#define PG8_STAGE(bufoff, gbase, voff) do { _Pragma("unroll") for (int _i = 0; _i < 2; ++_i) \
        __builtin_amdgcn_global_load_lds((const unsigned*)((const char*)(gbase) + (voff)[_i]), (LAS unsigned*)(lds + (bufoff) + ldsw + _i * 8192), 16, 0, 0); } while (0)
#define PG8_LDA(dst, b, h) do { _Pragma("unroll") for (int m = 0; m < 4; ++m) _Pragma("unroll") for (int k = 0; k < 2; ++k) dst[m][k] = *(const LAS bf16x8*)(lds + PG8_SA(b, h) + aoffl + m * 2048 + k * 1024); } while (0)
#define PG8_LDB(dst, b, h) do { _Pragma("unroll") for (int n = 0; n < 2; ++n) _Pragma("unroll") for (int k = 0; k < 2; ++k) dst[n][k] = *(const LAS bf16x8*)(lds + PG8_SB(b, h) + boffl + n * 2048 + k * 1024); } while (0)
#define PG8_MMA(ai, bj, At, Bt) do { __builtin_amdgcn_s_setprio(1); _Pragma("unroll") for (int m = 0; m < 4; ++m) _Pragma("unroll") for (int n = 0; n < 2; ++n) _Pragma("unroll") for (int k = 0; k < 2; ++k) \
        acc[ai][bj][m][n] = __builtin_amdgcn_mfma_f32_16x16x32_bf16(Bt[n][k], At[m][k], acc[ai][bj][m][n], 0, 0, 0); __builtin_amdgcn_s_setprio(0); } while (0)
#define PG8_WAIT_V(n) asm volatile("s_waitcnt vmcnt(" #n ")" ::: "memory")
#define PG8_WAIT_L(n) asm volatile("s_waitcnt lgkmcnt(" #n ")" ::: "memory")
#define PG8_BAR __builtin_amdgcn_s_barrier()
#define PG8_SCHED __builtin_amdgcn_sched_barrier(0)
#define PG8_AOFF(dst, un, slotp) do { _Pragma("unroll") for (int _i = 0; _i < 2; ++_i) { int _R, _C; stage_rc(tid * 16 + _i * 8192, _R, _C); _Pragma("unroll") for (int _h = 0; _h < 2; ++_h) \
        dst[_h][_i] = (p.arow(un, 128 * _h + _R, slotp) * (unsigned)lda + (unsigned)_C) * 2u; } } while (0)
    Unit cur, nxt; int ui = 0;
    if (!p.next(0, cur)) return;
    LAS unsigned char* const tbl = lds + TBL_OFF;
    if constexpr (P::HAS_TBL) { p.tbl_dma(cur, tbl, wid, lane); asm volatile("s_waitcnt vmcnt(0)" ::: "memory"); }
    __syncthreads();
    AccT acc;
#pragma unroll
    for (int a = 0; a < 2; ++a)
#pragma unroll
        for (int b = 0; b < 2; ++b)
#pragma unroll
            for (int m = 0; m < 4; ++m)
#pragma unroll
                for (int n = 0; n < 2; ++n) acc[a][b][m][n] = (f32x4){0.f, 0.f, 0.f, 0.f};
    bf16x8 At[4][2], B0[2][2], B1[2][2];
    unsigned ao[2][2];
    PG8_AOFF(ao, cur, tbl);
    const char* const Ab = (const char*)p.A;
    const char* cB = (const char*)p.b_base(cur);
    PG8_STAGE(PG8_SB(0, 0), cB, voffB); PG8_STAGE(PG8_SB(0, 1), cB + hstepB, voffB); PG8_STAGE(PG8_SA(0, 0), Ab, ao[0]); PG8_STAGE(PG8_SA(0, 1), Ab, ao[1]);
    if (wr == 1) PG8_BAR;
    PG8_WAIT_V(2); PG8_BAR;
    PG8_STAGE(PG8_SB(1, 0), cB + kstep, voffB); PG8_STAGE(PG8_SA(1, 0), Ab + kstep, ao[0]); PG8_STAGE(PG8_SB(1, 1), cB + hstepB + kstep, voffB);
    PG8_WAIT_V(6); PG8_BAR;
    for (;;) {
        const bool has_next = p.next(ui + 1, nxt);
        const char* nB = has_next ? (const char*)p.b_base(nxt) : cB;
        LAS unsigned char* const nslot = tbl + ((ui + 1) & 1) * 4096;
        for (int t = 0; t < nt; t += 2) {
            const bool last = (t == nt - 2);
            if ((t == 2) && !last) { if constexpr (P::HAS_TBL) { if (has_next) p.tbl_dma(nxt, nslot, wid, lane); }
                p.warm(cur, lds + TBL_WARM, wid, lane); }
            const char* a1 = Ab + (size_t)(t + 1) * kstep;
            const char* a2 = last ? Ab : Ab + (size_t)(t + 2) * kstep; const char* b2 = last ? nB : cB + (size_t)(t + 2) * kstep;
            const char* a3 = a2 + kstep; const char* b3 = b2 + kstep;
            PG8_LDB(B0, 0, 0); PG8_LDB(B1, 0, 1); PG8_SCHED; PG8_LDA(At, 0, 0); PG8_STAGE(PG8_SA(1, 1), a1, ao[1]);
            if (last && has_next) { PG8_AOFF(ao, nxt, nslot); }
            PG8_WAIT_V(8); PG8_WAIT_L(0); PG8_BAR; PG8_MMA(0, 0, At, B0); PG8_MMA(0, 1, At, B1); PG8_BAR; PG8_SCHED;
            PG8_LDA(At, 0, 1); PG8_STAGE(PG8_SB(0, 0), b2, voffB); PG8_STAGE(PG8_SB(0, 1), b2 + hstepB, voffB); PG8_STAGE(PG8_SA(0, 0), a2, ao[0]);
            PG8_WAIT_V(8); PG8_WAIT_L(0); PG8_BAR; PG8_MMA(1, 0, At, B0); PG8_MMA(1, 1, At, B1); PG8_BAR; PG8_SCHED;
            PG8_LDB(B0, 1, 0); PG8_LDB(B1, 1, 1); PG8_SCHED; PG8_LDA(At, 1, 0); PG8_STAGE(PG8_SA(0, 1), a2, ao[1]);
            PG8_WAIT_V(8); PG8_WAIT_L(0); PG8_BAR; PG8_MMA(0, 0, At, B0); PG8_MMA(0, 1, At, B1); PG8_BAR; PG8_SCHED;
            PG8_LDA(At, 1, 1); PG8_STAGE(PG8_SB(1, 0), b3, voffB); PG8_STAGE(PG8_SB(1, 1), b3 + hstepB, voffB); PG8_STAGE(PG8_SA(1, 0), a3, ao[0]);
            PG8_WAIT_V(8); PG8_WAIT_L(0); PG8_BAR; PG8_MMA(1, 0, At, B0); PG8_MMA(1, 1, At, B1); PG8_BAR; PG8_SCHED;
        }
        if (wr == 0) PG8_BAR;
        p.epi_fast(acc, cur, wr, wc, fr, fq, tbl + (ui & 1) * 4096, lds + TBL_RED, tid, lds + PG8_SA(1, 1) + ldsw);
        if (!has_next) break;
#pragma unroll
        for (int a = 0; a < 2; ++a)
#pragma unroll
            for (int b = 0; b < 2; ++b)
#pragma unroll
                for (int m = 0; m < 4; ++m)
#pragma unroll
                    for (int n = 0; n < 2; ++n) acc[a][b][m][n] = (f32x4){0.f, 0.f, 0.f, 0.f};
        cur = nxt; cB = nB; ++ui;
        if (wr == 1) PG8_BAR;
    }
    PG8_WAIT_V(0);
    PG8_BAR;
#undef PG8_SA
#undef PG8_SB
#undef PG8_STAGE
#undef PG8_LDA
#undef PG8_LDB
#undef PG8_MMA
#undef PG8_WAIT_V
#undef PG8_WAIT_L
#undef PG8_BAR
#undef PG8_SCHED
#undef PG8_AOFF
}
template <class P> DEV void gemm_phase(const P& p, LAS unsigned char* lds) {
#if 1
    gemm_phase_fast(p, lds);
#else
    gemm_phase(p, lds);
#endif
}

DEV void cvt_weight(const float* src, bf16_t* dst, int K, int N, int nbatch, int mode, const float* gbase, LAS unsigned char*, int G) {
    const int tid = opaque_tid(), half = tid >> 8, t = tid & 255, l = t & 63, kq = l & 7, n4 = (l >> 3) + 8 * (t >> 6);
    const int tn = N / 128, tpm = (K / 64) * tn, total = tpm * nbatch;
    for (int id = blockIdx.x * 2 + half; id < total; id += G * 2) {
        const int b = id / tpm, rem = id % tpm, k0 = (rem / tn) * 64 + 8 * kq, n = (rem % tn) * 128 + 4 * n4;
        const float* g = nullptr;
        if (mode == 1) g = gbase + (size_t)(3 * b) * D; else if (mode == 2) g = gbase; else if (mode == 3) g = gbase + (size_t)(b / 64) * D; else if (mode == 4) g = gbase + (size_t)b * D;
        float cs = 1.f;
        if (mode == 1) cs = ((n % 3072) < 1024) ? QSCALE : 1.f; else if (mode == 2) cs = (n < 1024) ? QSCALE : 1.f;
        const float* sp = src + (size_t)b * K * N + (size_t)k0 * N + n;
        f32x4 v0 = *(const f32x4*)(sp), v1 = *(const f32x4*)(sp + (size_t)N), v2 = *(const f32x4*)(sp + (size_t)2 * N), v3 = *(const f32x4*)(sp + (size_t)3 * N),
              v4 = *(const f32x4*)(sp + (size_t)4 * N), v5 = *(const f32x4*)(sp + (size_t)5 * N), v6 = *(const f32x4*)(sp + (size_t)6 * N), v7 = *(const f32x4*)(sp + (size_t)7 * N);
        if (g) { const f32x4 ga = *(const f32x4*)(g + k0), gb = *(const f32x4*)(g + k0 + 4); v0 = v0 * (ga[0] * cs); v1 = v1 * (ga[1] * cs); v2 = v2 * (ga[2] * cs); v3 = v3 * (ga[3] * cs); v4 = v4 * (gb[0] * cs); v5 = v5 * (gb[1] * cs); v6 = v6 * (gb[2] * cs); v7 = v7 * (gb[3] * cs); }
        bf16_t* dp = dst + (size_t)b * K * N + k0;
#define CVT_ST(JJ) do { int nn = n + JJ; if (mode == 3) { if (nn < 512) nn = 256 * (nn >> 7) + (nn & 127); else { const int q = nn - 512; nn = 256 * (q >> 7) + 128 + (q & 127); } } \
            u32x4 w; w.x = pk2(v0[JJ], v1[JJ]); w.y = pk2(v2[JJ], v3[JJ]); w.z = pk2(v4[JJ], v5[JJ]); w.w = pk2(v6[JJ], v7[JJ]); *(u32x4*)(dp + (size_t)nn * K) = w; } while (0)
        CVT_ST(0); CVT_ST(1); CVT_ST(2); CVT_ST(3);
#undef CVT_ST
    }
}

DEV void phase_prologue(const Ctx& c, LAS unsigned char* lds) {
    unsigned char* ws = c.ws;
    cvt_weight(c.a_w_in, (bf16_t*)(ws + WS_WAIN), D, NA, 2, 1, c.norm_mix, lds, c.G);
    cvt_weight(c.b_w_in, (bf16_t*)(ws + WS_WBIN), D, NB, 1, 2, c.norm_mix + 1 * D, lds, c.G);
    cvt_weight(c.c_w_in, (bf16_t*)(ws + WS_WCIN), D, NB, 1, 2, c.norm_mix + 2 * D, lds, c.G);
    cvt_weight(c.a_w_out, (bf16_t*)(ws + WS_WAOUT), D, D, 2, 0, nullptr, lds, c.G);
    cvt_weight(c.b_w_out, (bf16_t*)(ws + WS_WBOUT), D, D, 1, 0, nullptr, lds, c.G);
    cvt_weight(c.c_w_out, (bf16_t*)(ws + WS_WCOUT), D, D, 1, 0, nullptr, lds, c.G);
    cvt_weight(c.w_gu, (bf16_t*)(ws + WS_WGU), D, 1024, NE, 3, c.norm_ffn, lds, c.G);
    cvt_weight(c.w_dn, (bf16_t*)(ws + WS_WDN), FE, D, NE, 0, nullptr, lds, c.G);
    cvt_weight(c.w_pg, (bf16_t*)(ws + WS_WPG), D, D, DEPTH, 4, c.norm_ple, lds, c.G);
    cvt_weight(c.w_pp, (bf16_t*)(ws + WS_WPP), PLE, D, DEPTH, 0, nullptr, lds, c.G);
    { float* wr = (float*)(ws + WS_WR);
      for (int i = blockIdx.x * NTHR + threadIdx.x; i < DEPTH * 80 * D; i += c.G * NTHR) { const int k = i & (D - 1), n = (i >> 10) % 80, L = i / (80 * D);
          float v = 0.f; if (n < 8) v = c.w_coarse[((size_t)L * D + k) * 8 + n]; else if (n < 72) v = c.w_fine[((size_t)L * D + k) * 64 + (n - 8)];
          v *= c.norm_ffn[L * D + k]; wr[i] = v; const unsigned hb_ = f2bf(v); ((bf16_t*)(ws + WS_WRH))[i] = (bf16_t)hb_; ((bf16_t*)(ws + WS_WRH))[(size_t)DEPTH * 80 * D + i] = (bf16_t)f2bf(v - bf2f(hb_)); } }
    { const size_t n4 = (size_t)DEPTH * T * PLE / 4; const f32x4* s = (const f32x4*)c.p; uint2* d = (uint2*)(ws + WS_PB);
      for (size_t i = (size_t)blockIdx.x * NTHR + threadIdx.x; i < n4; i += (size_t)c.G * NTHR) { const f32x4 v = s[i]; d[i] = make_uint2(pk2(v.x, v.y), pk2(v.z, v.w)); } }
    { const int tid_ = opaque_tid(); const int w = tid_ >> 6, lane = tid_ & 63; bf16_t* hb = (bf16_t*)(ws + WS_HB); float* ssq = (float*)(ws + WS_SSQ);
      const int stride = c.G * NWAVES;
      for (int tok0 = blockIdx.x * NWAVES + w; tok0 < T; tok0 += 4 * stride) {
          f32x4 v[4][4];
#pragma unroll
          for (int q = 0; q < 4; ++q) { const int tok = tok0 + q * stride; const f32x4* xr = (const f32x4*)(c.x + (size_t)((tok < T) ? tok : tok0) * D) + lane;
#pragma unroll
              for (int j = 0; j < 4; ++j) v[q][j] = xr[64 * j]; }
#pragma unroll
          for (int q = 0; q < 4; ++q) { const int tok = tok0 + q * stride; if (tok < T) { uint2* o = (uint2*)(hb + (size_t)tok * D) + lane; float s = 0.f;
#pragma unroll
              for (int j = 0; j < 4; ++j) { const f32x4 t = v[q][j]; s += (t.x * t.x + t.y * t.y) + (t.z * t.z + t.w * t.w); o[64 * j] = make_uint2(pk2(t.x, t.y), pk2(t.z, t.w)); }
              s = wave_sum(s); if (lane < 4) ssq[(size_t)tok * 4 + lane] = (lane == 0) ? s : 0.f; } } } }
}


template <int NL> struct CvtGeo { static constexpr int NT = (NL == 8) ? 32 : 64, PER_LAYER = 64 * 16 * NT + 64 * 8 * NT, KQM = (NL == 8) ? 7 : 15, KQS = (NL == 8) ? 3 : 4; };
struct CvtAddr { const float* sp; bf16_t* dp; const float* g; int N, K, n, perm; };
template <int NL> DEV CvtAddr moe_cvt_addr(const Ctx& c, int L0, int idx, int lane) {
    typedef CvtGeo<NL> G_; CvtAddr a; const int Lc = L0 + idx / G_::PER_LAYER; int t = idx % G_::PER_LAYER; const int kq = lane & G_::KQM, n4 = lane >> G_::KQS;
    if (t < 64 * 16 * G_::NT) { const int e = t / (16 * G_::NT), kt = (t / G_::NT) & 15, nt = t % G_::NT; const int k0 = kt * 64 + NL * kq; a.n = nt * (4 * NL) + 4 * n4; a.N = 1024; a.K = D; a.perm = 1;
        a.sp = c.w_gu + ((size_t)(Lc * NE + e) * D + k0) * 1024 + a.n; a.dp = (bf16_t*)(c.ws + WS_WGU) + (size_t)(Lc * NE + e) * 1024 * D + k0; a.g = c.norm_ffn + Lc * D + k0; }
    else { t -= 64 * 16 * G_::NT; const int e = t / (8 * G_::NT), kt = (t / G_::NT) & 7, nt = t % G_::NT; const int k0 = kt * 64 + NL * kq; a.n = nt * (4 * NL) + 4 * n4; a.N = D; a.K = FE; a.perm = 0;
        a.sp = c.w_dn + ((size_t)(Lc * NE + e) * FE + k0) * D + a.n; a.dp = (bf16_t*)(c.ws + WS_WDN) + (size_t)(Lc * NE + e) * D * FE + k0; a.g = nullptr; }
    return a;
}
template <int NL> DEV void moe_cvt_issue(const Ctx& c, int L0, int idx, int lane, f32x4 (&v)[NL], f32x4 (&gv)[NL / 4]) {
    const CvtAddr a = moe_cvt_addr<NL>(c, L0, idx, lane);
#pragma unroll
    for (int j = 0; j < NL; ++j) v[j] = *(const f32x4*)(a.sp + (size_t)j * a.N);
#pragma unroll
    for (int j = 0; j < NL / 4; ++j) gv[j] = a.g ? *(const f32x4*)(a.g + 4 * j) : (f32x4){1.f, 1.f, 1.f, 1.f};
}
template <int NL> DEV void moe_cvt_finish(const Ctx& c, int L0, int idx, int lane, const f32x4 (&v)[NL], const f32x4 (&gv)[NL / 4]) {
    const CvtAddr a = moe_cvt_addr<NL>(c, L0, idx, lane);
#pragma unroll
    for (int jj = 0; jj < 4; ++jj) { int nn = a.n + jj;
        if (a.perm) { if (nn < 512) nn = 256 * (nn >> 7) + (nn & 127); else { const int q = nn - 512; nn = 256 * (q >> 7) + 128 + (q & 127); } }
        unsigned w[NL / 2];
#pragma unroll
        for (int j = 0; j < NL / 2; ++j) w[j] = cvt_pk_bf16(v[2 * j][jj] * gv[(2 * j) >> 2][(2 * j) & 3], v[2 * j + 1][jj] * gv[(2 * j + 1) >> 2][(2 * j + 1) & 3]);
        if constexpr (NL == 8) { u32x4 ww; ww.x = w[0]; ww.y = w[1]; ww.z = w[2]; ww.w = w[3]; *(u32x4*)(a.dp + (size_t)nn * a.K) = ww; }
        else { u32x2 ww; ww.x = w[0]; ww.y = w[1]; *(u32x2*)(a.dp + (size_t)nn * a.K) = ww; } }
}
struct CvtHost { int nxt, pend, step, total, L0; };
#define CVT_TICK(NL, H, c, lane, v, gv) do { if ((H).pend >= 0) { moe_cvt_finish<NL>(c, (H).L0, (H).pend, lane, v, gv); (H).pend = -1; } \
        if ((H).nxt < (H).total) { moe_cvt_issue<NL>(c, (H).L0, (H).nxt, lane, v, gv); (H).pend = (H).nxt; (H).nxt += (H).step; } } while (0)
#define CVT_DRAIN(NL, H, c, lane, v, gv) do { asm volatile("s_waitcnt vmcnt(0)" ::: "memory"); if ((H).pend >= 0) { moe_cvt_finish<NL>(c, (H).L0, (H).pend, lane, v, gv); (H).pend = -1; } \
        while ((H).nxt < (H).total) { f32x4 v1_[NL], g1_[NL / 4], v2_[NL], g2_[NL / 4], v3_[NL], g3_[NL / 4]; const int i0_ = (H).nxt, i1_ = i0_ + (H).step, i2_ = i1_ + (H).step, i3_ = i2_ + (H).step; \
            moe_cvt_issue<NL>(c, (H).L0, i0_, lane, v, gv); if (i1_ < (H).total) moe_cvt_issue<NL>(c, (H).L0, i1_, lane, v1_, g1_); if (i2_ < (H).total) moe_cvt_issue<NL>(c, (H).L0, i2_, lane, v2_, g2_); \
            if (i3_ < (H).total) moe_cvt_issue<NL>(c, (H).L0, i3_, lane, v3_, g3_); \
            moe_cvt_finish<NL>(c, (H).L0, i0_, lane, v, gv); if (i1_ < (H).total) moe_cvt_finish<NL>(c, (H).L0, i1_, lane, v1_, g1_); if (i2_ < (H).total) moe_cvt_finish<NL>(c, (H).L0, i2_, lane, v2_, g2_); \
            if (i3_ < (H).total) moe_cvt_finish<NL>(c, (H).L0, i3_, lane, v3_, g3_); (H).nxt = i3_ + (H).step; } } while (0)

typedef short s16x4 __attribute__((ext_vector_type(4)));
typedef short v4i16_t __attribute__((ext_vector_type(4)));
DEV s16x4 vtr(const LAS unsigned char* p) { return __builtin_bit_cast(s16x4, __builtin_amdgcn_ds_read_tr16_b64_v4i16((LAS v4i16_t*)p)); }
DEV void glds16(const void* g, LAS unsigned char* l) { __builtin_amdgcn_global_load_lds((const unsigned*)g, (LAS unsigned*)l, 16, 0, 0); }
DEV float xhalf_max(float v) { auto rr = __builtin_amdgcn_permlane32_swap(__float_as_uint(v), __float_as_uint(v), false, false); return fmaxf(__uint_as_float(rr[0]), __uint_as_float(rr[1])); }
DEV float xhalf_sum(float v) { auto rr = __builtin_amdgcn_permlane32_swap(__float_as_uint(v), __float_as_uint(v), false, false); return __uint_as_float(rr[0]) + __uint_as_float(rr[1]); }
DEV bf16x8 pack8(const f32x16& p, int s8) {
    u32x4 w; w.x = cvt_pk_bf16(p[s8], p[s8 + 1]); w.y = cvt_pk_bf16(p[s8 + 2], p[s8 + 3]); w.z = cvt_pk_bf16(p[s8 + 4], p[s8 + 5]); w.w = cvt_pk_bf16(p[s8 + 6], p[s8 + 7]);
    return __builtin_bit_cast(bf16x8, w);
}
#define ATT_WAITV(n) asm volatile("s_waitcnt vmcnt(" #n ")" ::: "memory")
#define ATT_BAR() asm volatile("s_waitcnt lgkmcnt(0)\n\ts_barrier" ::: "memory")
#define MFMA32(a, b, c) __builtin_amdgcn_mfma_f32_32x32x16_bf16((a), (b), (c), 0, 0, 0)

DEV void attB_stage(const bf16_t* kvb, int t, LAS unsigned char* buf, int wid, int lane) {
    if (wid < 4) { const int cc = wid >> 1;
#pragma unroll
        for (int j = 0; j < 4; ++j) { const int kk = (wid & 1) * 4 + j, row = 8 * kk + (lane >> 3), ch = (lane & 7) ^ ((row >> 1) & 7);
            glds16(kvb + hm(16 + cc, 64 * t + row) + ch * 8, buf + cc * 8192 + kk * 1024); }
    } else {
#pragma unroll
        for (int j = 0; j < 4; ++j) { const int kk = (wid - 4) * 4 + j, row = 4 * kk + (lane >> 4), ch = (lane & 15) ^ ((row & 3) << 2);
            glds16(kvb + hm(32 + (ch >> 3), 64 * t + row) + (ch & 7) * 8, buf + 16384 + kk * 1024); }
    }
}
DEV void attB_kmax(const Ctx& c) {
    const int tid_ = opaque_tid(); const int w = tid_ >> 6, lane = tid_ & 63;
    const bf16_t* qkv = (const bf16_t*)(c.ws + WS_QKV); float* km = (float*)(c.ws + WS_KMAX);
    for (int it = blockIdx.x * NWAVES + w; it < 8 * 8 * 2 * 64; it += c.G * NWAVES) {
        const int t = it & 63, cc = (it >> 6) & 1, h = (it >> 7) & 7, b = it >> 10;
        const uint4* kp = (const uint4*)(qkv + hm(16 + 2 * h + cc, b * SEQ + 64 * t + lane)); float s = 0.f;
#pragma unroll
        for (int j = 0; j < 8; ++j) { const uint4 v = kp[j]; const unsigned ws_[4] = {v.x, v.y, v.z, v.w};
#pragma unroll
            for (int k = 0; k < 4; ++k) { const float a = bf2f(ws_[k] & 0xffffu), bq = bf2f(ws_[k] >> 16); s += a * a + bq * bq; } }
        s = wave_max(s);
        if (lane == 0) km[it] = sqrtf(s) * 1.01f;
    }
}
DEV void attB_fast(const Ctx& c, float lam, float lambda_init, const float* subln, LAS unsigned char* lds) {
    const int tid = opaque_tid(), wid = __builtin_amdgcn_readfirstlane(tid >> 6), lane = tid & 63, r = lane & 31, hh = lane >> 5;
    const int qt = wid & 3, cc = wid >> 2;
    const bf16_t* qkv = (const bf16_t*)(c.ws + WS_QKV); bf16_t* o = (bf16_t*)(c.ws + WS_O);
    const int vcu = (c.G % 8 == 0) ? ((int)blockIdx.x % 8) * (c.G / 8) + (int)blockIdx.x / 8 : (int)blockIdx.x;
    int koff[4], voff[4];
#pragma unroll
    for (int ds = 0; ds < 4; ++ds) koff[ds] = r * 128 + (((2 * ds + hh) ^ ((r >> 1) & 7)) << 4);
    { const int i16 = lane & 15, qp = i16 >> 2, pp = i16 & 3, blk = (lane >> 4) & 1;
#pragma unroll
      for (int db = 0; db < 4; ++db) voff[db] = (4 * hh + qp) * 256 + 8 * (pp & 1) + ((((db ^ qp) << 2) + 2 * blk + (pp >> 1)) << 4); }
    CvtHost H; H.L0 = 1; H.total = 2 * CvtGeo<4>::PER_LAYER; H.step = c.G * NWAVES; H.nxt = (int)blockIdx.x * NWAVES + wid; H.pend = -1; f32x4 cv[4], cg[1];
    LAS unsigned* flags = (LAS unsigned*)(lds + TBL_RED);
    const float* kmaxp = (const float*)(c.ws + WS_KMAX);
    for (int pu = vcu; pu < 1024; pu += c.G) {
        const int iu = pu >> 8, vq = pu & 255, g16 = (vq >> 4) & 15, s = vq & 15, b = g16 >> 1;
        const int h = (g16 & 1) ? ((iu == 0) ? 6 : (iu == 1) ? 1 : (iu == 2) ? 0 : 5) : ((iu == 0) ? 7 : (iu == 1) ? 2 : (iu == 2) ? 3 : 4);
        float kms = kmaxp[((b * 8 + h) * 2 + cc) * 64 + lane];
#pragma unroll
        for (int d = 1; d < 64; d <<= 1) { const float v = __shfl_up(kms, d); if (lane >= d) kms = fmaxf(kms, v); }
        const float slope2 = exp2f(-(float)(h + 1)) * LOG2E;
        f32x16 Bt;
#pragma unroll
        for (int i = 0; i < 16; ++i) Bt[i] = slope2 * (float)(crow(i, hh) - r);
        const bf16_t* kvb = qkv + hm(2 * h, b * SEQ);
        for (int half = 0; half < 2; ++half) {
            const int qb = half ? 31 - s : s, Q0 = qb * 128, Tn = 2 * qb + 2, qrow0 = Q0 + 32 * qt;
            attB_stage(kvb, Tn - 1, lds, wid, lane);
            ATT_BAR();
            float qn = 0.f;
            LAS unsigned char* const qlds = lds + 98304 + wid * 4096 + lane * 16;
            { const bf16_t* qp_ = kvb + hm(cc, qrow0 + r) + 8 * hh;
#pragma unroll
              for (int ds = 0; ds < 4; ++ds) { const bf16x8 qv = *(const bf16x8*)(qp_ + 16 * ds); *(LAS bf16x8*)(qlds + ds * 1024) = qv;
#pragma unroll
                  for (int j = 0; j < 8; ++j) { const float v = bf2f((unsigned)(unsigned short)qv[j]); qn += v * v; } } }
            attB_stage(kvb, Tn - 2, lds + 32768, wid, lane);
            qn = sqrtf(xhalf_sum(qn)) * 1.01f;
            if (lane == 0) { flags[wid] = 1u; flags[8 + wid] = 1u; }
            int par = 0;
            f32x16 O[4];
#pragma unroll
            for (int db = 0; db < 4; ++db)
#pragma unroll
                for (int i = 0; i < 16; ++i) O[db][i] = 0.f;
            float m = -1e30f, l = 0.f; int bi = 0;
            for (int t = Tn - 1; t >= 0; --t) {
                ATT_WAITV(0);
                ATT_BAR();
                { unsigned al = 0u;
#pragma unroll
                  for (int k = 0; k < 8; ++k) al |= flags[par * 8 + k];
                  if (__builtin_amdgcn_readfirstlane(al) == 0u) break; }
                if ((par & 1) == 0) CVT_TICK(4, H, c, lane, cv, cg);
                if (t >= 2) attB_stage(kvb, t - 2, lds + ((bi + 2) % 3) * 32768, wid, lane);
                if (64 * t <= qrow0) {
                    const LAS unsigned char* Kb = lds + bi * 32768 + cc * 8192; const LAS unsigned char* Vb = lds + bi * 32768 + 16384;
                    f32x16 p0 = Bt, p1 = Bt;
#pragma unroll
                    for (int ds = 0; ds < 4; ++ds) { const bf16x8 k0 = *(const LAS bf16x8*)(Kb + koff[ds]), k1 = *(const LAS bf16x8*)(Kb + 4096 + koff[ds]), qv = *(const LAS bf16x8*)(qlds + ds * 1024); p0 = MFMA32(k0, qv, p0); p1 = MFMA32(k1, qv, p1); }
                    const float off0 = slope2 * (float)(64 * t - qrow0), off1 = off0 + 32.f * slope2;
                    if (64 * t + 63 > qrow0) {
#pragma unroll
                        for (int i = 0; i < 16; ++i) { const int key = 64 * t + crow(i, hh); if (key > qrow0 + r) p0[i] = -INFINITY; if (key + 32 > qrow0 + r) p1[i] = -INFINITY; } }
                    float mx0 = p0[0], mx1 = p1[0];
#pragma unroll
                    for (int i = 1; i < 16; ++i) { mx0 = fmaxf(mx0, p0[i]); mx1 = fmaxf(mx1, p1[i]); }
                    const float mx = xhalf_max(fmaxf(mx0 + off0, mx1 + off1));
                    if (__any(mx > m + 8.f)) { const float mn = fmaxf(m, mx), f = __builtin_amdgcn_exp2f(m - mn); l *= f; m = mn;
#pragma unroll
                        for (int db = 0; db < 4; ++db)
#pragma unroll
                            for (int i = 0; i < 16; ++i) O[db][i] *= f; }
                    const float e0 = off0 - m, e1 = off1 - m; float ls = 0.f;
#pragma unroll
                    for (int i = 0; i < 16; ++i) { p0[i] = __builtin_amdgcn_exp2f(p0[i] + e0); p1[i] = __builtin_amdgcn_exp2f(p1[i] + e1); ls += p0[i] + p1[i]; }
                    l += ls;
                    bf16x8 pa[4]; pa[0] = pack8(p0, 0); pa[1] = pack8(p0, 8); pa[2] = pack8(p1, 0); pa[3] = pack8(p1, 8);
#pragma unroll
                    for (int db = 0; db < 4; ++db) { const unsigned va = (unsigned)(uintptr_t)(Vb + voff[db]); s16x4 lo[4], hi[4];
#pragma unroll
                        for (int ks = 0; ks < 4; ++ks) { asm volatile("ds_read_b64_tr_b16 %0, %1 offset:%c2" : "=&v"(lo[ks]) : "v"(va), "i"(ks * 4096) : "memory");
                                                         asm volatile("ds_read_b64_tr_b16 %0, %1 offset:%c2" : "=&v"(hi[ks]) : "v"(va), "i"(ks * 4096 + 2048) : "memory"); }
                        asm volatile("s_waitcnt lgkmcnt(0)" ::: "memory"); __builtin_amdgcn_sched_barrier(0);
#pragma unroll
                        for (int ks = 0; ks < 4; ++ks) { const bf16x8 vf = (bf16x8){lo[ks][0], lo[ks][1], lo[ks][2], lo[ks][3], hi[ks][0], hi[ks][1], hi[ks][2], hi[ks][3]}; O[db] = MFMA32(vf, pa[ks], O[db]); } }
                }
                bi = (bi + 1) % 3; par ^= 1;
                if (t >= 1) { const float kb = __builtin_amdgcn_readlane(kms, t - 1);
                    const float ub = qn * kb + slope2 * (float)(64 * (t - 1) + 63 - (qrow0 + r)) - m;
                    const bool alive = __any(ub > -36.f); if (lane == 0) flags[par * 8 + wid] = alive ? 1u : 0u; }
            }
            ATT_WAITV(0);
            l = xhalf_sum(l);
            ATT_BAR();
            LAS float* X = (LAS float*)(lds + 65536) + qt * 4096;
            if (cc == 1) { const float sc = lam / l;
#pragma unroll
                for (int db = 0; db < 4; ++db)
#pragma unroll
                    for (int i = 0; i < 16; ++i) X[(db * 16 + i) * 64 + lane] = O[db][i] * sc; }
            ATT_BAR();
            if (cc == 0) { const float inv = 1.f / l; float ss = 0.f;
#pragma unroll
                for (int db = 0; db < 4; ++db)
#pragma unroll
                    for (int i = 0; i < 16; ++i) { const float v = O[db][i] * inv - X[(db * 16 + i) * 64 + lane]; O[db][i] = v; ss += v * v; }
                ss = xhalf_sum(ss); const float rs = rsqrtf(ss * (1.f / 128.f) + EPS) * (1.f - lambda_init);
                bf16_t* op = o + (size_t)(b * SEQ + qrow0 + r) * D + h * 128 + 4 * hh;
#pragma unroll
                for (int db = 0; db < 4; ++db)
#pragma unroll
                    for (int g = 0; g < 4; ++g) { const int d = 32 * db + 8 * g; const f32x4 sl = *(const f32x4*)(subln + d + 4 * hh);
                        u32x2 w; w.x = cvt_pk_bf16(O[db][4 * g] * rs * sl[0], O[db][4 * g + 1] * rs * sl[1]); w.y = cvt_pk_bf16(O[db][4 * g + 2] * rs * sl[2], O[db][4 * g + 3] * rs * sl[3]);
                        *(u32x2*)(op + d) = w; } }
        }
    }
    CVT_DRAIN(4, H, c, lane, cv, cg);
    ATT_WAITV(0);
    ATT_BAR();
}

DEV void attC_stage(const bf16_t* kvb, int t, LAS unsigned char* buf, int wid, int lane) {
    const int row = 8 * wid + (lane >> 3);
    glds16(kvb + hm(16, 64 * t + row) + (((lane & 7) ^ ((row >> 1) & 7)) << 3), buf + wid * 1024);
    glds16(kvb + hm(32, 64 * t + row) + (((lane & 7) ^ (((row >> 1) & 1) << 2)) << 3), buf + 8192 + wid * 1024);
}
DEV float sb_scan(const f32x16& w, f32x16& a, float Rin, int hh) {
    float ex[16], gp[4], gq[4];
#pragma unroll
    for (int g = 0; g < 4; ++g) { const float t23 = w[4 * g + 2] * w[4 * g + 3], s0 = w[4 * g + 1] * t23; gp[g] = w[4 * g] * s0; ex[4 * g] = s0; ex[4 * g + 1] = t23; ex[4 * g + 2] = w[4 * g + 3]; ex[4 * g + 3] = 1.f; }
    float pp[4];
#pragma unroll
    for (int g = 0; g < 4; ++g) { auto rr = __builtin_amdgcn_permlane32_swap(__float_as_uint(gp[g]), __float_as_uint(gp[g]), false, false);
        const float lo = __uint_as_float(rr[0]), hi = __uint_as_float(rr[1]); pp[g] = lo * hi; gq[g] = hh ? 1.f : hi; }
    float Q[4]; Q[3] = 1.f; Q[2] = pp[3]; Q[1] = pp[2] * Q[2]; Q[0] = pp[1] * Q[1];
    const float tot = pp[0] * Q[0];
#pragma unroll
    for (int g = 0; g < 4; ++g) { const float base = Rin * Q[g] * gq[g];
#pragma unroll
        for (int j = 0; j < 4; ++j) a[4 * g + j] = a[4 * g + j] * (base * ex[4 * g + j]); }
    return tot;
}
DEV void attC_fast(const Ctx& c, LAS unsigned char* lds) {
    const int tid = opaque_tid(), wid = __builtin_amdgcn_readfirstlane(tid >> 6), lane = tid & 63, r = lane & 31, hh = lane >> 5;
    const bf16_t* qkv = (const bf16_t*)(c.ws + WS_QKV); bf16_t* o = (bf16_t*)(c.ws + WS_O);
    const int vcu = (c.G % 8 == 0) ? ((int)blockIdx.x % 8) * (c.G / 8) + (int)blockIdx.x / 8 : (int)blockIdx.x;
    CvtHost H; H.L0 = 3; H.total = CvtGeo<8>::PER_LAYER; H.step = c.G * NWAVES; H.nxt = (int)blockIdx.x * NWAVES + wid; H.pend = -1; f32x4 cv[8], cg[2];
    LAS unsigned* flags = (LAS unsigned*)(lds + 49152);
    int koff[4], voff[2];
#pragma unroll
    for (int ds = 0; ds < 4; ++ds) koff[ds] = r * 128 + (((2 * ds + hh) ^ ((r >> 1) & 7)) << 4);
    { const int i16 = lane & 15, qp = i16 >> 2, pp = i16 & 3, blk = (lane >> 4) & 1;
#pragma unroll
      for (int db = 0; db < 2; ++db) voff[db] = (4 * hh + qp) * 128 + 8 * (pp & 1) + (((4 * (db ^ (qp >> 1))) + 2 * blk + (pp >> 1)) << 4); }
    for (int un = vcu; un < 2048; un += c.G) {
        const int bh = un >> 4, qb = un & 15, b = bh >> 4, h = bh & 15;
        const bf16_t* kvb = qkv + hm(h, b * SEQ);
        const int Q0 = qb * 256, qrow0 = Q0 + 32 * wid, T1 = Q0 / 64 + 3;
        attC_stage(kvb, T1, lds, wid, lane);
        bf16x8 qf[4];
        { const bf16_t* qp_ = kvb + hm(0, qrow0 + r) + 8 * hh;
#pragma unroll
          for (int ds = 0; ds < 4; ++ds) qf[ds] = *(const bf16x8*)(qp_ + 16 * ds); }
        attC_stage(kvb, T1 - 1, lds + 16384, wid, lane);
        f32x16 O[2];
#pragma unroll
        for (int db = 0; db < 2; ++db)
#pragma unroll
            for (int i = 0; i < 16; ++i) O[db][i] = 0.f;
        float R = 1.f; int bi = 0, par = 0;
        if (lane == 0) { flags[wid] = 1u; flags[8 + wid] = 1u; }
        for (int t = T1; t >= 0; --t) {
            ATT_WAITV(0);
            ATT_BAR();
            { unsigned al = 0u;
#pragma unroll
              for (int k = 0; k < 8; ++k) al |= flags[par * 8 + k];
              if (__builtin_amdgcn_readfirstlane(al) == 0u) break; }
            CVT_TICK(8, H, c, lane, cv, cg);
            if (t >= 2) attC_stage(kvb, t - 2, lds + ((bi + 2) % 3) * 16384, wid, lane);
            if (64 * t < qrow0 + 31) {
                const LAS unsigned char* Kb = lds + bi * 16384; const LAS unsigned char* Vb = Kb + 8192;
                f32x16 p0, p1;
#pragma unroll
                for (int i = 0; i < 16; ++i) { p0[i] = 0.f; p1[i] = 0.f; }
#pragma unroll
                for (int ds = 0; ds < 4; ++ds) { const bf16x8 k0 = *(const LAS bf16x8*)(Kb + koff[ds]), k1 = *(const LAS bf16x8*)(Kb + 4096 + koff[ds]); p0 = MFMA32(k0, qf[ds], p0); p1 = MFMA32(k1, qf[ds], p1); }
                const bool diag = 64 * t + 63 >= qrow0;
                f32x16 w0, w1;
#pragma unroll
                for (int i = 0; i < 16; ++i) {
                    const float E0 = __builtin_amdgcn_exp2f(fminf(p0[i], 60.f)), E1 = __builtin_amdgcn_exp2f(fminf(p1[i], 60.f));
                    float v0 = __builtin_amdgcn_rcpf(1.f + E0), v1 = __builtin_amdgcn_rcpf(1.f + E1); float b0 = E0 * v0, b1 = E1 * v1;
                    if (diag) { const int key = 64 * t + crow(i, hh); if (key >= qrow0 + r) { v0 = 1.f; b0 = 0.f; } if (key + 32 >= qrow0 + r) { v1 = 1.f; b1 = 0.f; } }
                    w0[i] = v0; w1[i] = v1; p0[i] = b0; p1[i] = b1; }
                const float tot1 = sb_scan(w1, p1, R, hh);
                const float R1 = R * tot1;
                const float tot0 = sb_scan(w0, p0, R1, hh);
                R = R1 * tot0;
                bf16x8 pa[4]; pa[0] = pack8(p0, 0); pa[1] = pack8(p0, 8); pa[2] = pack8(p1, 0); pa[3] = pack8(p1, 8);
#pragma unroll
                for (int db = 0; db < 2; ++db) { const unsigned va = (unsigned)(uintptr_t)(Vb + voff[db]); s16x4 lo[4], hi[4];
#pragma unroll
                    for (int ks = 0; ks < 4; ++ks) { asm volatile("ds_read_b64_tr_b16 %0, %1 offset:%c2" : "=&v"(lo[ks]) : "v"(va), "i"(ks * 2048) : "memory");
                                                     asm volatile("ds_read_b64_tr_b16 %0, %1 offset:%c2" : "=&v"(hi[ks]) : "v"(va), "i"(ks * 2048 + 1024) : "memory"); }
                    asm volatile("s_waitcnt lgkmcnt(0)" ::: "memory"); __builtin_amdgcn_sched_barrier(0);
#pragma unroll
                    for (int ks = 0; ks < 4; ++ks) { const bf16x8 vf = (bf16x8){lo[ks][0], lo[ks][1], lo[ks][2], lo[ks][3], hi[ks][0], hi[ks][1], hi[ks][2], hi[ks][3]}; O[db] = MFMA32(vf, pa[ks], O[db]); } }
            }
            par ^= 1;
            { const bool alive = __any(R > 8.6736174e-19f); if (lane == 0) flags[par * 8 + wid] = alive ? 1u : 0u; }
            bi = (bi + 1) % 3;
        }
        ATT_WAITV(0);
        bf16_t* op = o + (size_t)(b * SEQ + qrow0 + r) * D + h * 64 + 4 * hh;
#pragma unroll
        for (int db = 0; db < 2; ++db)
#pragma unroll
            for (int g = 0; g < 4; ++g) { u32x2 wv; wv.x = cvt_pk_bf16(O[db][4 * g], O[db][4 * g + 1]); wv.y = cvt_pk_bf16(O[db][4 * g + 2], O[db][4 * g + 3]); *(u32x2*)(op + 32 * db + 8 * g) = wv; }
        ATT_BAR();
    }
    CVT_DRAIN(8, H, c, lane, cv, cg);
    ATT_WAITV(0);
}

struct AUnit { int b, h, g, cres, rr, i0; };
DEV AUnit attA_unit(int un, int g) {
    AUnit u; const int bh = un >> 4, j = un & 15; u.b = bh >> 4; u.h = bh & 15; u.g = g;
    int m; if (g == 0) { u.cres = 0; m = j; } else if (g == 1) { u.cres = j >> 2; m = j & 3; } else { u.cres = j; m = 0; }
    u.rr = (g == 0) ? 1 : (g == 1 ? 4 : 16); u.i0 = m * 256; return u;
}
DEV void attA_fast(const Ctx& c, int grp, LAS unsigned char* lds) {
    const int tid = opaque_tid(), wid = __builtin_amdgcn_readfirstlane(tid >> 6), lane = tid & 63, r = lane & 31, hh = lane >> 5;
    const bf16_t* qkv = (const bf16_t*)(c.ws + WS_QKV + (size_t)(grp & 1) * 208 * MiB); bf16_t* og = (bf16_t*)(c.ws + WS_OG); float* lse = (float*)(c.ws + WS_LSE); bf16_t* omerged = (bf16_t*)(c.ws + WS_O);
    const int vcu = (c.G % 8 == 0) ? ((int)blockIdx.x % 8) * (c.G / 8) + (int)blockIdx.x / 8 : (int)blockIdx.x;
    int koff[4], voff[2];
#pragma unroll
    for (int ds = 0; ds < 4; ++ds) koff[ds] = r * 128 + (((2 * ds + hh) ^ ((r >> 1) & 7)) << 4);
    { const int i16 = lane & 15, qp = i16 >> 2, pp = i16 & 3, blk = (lane >> 4) & 1;
#pragma unroll
      for (int db = 0; db < 2; ++db) voff[db] = (4 * hh + qp) * 128 + 8 * (pp & 1) + (((4 * (db ^ (qp >> 1))) + 2 * blk + (pp >> 1)) << 4); }
    LAS unsigned char* const Kb = lds; LAS unsigned char* const Vb = lds + 49152;
    LAS unsigned char* const Qw = lds + 98304 + wid * 4096;
#define ATTA_LOAD_KQ(U) do { const bf16_t* base_ = qkv + hm((U).h, (U).b * SEQ); \
        _Pragma("unroll") for (int k = 0; k < 6; ++k) { const int row = 8 * (6 * wid + k) + (lane >> 3); int ik = (U).i0 - 128 + row; ik = ik < 0 ? 0 : ik; \
            glds16(base_ + hm(16, ik * (U).rr + (U).cres) + (((lane & 7) ^ ((row >> 1) & 7)) << 3), Kb + (6 * wid + k) * 1024); } \
        } while (0)
#define ATTA_LOAD_Q(U) do { const bf16_t* qp_ = qkv + hm((U).h, (U).b * SEQ) + hm(0, ((U).i0 + 32 * wid + r) * (U).rr + (U).cres) + 8 * hh; \
        _Pragma("unroll") for (int ds = 0; ds < 4; ++ds) glds16(qp_ + 16 * ds, Qw + ds * 1024); } while (0)
    int un = vcu;
    AUnit u = attA_unit(un < 2048 ? un : 0, grp);
    if (un < 2048) { ATTA_LOAD_KQ(u); ATTA_LOAD_Q(u); }
    for (; un < 2048; un += c.G) {
        const int unn = un + c.G; const AUnit nu = attA_unit(unn < 2048 ? unn : 0, grp);
        const bf16_t* base = qkv + hm(u.h, u.b * SEQ);
        ATT_WAITV(0);
        ATT_BAR();
#pragma unroll
        for (int k = 0; k < 6; ++k) { const int row = 8 * (6 * wid + k) + (lane >> 3); int ik = u.i0 - 128 + row; ik = ik < 0 ? 0 : ik;
            glds16(base + hm(32, ik * u.rr + u.cres) + (((lane & 7) ^ (((row >> 1) & 1) << 2)) << 3), Vb + (6 * wid + k) * 1024); }
        const int tokq = u.b * SEQ + (u.i0 + 32 * wid + r) * u.rr + u.cres;
        const float sr = exp2f(-0.5f * (float)(u.h + 1)) * LOG2E * (float)u.rr;
        f32x16 S[5];
#pragma unroll
        for (int sidx = 0; sidx < 5; ++sidx) {
#pragma unroll
            for (int i = 0; i < 16; ++i) S[sidx][i] = sr * (float)(crow(i, hh) - r + 32 * sidx - 128);
            if (u.i0 + 32 * wid - 128 + 32 * sidx >= 0) {
                const LAS unsigned char* kb = Kb + (32 * (wid + sidx)) * 128;
#pragma unroll
                for (int ds = 0; ds < 4; ++ds) { const bf16x8 kf = *(const LAS bf16x8*)(kb + koff[ds]), qv = *(const LAS bf16x8*)(Qw + ds * 1024 + lane * 16); S[sidx] = MFMA32(kf, qv, S[sidx]); }
                if (sidx == 0) {
#pragma unroll
                    for (int i = 0; i < 16; ++i) if (crow(i, hh) < r) S[sidx][i] = -INFINITY; }
                if (sidx == 4) {
#pragma unroll
                    for (int i = 0; i < 16; ++i) if (crow(i, hh) > r) S[sidx][i] = -INFINITY; }
            } else {
#pragma unroll
                for (int i = 0; i < 16; ++i) S[sidx][i] = -INFINITY; }
        }
        float mx = S[0][0];
#pragma unroll
        for (int sidx = 0; sidx < 5; ++sidx)
#pragma unroll
            for (int i = 0; i < 16; ++i) mx = fmaxf(mx, S[sidx][i]);
        mx = xhalf_max(mx);
        float l = 0.f; bf16x8 pa[5][2];
#pragma unroll
        for (int sidx = 0; sidx < 5; ++sidx) {
#pragma unroll
            for (int i = 0; i < 16; ++i) { S[sidx][i] = __builtin_amdgcn_exp2f(S[sidx][i] - mx); l += S[sidx][i]; }
            pa[sidx][0] = pack8(S[sidx], 0); pa[sidx][1] = pack8(S[sidx], 8); }
        l = xhalf_sum(l);
        ATT_WAITV(0);
        ATT_BAR();
        if (unn < 2048) ATTA_LOAD_KQ(nu);
        f32x16 O[2];
#pragma unroll
        for (int db = 0; db < 2; ++db)
#pragma unroll
            for (int i = 0; i < 16; ++i) O[db][i] = 0.f;
#pragma unroll
        for (int sidx = 0; sidx < 5; ++sidx) {
            if (u.i0 + 32 * wid - 128 + 32 * sidx >= 0) {
#pragma unroll
                for (int db = 0; db < 2; ++db) { const unsigned va = (unsigned)(uintptr_t)(Vb + (32 * (wid + sidx)) * 128 + voff[db]); s16x4 lo[2], hi[2];
#pragma unroll
                    for (int ks = 0; ks < 2; ++ks) { asm volatile("ds_read_b64_tr_b16 %0, %1 offset:%c2" : "=&v"(lo[ks]) : "v"(va), "i"(ks * 2048) : "memory");
                                                     asm volatile("ds_read_b64_tr_b16 %0, %1 offset:%c2" : "=&v"(hi[ks]) : "v"(va), "i"(ks * 2048 + 1024) : "memory"); }
                    asm volatile("s_waitcnt lgkmcnt(0)" ::: "memory"); __builtin_amdgcn_sched_barrier(0);
#pragma unroll
                    for (int ks = 0; ks < 2; ++ks) { const bf16x8 vf = (bf16x8){lo[ks][0], lo[ks][1], lo[ks][2], lo[ks][3], hi[ks][0], hi[ks][1], hi[ks][2], hi[ks][3]}; O[db] = MFMA32(vf, pa[sidx][ks], O[db]); } }
            }
        }
        const float inv = 1.f / l;
#pragma unroll
        for (int db = 0; db < 2; ++db)
#pragma unroll
            for (int q4 = 0; q4 < 4; ++q4) { u32x2 wv; wv.x = cvt_pk_bf16(O[db][4 * q4] * inv, O[db][4 * q4 + 1] * inv); wv.y = cvt_pk_bf16(O[db][4 * q4 + 2] * inv, O[db][4 * q4 + 3] * inv);
                *(LAS u32x2*)(Qw + r * 128 + (((4 * db + q4) ^ (r & 7)) << 4) + 8 * hh) = wv; }
        const float lse2 = mx + __builtin_amdgcn_logf(l);
        if (grp == 2 && hh == 0) ((LAS float*)(lds + TBL_OFF))[wid * 32 + r] = lse2;
        asm volatile("s_waitcnt lgkmcnt(0)" ::: "memory");
#pragma unroll
        for (int ps = 0; ps < 4; ++ps) { const int row = (lane >> 3) + 8 * ps; const u32x4 vv = *(const LAS u32x4*)(Qw + row * 128 + (((lane & 7) ^ (row & 7)) << 4));
            const int tk = u.b * SEQ + (u.i0 + 32 * wid + row) * u.rr + u.cres; const size_t oo = (size_t)tk * D + u.h * 64 + (lane & 7) * 8;
            if (grp < 2) { *(u32x4*)(og + (size_t)u.g * T * D + oo) = vv; }
            else { const float l0 = lse[(size_t)tk * 16 + u.h], l1 = lse[(size_t)T * 16 + (size_t)tk * 16 + u.h], l2 = ((const LAS float*)(lds + TBL_OFF))[wid * 32 + row];
                const float mm = fmaxf(l0, fmaxf(l1, l2)); const float e0 = __builtin_amdgcn_exp2f(l0 - mm), e1 = __builtin_amdgcn_exp2f(l1 - mm), e2 = __builtin_amdgcn_exp2f(l2 - mm); const float iv = 1.f / (e0 + e1 + e2);
                const float w0 = e0 * iv, w1 = e1 * iv, w2 = e2 * iv;
                const u32x4 x0 = *(const u32x4*)(og + oo), x1 = *(const u32x4*)(og + (size_t)T * D + oo); u32x4 res;
#pragma unroll
                for (int k = 0; k < 4; ++k) { const float lo = w0 * bf2f(x0[k] & 0xffffu) + w1 * bf2f(x1[k] & 0xffffu) + w2 * bf2f(vv[k] & 0xffffu), hi = w0 * bf2f(x0[k] >> 16) + w1 * bf2f(x1[k] >> 16) + w2 * bf2f(vv[k] >> 16); res[k] = cvt_pk_bf16(lo, hi); }
                *(u32x4*)(omerged + oo) = res; } }
        asm volatile("s_waitcnt lgkmcnt(0)" ::: "memory");
        if (unn < 2048) ATTA_LOAD_Q(nu);
        if (grp < 2 && hh == 0) lse[(size_t)u.g * T * 16 + (size_t)tokq * 16 + u.h] = lse2;
        u = nu;
    }
#undef ATTA_LOAD_KQ
#undef ATTA_LOAD_Q
    ATT_WAITV(0);
    ATT_BAR();
}
template <int L, int SH = 0> DEV void phase_router_fast(const Ctx& c, LAS unsigned char* lds) {
    const int tid = opaque_tid(), wid = __builtin_amdgcn_readfirstlane(tid >> 6), lane = tid & 63, fr = lane & 15, fq = lane >> 4;
    LAS float* lg;
    const bf16_t* hbr = (const bf16_t*)(c.ws + WS_HB + (size_t)(L & 1) * 64 * MiB);
    unsigned char* ob = SH ? c.ws + WS_OG : c.ws;
    float* tok_gate = (float*)(ob + (SH ? 0 : WS_TOK)); int* tok_e = (int*)(ob + (SH ? 0 : WS_TOK) + 262144); int* tok_slot = (int*)(ob + (SH ? 0 : WS_TOK) + 524288);
    int* list = (int*)(ob + (SH ? 2 * MiB : WS_LIST)); float* list_rs = (float*)(ob + (SH ? 12 * MiB : WS_LRS)); float* list_gate = (float*)(ob + (SH ? 22 * MiB : WS_LGATE)); unsigned* cnt = ctl(c) + CW_CNT + (SH ? 4 : L) * 64 * CNT_S;
    const bf16_t* wbase = (const bf16_t*)(c.ws + WS_WRH) + (size_t)L * 80 * D;
#define RT_STAGE(ck, bufp) do { _Pragma("unroll") for (int i_ = 0; i_ < 5; ++i_) { const int ii = 5 * wid + i_, part = ii / 20, ri = ii % 20, row = 4 * ri + (lane >> 4); \
        glds16(wbase + (size_t)part * DEPTH * 80 * D + (size_t)row * D + 128 * (ck) + 8 * ((lane & 15) ^ (row & 15)), (bufp) + part * 20480 + ri * 1024); } } while (0)
    lg = (LAS float*)(lds + 81920) + wid * 1344;
    volatile LAS unsigned* lcnt = (volatile LAS unsigned*)(lds + 126976); volatile LAS unsigned* lbase = lcnt + 64;
    if (tid < 64) lcnt[tid] = 0u;
    for (int pass = blockIdx.x; pass < T / 128; pass += c.G) {
        const int tok0 = pass * 128 + wid * 16;
        f32x4 acc[5];
#pragma unroll
        for (int nt = 0; nt < 5; ++nt) acc[nt] = (f32x4){0.f, 0.f, 0.f, 0.f};
        float ssq = 0.f;
        const u32x4* ap8 = (const u32x4*)(hbr + (size_t)(tok0 + fr) * D + 8 * fq);
        RT_STAGE(0, lds);
        for (int ck = 0; ck < 8; ++ck) {
            u32x4 xa[4];
#pragma unroll
            for (int kb = 0; kb < 4; ++kb) xa[kb] = ap8[ck * 16 + kb * 4];
            ATT_WAITV(0);
            ATT_BAR();
            if (ck + 1 < 8) RT_STAGE(ck + 1, lds + ((ck + 1) & 1) * 40960);
            const LAS unsigned char* wb = lds + (ck & 1) * 40960 + fr * 256;
#pragma unroll
            for (int kb = 0; kb < 4; ++kb) {
                { const u32x4 v = xa[kb]; const float e0 = bf2f(v.x & 0xffffu), e1 = bf2f(v.x >> 16), e2 = bf2f(v.y & 0xffffu), e3 = bf2f(v.y >> 16), e4 = bf2f(v.z & 0xffffu), e5 = bf2f(v.z >> 16), e6 = bf2f(v.w & 0xffffu), e7 = bf2f(v.w >> 16);
                  ssq += ((e0 * e0 + e1 * e1) + (e2 * e2 + e3 * e3)) + ((e4 * e4 + e5 * e5) + (e6 * e6 + e7 * e7)); }
                const bf16x8 xhv = __builtin_bit_cast(bf16x8, xa[kb]); const int co = (((4 * kb + fq) ^ fr) << 4);
#pragma unroll
                for (int nt = 0; nt < 5; ++nt) { const bf16x8 wh = *(const LAS bf16x8*)(wb + nt * 4096 + co), wl = *(const LAS bf16x8*)(wb + 20480 + nt * 4096 + co);
                    acc[nt] = __builtin_amdgcn_mfma_f32_16x16x32_bf16(xhv, wh, acc[nt], 0, 0, 0); acc[nt] = __builtin_amdgcn_mfma_f32_16x16x32_bf16(xhv, wl, acc[nt], 0, 0, 0); }
            }
        }
        ssq += __shfl_xor(ssq, 16); ssq += __shfl_xor(ssq, 32);
        const float rs = rsqrtf(ssq * (1.f / D) + EPS);
        if (fq == 0) lg[1280 + fr] = rs;
#pragma unroll
        for (int nt = 0; nt < 5; ++nt)
#pragma unroll
            for (int i = 0; i < 4; ++i) lg[(4 * fq + i) * 80 + 16 * nt + fr] = acc[nt][i];
        wave_lds_fence();
        int e1 = 0, e2i = 0, r1 = 0, r2 = 0; float g1 = 0.f, g2 = 0.f, rsv = 0.f;
        if (lane < 16) { const LAS float* l = lg + lane * 80; rsv = lg[1280 + lane];
            float lc[8]; int gi = 0; float gm = -INFINITY;
#pragma unroll
            for (int j = 0; j < 8; ++j) { lc[j] = l[j] * rsv + c.b_coarse[L * 8 + j]; if (lc[j] > gm) { gm = lc[j]; gi = j; } }
            float gs = 0.f;
#pragma unroll
            for (int j = 0; j < 8; ++j) gs += __expf(lc[j] - gm);
            const float gp = 1.f / gs;
            float f[8];
#pragma unroll
            for (int j = 0; j < 8; ++j) f[j] = l[8 + gi * 8 + j] * rsv + c.b_fine[L * 64 + gi * 8 + j];
            int i1 = 0; float f1 = f[0];
#pragma unroll
            for (int j = 1; j < 8; ++j) if (f[j] > f1) { f1 = f[j]; i1 = j; }
            int i2 = (i1 == 0) ? 1 : 0; float f2 = -INFINITY;
#pragma unroll
            for (int j = 0; j < 8; ++j) if (j != i1 && f[j] > f2) { f2 = f[j]; i2 = j; }
            const float e2 = __expf(f2 - f1); const float p1 = 1.f / (1.f + e2), p2 = e2 / (1.f + e2);
            e1 = gi * 8 + i1; e2i = gi * 8 + i2; g1 = gp * p1; g2 = gp * p2;
            r1 = (int)__hip_atomic_fetch_add((LAS unsigned*)lcnt + e1, 1u, __ATOMIC_RELAXED, __HIP_MEMORY_SCOPE_WORKGROUP); r2 = (int)__hip_atomic_fetch_add((LAS unsigned*)lcnt + e2i, 1u, __ATOMIC_RELAXED, __HIP_MEMORY_SCOPE_WORKGROUP); }
        __syncthreads();
        if (tid < 64) { const unsigned n = lcnt[tid]; lbase[tid] = n ? atomicAdd(cnt + tid * CNT_S, n) : 0u; lcnt[tid] = 0u; }
        __syncthreads();
        if (lane < 16) { const int tok = tok0 + lane; const int s1 = (int)lbase[e1] + r1, s2 = (int)lbase[e2i] + r2; const float gp = 1.f, p1 = g1, p2 = g2;
            list[(size_t)e1 * T + s1] = tok * 2; list[(size_t)e2i * T + s2] = tok * 2 + 1; list_rs[(size_t)e1 * T + s1] = rsv; list_rs[(size_t)e2i * T + s2] = rsv; list_gate[(size_t)e1 * T + s1] = gp * p1; list_gate[(size_t)e2i * T + s2] = gp * p2;
            tok_e[tok * 2] = e1; tok_e[tok * 2 + 1] = e2i; tok_slot[tok * 2] = s1; tok_slot[tok * 2 + 1] = s2; tok_gate[tok * 2] = gp * p1; tok_gate[tok * 2 + 1] = gp * p2; }
        wave_lds_fence();
    }
#undef RT_STAGE
    ATT_WAITV(0);
    ATT_BAR();
}

template <int L, int SH = 0> DEV void phase_combine(const Ctx& c, LAS unsigned char* lds) {
    const int tid_ = opaque_tid(); const int w = tid_ >> 6, lane = tid_ & 63;
    LAS int* tpre = (LAS int*)(lds + TBL_TPRE);
    moe_prefix((const int*)(ctl(c) + CW_CNT + L * 64 * CNT_S), tpre);
    const bf16_t* hsrc = (const bf16_t*)(c.ws + WS_HB + (size_t)(L & 1) * 64 * MiB); bf16_t* hb = SH ? (bf16_t*)(c.ws + WS_OG + 128 * MiB) : (bf16_t*)(c.ws + WS_HB + (size_t)(L & 1) * 64 * MiB);
    float* ssq = SH ? (float*)(c.ws + WS_LSE) : (float*)(c.ws + WS_SSQ + (size_t)(L & 1) * 2 * MiB); const bf16_t* y = (const bf16_t*)(c.ws + WS_Y);
    const int* tok_e = (const int*)(c.ws + WS_TOK + 262144); const int* tok_slot = (const int*)(c.ws + WS_TOK + 524288);
    const int stride = c.G * NWAVES;
    for (int tok0 = blockIdx.x * NWAVES + w; tok0 < T; tok0 += 4 * stride) {
        int e0[4], e1[4], s0[4], s1[4];
#pragma unroll
        for (int q = 0; q < 4; ++q) { const int tok = tok0 + q * stride; const bool ok = tok < T; const int tt = ok ? tok : tok0;
            e0[q] = tok_e[tt * 2]; e1[q] = tok_e[tt * 2 + 1]; s0[q] = tok_slot[tt * 2]; s1[q] = tok_slot[tt * 2 + 1]; }
        u32x4 hv[4][2], ya[4][2], yb[4][2];
#pragma unroll
        for (int q = 0; q < 4; ++q) { const int tok = tok0 + q * stride; const int tt = (tok < T) ? tok : tok0;
            const size_t p0 = (size_t)tpre[e0[q]] * 256 + s0[q], p1 = (size_t)tpre[e1[q]] * 256 + s1[q];
            const u32x4* hs = (const u32x4*)(hsrc + (size_t)tt * D) + lane; const u32x4* y0 = (const u32x4*)(y + p0 * D) + lane; const u32x4* y1 = (const u32x4*)(y + p1 * D) + lane;
#pragma unroll
            for (int j = 0; j < 2; ++j) { hv[q][j] = hs[64 * j]; ya[q][j] = y0[64 * j]; yb[q][j] = y1[64 * j]; } }
#pragma unroll
        for (int q = 0; q < 4; ++q) { const int tok = tok0 + q * stride; if (tok < T) { u32x4* o = (u32x4*)(hb + (size_t)tok * D) + lane; float s = 0.f;
#pragma unroll
            for (int j = 0; j < 2; ++j) { u32x4 r;
#pragma unroll
                for (int k = 0; k < 4; ++k) { const float lo = bf2f(hv[q][j][k] & 0xffffu) + bf2f(ya[q][j][k] & 0xffffu) + bf2f(yb[q][j][k] & 0xffffu), hi = bf2f(hv[q][j][k] >> 16) + bf2f(ya[q][j][k] >> 16) + bf2f(yb[q][j][k] >> 16); r[k] = cvt_pk_bf16(lo, hi); s += lo * lo + hi * hi; }
                o[64 * j] = r; }
            s = wave_sum(s); if (lane < 4) ssq[(size_t)tok * 4 + lane] = (lane == 0) ? s : 0.f; } }
    }
}

DEV void phase_final(const Ctx& c) {
    const int tid_ = opaque_tid(); const int w = tid_ >> 6, lane = tid_ & 63;
    const bf16_t* hb = (const bf16_t*)(c.ws + WS_HB + (size_t)(DEPTH & 1) * 64 * MiB); const float* ssq = (const float*)(c.ws + WS_SSQ + (size_t)(DEPTH & 1) * 2 * MiB);
    const int stride = c.G * NWAVES;
    f32x4 g0[2], g1[2];
#pragma unroll
    for (int j = 0; j < 2; ++j) { const int col = (64 * j + lane) * 8; g0[j] = *(const f32x4*)(c.norm_final + col); g1[j] = *(const f32x4*)(c.norm_final + col + 4); }
    for (int tok0 = blockIdx.x * NWAVES + w; tok0 < T; tok0 += 4 * stride) {
        f32x4 pq[4]; u32x4 hv[4][2];
#pragma unroll
        for (int q = 0; q < 4; ++q) { const int tok = tok0 + q * stride; const int tt = (tok < T) ? tok : tok0; pq[q] = *(const f32x4*)(ssq + (size_t)tt * 4);
            const u32x4* hr = (const u32x4*)(hb + (size_t)tt * D) + lane; hv[q][0] = hr[0]; hv[q][1] = hr[64]; }
#pragma unroll
        for (int q = 0; q < 4; ++q) { const int tok = tok0 + q * stride; if (tok < T) {
            const float a = (pq[q][0] + pq[q][1]) + (pq[q][2] + pq[q][3]); const float rs = rsqrtf(a * (1.f / D) + EPS); f32x4* o = (f32x4*)(c.out + (size_t)tok * D);
#pragma unroll
            for (int j = 0; j < 2; ++j) { const u32x4 v = hv[q][j]; const int col = (64 * j + lane) * 8; f32x4 r0, r1;
                r0[0] = bf2f(v.x & 0xffffu) * rs * g0[j][0]; r0[1] = bf2f(v.x >> 16) * rs * g0[j][1]; r0[2] = bf2f(v.y & 0xffffu) * rs * g0[j][2]; r0[3] = bf2f(v.y >> 16) * rs * g0[j][3];
                r1[0] = bf2f(v.z & 0xffffu) * rs * g1[j][0]; r1[1] = bf2f(v.z >> 16) * rs * g1[j][1]; r1[2] = bf2f(v.w & 0xffffu) * rs * g1[j][2]; r1[3] = bf2f(v.w >> 16) * rs * g1[j][3];
                o[col / 4] = r0; o[col / 4 + 1] = r1; } } }
    }
}

template <int PH, int SUB = 0> DEV void run_phase(const Ctx& c, LAS unsigned char* lds) {
    unsigned char* ws = c.ws;
    if constexpr (PH == 0) { phase_prologue(c, lds); }
    else if constexpr (PH == 41) { phase_final(c); }
    else {
        constexpr int L = (PH - 1) / 10, S = (PH - 1) % 10, KIND = L % 3, J = L / 3;
        constexpr size_t HBC = WS_HB + (size_t)(L & 1) * 64 * MiB, HBN = WS_HB + (size_t)((L + 1) & 1) * 64 * MiB, SQC = WS_SSQ + (size_t)(L & 1) * 2 * MiB, SQN = WS_SSQ + (size_t)((L + 1) & 1) * 2 * MiB;
        if constexpr (S == 0) {
            Prob<0> p; p.headmajor = 1; p.A = (const bf16_t*)(ws + HBC); p.lda = D; p.K = D; p.out = (bf16_t*)(ws + WS_QKV + ((KIND == 0) ? (size_t)(SUB & 1) * 208 * MiB : 0)); p.ssq = (const float*)(ws + SQC);
            if (KIND == 0) { p.Bt = (const bf16_t*)(ws + WS_WAIN) + (size_t)J * NA * D + (size_t)SUB * NB * D; p.N = NB; }   else if (KIND == 1) { p.Bt = (const bf16_t*)(ws + WS_WBIN); p.N = NB; } else { p.Bt = (const bf16_t*)(ws + WS_WCIN); p.N = NB; }
            p.S.init(T, p.N, c.G, blockIdx.x);
            gemm_phase(p, lds);
        } else if constexpr (S == 1) {
            if constexpr (KIND == 0) { attA_fast(c, SUB, lds);
                if constexpr (SUB < 2) { __syncthreads(); run_phase<PH - 1, SUB + 1>(c, lds); } }
            else if constexpr (KIND == 1) {
                const float lambda_init = 0.8f - 0.6f * expf(-0.3f * (float)L);
                float s1 = 0.f, s2 = 0.f; for (int i = 0; i < 64; ++i) { s1 += c.lq1[J * 64 + i] * c.lk1[J * 64 + i]; s2 += c.lq2[J * 64 + i] * c.lk2[J * 64 + i]; }
                const float lam = expf(s1) - expf(s2) + lambda_init;
                attB_fast(c, lam, lambda_init, c.subln + J * 128, lds);
            } else { attC_fast(c, lds); }
        } else if constexpr (S == 2) {
            if constexpr (L == 0) {
                Prob<6> q; q.A = (const bf16_t*)(ws + WS_PB); q.lda = PLE; q.K = PLE; q.N = D; q.Bt = (const bf16_t*)(ws + WS_WPP);
                q.o0 = (bf16_t*)(ws + WS_H);
                q.S.init(3 * T, D, c.G, blockIdx.x);
                gemm_phase(q, lds); }
        } else if constexpr (S == 3) {
            Prob<1> p; p.A = (const bf16_t*)(ws + WS_O); p.lda = D; p.K = D; p.N = D;
            p.Bt = (KIND == 0) ? (const bf16_t*)(ws + WS_WAOUT) + (size_t)J * D * D : (KIND == 1) ? (const bf16_t*)(ws + WS_WBOUT) : (const bf16_t*)(ws + WS_WCOUT);
            p.hin = (const bf16_t*)(ws + HBC); p.hb = (bf16_t*)(ws + HBC); p.ssq = (float*)(ws + SQC);
            if constexpr (SUB == 7) { p.hb = (bf16_t*)(ws + WS_OG + 128 * MiB); p.ssq = (float*)(ws + WS_LSE); }
            p.S.init(T, D, c.G, blockIdx.x);
            gemm_phase(p, lds);
        } else if constexpr (S == 4) {
            phase_router_fast<L, (SUB == 7) ? 1 : 0>(c, lds);
        } else if constexpr (S == 5) {
            LAS int* tpre = (LAS int*)(lds + TBL_TPRE); const int* cnt = (const int*)(ctl(c) + CW_CNT + L * 64 * CNT_S);
            moe_prefix(cnt, tpre);
            Prob<2> p; p.A = (const bf16_t*)(ws + HBC); p.lda = D; p.K = D; p.Bt = (const bf16_t*)(ws + WS_WGU) + (size_t)L * NE * 1024 * D; p.act = (bf16_t*)(ws + WS_ACT);
            p.list = (const int*)(ws + WS_LIST); p.list_rs = (const float*)(ws + WS_LRS); p.S.init(tpre, cnt, c.G, blockIdx.x, 4);
            gemm_phase(p, lds);
        } else if constexpr (S == 6) {
            LAS int* tpre = (LAS int*)(lds + TBL_TPRE); const int* cnt = (const int*)(ctl(c) + CW_CNT + L * 64 * CNT_S);
            moe_prefix(cnt, tpre);
            Prob<3> p; p.A = (const bf16_t*)(ws + WS_ACT); p.lda = FE; p.K = FE; p.Bt = (const bf16_t*)(ws + WS_WDN) + (size_t)L * NE * D * FE; p.y = (bf16_t*)(ws + WS_Y);
            p.list_gate = (const float*)(ws + WS_LGATE); p.S.init(tpre, cnt, c.G, blockIdx.x, 4);
            gemm_phase(p, lds);
        } else if constexpr (S == 7) {
            phase_combine<L, (SUB == 7) ? 1 : 0>(c, lds);
            __syncthreads();
            if constexpr (L == 3) {
            Prob<0> p; p.headmajor = 0; p.ssq = nullptr; p.A = (const bf16_t*)(ws + WS_PB) + (size_t)L * T * PLE; p.lda = PLE; p.K = PLE; p.N = D; p.Bt = (const bf16_t*)(ws + WS_WPP) + (size_t)L * D * PLE; p.out = (bf16_t*)(ws + WS_PROJ);
            p.S.init(T, D, c.G, blockIdx.x);
            gemm_phase(p, lds); }
        } else if constexpr (S == 9) {
            if constexpr (KIND == 1) attB_kmax(c);
        } else if constexpr (S == 8) {
            Prob<5> p; p.A = (const bf16_t*)(ws + HBC); p.lda = D; p.K = D; p.N = D; p.Bt = (const bf16_t*)(ws + WS_WPG) + (size_t)L * D * D; p.proj = (const bf16_t*)(ws + ((L == 0) ? WS_H : (L == 1) ? WS_H + 64 * MiB : WS_PROJ));
            p.hin = (const bf16_t*)(ws + HBC); p.hb = (bf16_t*)(ws + HBN); p.ssq_in = (const float*)(ws + SQC); p.ssq_out = (float*)(ws + SQN);
            if constexpr (SUB == 7) { p.hb = (bf16_t*)(ws + WS_OG + 128 * MiB); p.ssq_out = (float*)(ws + WS_LSE); }
            p.S.init(T, D, c.G, blockIdx.x);
            gemm_phase(p, lds);
        }
    }
}

#define XB_TMO      128
#define XB_XCNT(j)  (256  + 64 * (j))
#define XB_XSUB(j)  (1280 + 64 * (j))
#define XB_XGEN(j)  (2304 + 64 * (j))
#define XB_TOP      3328
#define XB_TOPGEN   3392
#define XCD_BAR_WORDS 3456
#define XB_SPIN_CAP (1u << 18)
__device__ __forceinline__ unsigned xb_ld(unsigned* p)              { return __hip_atomic_load(p, __ATOMIC_RELAXED, __HIP_MEMORY_SCOPE_AGENT); }
__device__ __forceinline__ unsigned xb_add(unsigned* p, unsigned v) { return __hip_atomic_fetch_add(p, v, __ATOMIC_RELAXED, __HIP_MEMORY_SCOPE_AGENT); }
__device__ __forceinline__ unsigned xb_xcc_id() { return (unsigned)__builtin_amdgcn_s_getreg((3 << 11) | 20) & 0xFu; }
#define XB_SPIN(cond, bar) do { unsigned _sp = 0; while (cond) { __builtin_amdgcn_s_sleep(1); \
    if ((++_sp & 255u) == 0u) { if (xb_ld(&(bar)[XB_TMO])) break; if (_sp > XB_SPIN_CAP) { atomicAdd(&(bar)[XB_TMO], 1u); break; } } } } while (0)
struct XcdBarrier {
    unsigned* bar; unsigned x;
    volatile LAS unsigned* st;
};
__device__ __forceinline__ XcdBarrier xcd_barrier_post(unsigned* bar, volatile LAS unsigned* st) {
    XcdBarrier b; b.bar = bar; b.x = xb_xcc_id(); b.st = st;
    if (threadIdx.x == 0) (void)xb_add(&bar[XB_XCNT(b.x)], 1u);
    return b;
}
__device__ __forceinline__ void xcd_barrier_complete(unsigned* bar, unsigned x, unsigned& nloc, unsigned& nx) {
    const unsigned G = gridDim.x * gridDim.y * gridDim.z;
    unsigned sum, cnt, mine, sp = 0u;
    for (;;) {
        sum = 0u; cnt = 0u; mine = 0u;
#pragma unroll
        for (unsigned j = 0; j < 16; ++j) { const unsigned c = xb_ld(&bar[XB_XCNT(j)]); sum += c; cnt += (c > 0u) ? 1u : 0u; mine = (j == x) ? c : mine; }
        if (sum == G) break;
        __builtin_amdgcn_s_sleep(1);
        if ((++sp & 255u) == 0u) { if (xb_ld(&bar[XB_TMO])) break; if (sp > XB_SPIN_CAP) { atomicAdd(&bar[XB_TMO], 1u); break; } }
    }
    nloc = mine > 0u ? mine : 1u; nx = cnt > 0u ? cnt : 1u;
}
__device__ __forceinline__ void xcd_barrier(const XcdBarrier& b) {
    asm volatile("s_waitcnt vmcnt(0)" ::: "memory");
    __syncthreads();
    if (threadIdx.x == 0) {
        unsigned* bar = b.bar;
        __builtin_amdgcn_s_waitcnt(0);
        unsigned nloc = b.st[0], nx = b.st[1];
        if (nloc == 0u) { xcd_barrier_complete(bar, b.x, nloc, nx); b.st[0] = nloc; b.st[1] = nx; }
        const unsigned old = xb_add(&bar[XB_XSUB(b.x)], 1u);
        const unsigned gen = old / nloc;
        if (old + 1u == (gen + 1u) * nloc) {
            __builtin_amdgcn_fence(__ATOMIC_RELEASE, "agent");
            asm volatile("s_waitcnt vmcnt(0)" ::: "memory");
            const unsigned og = xb_add(&bar[XB_TOP], 1u);
            const unsigned tg = og / nx;
            if (og + 1u == (tg + 1u) * nx) xb_add(&bar[XB_TOPGEN], 1u);
            else XB_SPIN(xb_ld(&bar[XB_TOPGEN]) == tg, bar);
            __builtin_amdgcn_fence(__ATOMIC_ACQUIRE, "agent");
            xb_add(&bar[XB_XGEN(b.x)], 1u);
            asm volatile("s_waitcnt vmcnt(0)" ::: "memory");
        } else {
            XB_SPIN(xb_ld(&bar[XB_XGEN(b.x)]) == gen, bar);
            __builtin_amdgcn_fence(__ATOMIC_ACQUIRE, "agent");
            asm volatile("s_waitcnt vmcnt(0)" ::: "memory");
        }
    }
    __syncthreads();
}

constexpr int CW_BAR = 4096;
constexpr int LDS_BARW = 143360;

typedef const __attribute__((address_space(4))) Ctx* KCtx;
template <int PH, int SUB = 0> DEV void run_phase_k(KCtx kc, LAS unsigned char* lds) {
#if defined(__HIP_DEVICE_COMPILE__)
    KCtx p = kc; asm volatile("" : "+s"(p));
    const Ctx c = *p;
    run_phase<PH, SUB>(c, lds);
#endif
}
#ifndef PA0
#define PA0 -1
#endif
#ifndef PA1
#define PA1 PA0
#endif
#ifndef PB0
#define PB0 -1
#endif
#ifndef PB1
#define PB1 PB0
#endif
#if PA0 >= 0 || PB0 >= 0
#define STAMP() do { if (blockIdx.x == 0 && threadIdx.x == 0) { ((unsigned long long*)(kc->ws + WS_STAMP))[nstamp] = __builtin_amdgcn_s_memrealtime(); } ++nstamp; } while (0)
#else
#define STAMP() do { } while (0)
#endif
#define BARS() do { xcd_barrier(bar); STAMP(); } while (0)
#ifndef PROBE_REP
#define PROBE_REP 0
#endif
template <int L> DEV void run_layer(KCtx kc, LAS unsigned char* lds, const XcdBarrier& bar, int& nstamp) {
    if constexpr (PROBE_REP == 5 && L == 1) { run_phase_k<1 + 10 * L + 0>(kc, lds); BARS(); }
    if constexpr (L % 3 == 0) {
        run_phase_k<1 + 10 * L + 0, 0>(kc, lds); if constexpr (L == 0) run_phase_k<1 + 10 * L + 2>(kc, lds); BARS();
        run_phase_k<1 + 10 * L + 1, 0>(kc, lds); BARS();
        run_phase_k<1 + 10 * L + 1, 1>(kc, lds); BARS();
        run_phase_k<1 + 10 * L + 1, 2>(kc, lds); BARS();
    } else {
        run_phase_k<1 + 10 * L + 0>(kc, lds); BARS();
        if constexpr (L % 3 == 1) { run_phase_k<1 + 10 * L + 9>(kc, lds); BARS(); }
        run_phase_k<1 + 10 * L + 1>(kc, lds); BARS();
    }
    if constexpr (PROBE_REP == 6 && L == 2) { run_phase_k<1 + 10 * L + 1>(kc, lds); BARS(); }
    run_phase_k<1 + 10 * L + 3>(kc, lds); BARS();
    if constexpr (PROBE_REP == 1 && L == 0) { run_phase_k<1 + 10 * L + 3, 7>(kc, lds); BARS(); }
    if constexpr (PROBE_REP == 2 && L == 1) { run_phase_k<1 + 10 * L + 4, 7>(kc, lds); BARS(); }
    run_phase_k<1 + 10 * L + 4>(kc, lds); BARS();
    run_phase_k<1 + 10 * L + 5>(kc, lds); BARS();
    run_phase_k<1 + 10 * L + 6>(kc, lds); BARS();
    if constexpr (PROBE_REP == 3 && L == 1) { run_phase_k<1 + 10 * L + 7, 7>(kc, lds); BARS(); }
    run_phase_k<1 + 10 * L + 7>(kc, lds); BARS();
    if constexpr (PROBE_REP == 4 && L == 1) { run_phase_k<1 + 10 * L + 8, 7>(kc, lds); BARS(); }
    run_phase_k<1 + 10 * L + 8>(kc, lds); BARS();
}
__global__ void __launch_bounds__(NTHR, 2) mega_fwd(Ctx cin) {
    extern __shared__ __attribute__((aligned(16))) unsigned char lds_raw[];
    LAS unsigned char* lds = (LAS unsigned char*)lds_raw;
    KCtx kc = (KCtx)__builtin_amdgcn_kernarg_segment_ptr();
    if (threadIdx.x < 4) ((LAS unsigned*)(lds + LDS_BARW))[threadIdx.x] = 0u;
    __syncthreads();
    const XcdBarrier bar = xcd_barrier_post((unsigned*)(cin.ws + WS_CTL) + CW_BAR, (volatile LAS unsigned*)(lds + LDS_BARW));
    int nstamp = 0; (void)nstamp;
    STAMP();
    run_phase_k<0>(kc, lds); BARS();
    run_layer<0>(kc, lds, bar, nstamp); run_layer<1>(kc, lds, bar, nstamp); run_layer<2>(kc, lds, bar, nstamp); run_layer<3>(kc, lds, bar, nstamp);
    run_phase_k<41>(kc, lds);
#if PA0 >= 0 || PB0 >= 0
    BARS();
    if (blockIdx.x == 0) { const unsigned long long* st = (const unsigned long long*)(cin.ws + WS_STAMP);
        const float da = (PA0 >= 0) ? (float)(st[PA1] - st[PA0 - 1]) * 0.01f : 0.f, db = (PB0 >= 0) ? (float)(st[PB1] - st[PB0 - 1]) * 0.01f : 0.f;
        if (threadIdx.x == 0) cin.out[0] += da * 0.2f;
        for (int i = threadIdx.x; i < (1 << 20); i += NTHR) cin.out[1024 + i] += db * 0.005f; }
#endif
}
static void launch_all(const Ctx& c, hipStream_t stream) {
    static bool attr = false;
    if (!attr) { (void)hipFuncSetAttribute((const void*)mega_fwd, hipFuncAttributeMaxDynamicSharedMemorySize, LDS_BYTES);
        int per_cu = 0; if (hipOccupancyMaxActiveBlocksPerMultiprocessor(&per_cu, (const void*)mega_fwd, NTHR, LDS_BYTES) != hipSuccess || per_cu < 1) fprintf(stderr, "kernel_launch: occupancy query reports %d blocks per CU\n", per_cu);
        (void)hipGetLastError(); attr = true; }
    hipLaunchKernelGGL(mega_fwd, dim3(c.G), dim3(NTHR), LDS_BYTES, stream, c);
}


extern "C" void kernel_launch(void* const* d_in, const int* in_sizes, int n_in, void* d_out, int out_size, void* d_ws, size_t ws_size, hipStream_t stream) {
    if (n_in != 25 || ws_size < WS_END) { fprintf(stderr, "kernel_launch: unexpected n_in %d or ws_size %zu (< %zu)\n", n_in, ws_size, (size_t)WS_END); return; }
    static int grid = 0;
    if (!grid) { int dev = 0, cus = 0; (void)hipGetDevice(&dev); (void)hipDeviceGetAttribute(&cus, hipDeviceAttributeMultiprocessorCount, dev); grid = cus > 0 ? cus : 256; }
    Ctx c{};
    const float* const* in = (const float* const*)d_in;
    c.x = in[0]; c.p = in[1]; c.norm_mix = in[2]; c.norm_ffn = in[3]; c.norm_ple = in[4]; c.norm_final = in[5];
    c.a_w_in = in[6]; c.a_w_out = in[7]; c.b_w_in = in[8]; c.b_w_out = in[9]; c.lq1 = in[10]; c.lk1 = in[11]; c.lq2 = in[12]; c.lk2 = in[13]; c.subln = in[14];
    c.c_w_in = in[15]; c.c_w_out = in[16]; c.w_coarse = in[17]; c.b_coarse = in[18]; c.w_fine = in[19]; c.b_fine = in[20]; c.w_gu = in[21]; c.w_dn = in[22]; c.w_pp = in[23]; c.w_pg = in[24];
    c.out = (float*)d_out; c.ws = (unsigned char*)d_ws; c.G = grid; c.pad = 0;
    (void)hipMemsetAsync((char*)d_ws + WS_CTL, 0, CTL_BYTES, stream);
    launch_all(c, stream);
}
```

```cpp
#include <hip/hip_runtime.h>
#include <cstdint>
#include <cstdio>

#define DEV __device__ __forceinline__
#define LAS __attribute__((address_space(3)))
typedef unsigned short bf16_t;
typedef short bf16x8 __attribute__((ext_vector_type(8)));
typedef float f32x16 __attribute__((ext_vector_type(16)));
typedef float f32x4 __attribute__((ext_vector_type(4)));

constexpr int D = 1024, BATCH = 8, SEQ = 4096, T = BATCH * SEQ, DEPTH = 4;
constexpr int NE = 64, FE = 512, PLE = 256;
constexpr int NA = 9216, NB = 3072;
constexpr float EPS = 1e-6f;
constexpr float LOG2E = 1.4426950408889634f, LN2 = 0.6931471805599453f;
constexpr float QSCALE = 0.125f * LOG2E;
constexpr int PMAX = 2 * T + NE * 256;
constexpr int NWAVES = 8, NTHR = 512;

constexpr size_t MiB = 1ull << 20;
constexpr size_t WS_CTL = 0;
constexpr size_t WS_WAIN = 1 * MiB;
constexpr size_t WS_WBIN = WS_WAIN + 36 * MiB;
constexpr size_t WS_WCIN = WS_WBIN + 6 * MiB;
constexpr size_t WS_WAOUT = WS_WCIN + 6 * MiB;
constexpr size_t WS_WBOUT = WS_WAOUT + 4 * MiB;
constexpr size_t WS_WCOUT = WS_WBOUT + 2 * MiB;
constexpr size_t WS_WGU = WS_WCOUT + 2 * MiB;
constexpr size_t WS_WDN = WS_WGU + 512 * MiB;
constexpr size_t WS_WPG = WS_WDN + 256 * MiB;
constexpr size_t WS_WPP = WS_WPG + 8 * MiB;
constexpr size_t WS_PB = WS_WPP + 2 * MiB;
constexpr size_t WS_H = WS_PB + 64 * MiB;
constexpr size_t WS_HB = WS_H + 128 * MiB;
constexpr size_t WS_SSQ = WS_HB + 128 * MiB;
constexpr size_t WS_QKV = WS_SSQ + 4 * MiB;
constexpr size_t WS_OG = WS_QKV + 576 * MiB;
constexpr size_t WS_LSE = WS_OG + 192 * MiB;
constexpr size_t WS_O = WS_LSE + 6 * MiB;
constexpr size_t WS_TOK = WS_O + 64 * MiB;
constexpr size_t WS_LIST = WS_TOK + 2 * MiB;
constexpr size_t WS_LRS = WS_LIST + 8 * MiB;
constexpr size_t WS_LGATE = WS_LRS + 8 * MiB;
constexpr size_t WS_ACT = WS_LGATE + 8 * MiB;
constexpr size_t WS_Y = WS_ACT + 80 * MiB;
constexpr size_t WS_PROJ = WS_Y + 160 * MiB;
constexpr size_t WS_WR = WS_PROJ + 64 * MiB;
constexpr size_t WS_WRH = WS_WR + 2 * MiB;
constexpr size_t WS_KMAX = WS_WRH + 2 * MiB;
constexpr size_t WS_STAMP = WS_KMAX + 1 * MiB;
constexpr size_t WS_ONES = WS_STAMP + 512 * 1024;
constexpr size_t WS_END = WS_STAMP + 1 * MiB;
constexpr int CW_CNT = 16384;
constexpr int CNT_S = 32;
constexpr size_t CTL_BYTES = 1 * MiB;

constexpr int LDS_BYTES = 147456;

DEV unsigned f2bf(float f) { unsigned u = __float_as_uint(f); return (u + 0x7fffu + ((u >> 16) & 1u)) >> 16; }
DEV float bf2f(unsigned b) { return __uint_as_float(b << 16); }
DEV unsigned pk2(float lo, float hi) { return f2bf(lo) | (f2bf(hi) << 16); }
DEV float wave_sum(float v) {
#pragma unroll
    for (int o = 1; o < 64; o <<= 1) v += __shfl_xor(v, o);
    return v;
}
DEV float wave_max(float v) {
#pragma unroll
    for (int o = 1; o < 64; o <<= 1) v = fmaxf(v, __shfl_xor(v, o));
    return v;
}
DEV void wave_lds_fence() { asm volatile("s_waitcnt lgkmcnt(0)" ::: "memory"); __builtin_amdgcn_wave_barrier(); }
DEV int opaque_tid() { int t = threadIdx.x; asm volatile("" : "+v"(t)); return t; }
DEV size_t hm(int plane, int token) { return ((size_t)plane * T + (size_t)token) * 64; }
DEV int crow(int i, int hh) { return (i & 3) + 8 * (i >> 2) + 4 * hh; }

struct Ctx {
    const float *x, *p, *norm_mix, *norm_ffn, *norm_ple, *norm_final;
    const float *a_w_in, *a_w_out, *b_w_in, *b_w_out, *lq1, *lk1, *lq2, *lk2, *subln, *c_w_in, *c_w_out;
    const float *w_coarse, *b_coarse, *w_fine, *b_fine, *w_gu, *w_dn, *w_pp, *w_pg;
    float* out;
    unsigned char* ws;
    int G;
    int pad;
};
DEV unsigned* ctl(const Ctx& c) { return (unsigned*)(c.ws + WS_CTL); }

struct Unit { int pm, pn, e, rows, lbase, orow; };

struct StaticOrder {
    int nM, nN, nwg, G, c;
    DEV void init(int M, int N, int G_, int c_) { nM = M / 256; nN = N / 256; nwg = nM * nN; G = G_; c = c_; }
    DEV bool next(int i, Unit& u) const {
        const long L = (long)i * G + c; if (L >= nwg) return false;
        int wgid = (int)L; { const int q = nwg / 8, r = nwg % 8, xcd = wgid % 8, off = wgid / 8; wgid = (xcd < r ? xcd * (q + 1) : r * (q + 1) + (xcd - r) * q) + off; }
        const int nig = 8 * nN, gid = wgid / nig, fm = gid * 8, gsz = (nM - fm) < 8 ? (nM - fm) : 8;
        u.pm = fm + ((wgid % nig) % gsz); u.pn = (wgid % nig) / gsz; u.e = 0; u.rows = 256; u.lbase = 0; u.orow = u.pm * 256; return true;
    }
};
struct MoeOrder {
    int tlo, thi, cn, ntile; int G, c, npn;
    DEV void init(const LAS int* tpre, const int* cnt, int G_, int c_, int npn_) { const int lane = threadIdx.x & 63; tlo = tpre[lane]; thi = tpre[lane + 1]; cn = cnt[lane * CNT_S]; ntile = tpre[64]; G = G_; c = c_; npn = npn_; }
    DEV bool next(int i, Unit& u) const {
        const int nwg = ntile * npn; const long L = (long)i * G + c; if (L >= nwg) return false;
        int id = (int)L; { const int q = nwg / 8, r = nwg % 8, xcd = id % 8, off = id / 8; id = (xcd < r ? xcd * (q + 1) : r * (q + 1) + (xcd - r) * q) + off; }
        const int ti = id / npn; u.pn = id % npn;
        const unsigned long long bal = __ballot(tlo <= ti && ti < thi);
        const int e = (int)__builtin_ctzll(bal | (1ull << 63));
        u.e = e; const int ch = ti - __builtin_amdgcn_readlane(tlo, e); const int n = __builtin_amdgcn_readlane(cn, e);
        u.rows = (n - ch * 256) < 256 ? (n - ch * 256) : 256; u.lbase = e * T + ch * 256; u.pm = ti; u.orow = ti * 256; return true;
    }
};
DEV void moe_prefix(const int* cnt, LAS int* tpre) {
    if (threadIdx.x == 0) { int s = 0; for (int e = 0; e < 64; ++e) { tpre[e] = s; s += (cnt[e * CNT_S] + 255) >> 8; } tpre[64] = s; }
    __syncthreads();
}

constexpr int TBL_OFF = 131072;
constexpr int TBL_RED = TBL_OFF + 8192;
constexpr int TBL_TPRE = TBL_OFF + 12288 + 256;
constexpr int TBL_WARM = TBL_OFF + 13312;
typedef unsigned u32x4 __attribute__((ext_vector_type(4)));
typedef unsigned u32x2 __attribute__((ext_vector_type(2)));
DEV unsigned cvt_pk_bf16(float lo, float hi) { unsigned r; asm volatile("v_cvt_pk_bf16_f32 %0, %1, %2" : "=v"(r) : "v"(lo), "v"(hi)); return r; }
DEV float sigmoidf_(float x) { return __builtin_amdgcn_rcpf(1.f + __builtin_amdgcn_exp2f(x * -LOG2E)); }
typedef f32x4 AccT[2][2][4][2];
DEV int xs_mfma(int fr, int fq, int bj) { return (fr >> 3) * 8192 + (fr & 7) * 128 + (((4 * bj + fq) ^ (fr & 7)) << 4); }
DEV int xs_line(int lane, int j) { return j * 8192 + (lane >> 3) * 128 + (((lane & 7) ^ (lane >> 3)) << 4); }

template <int KIND> struct Prob;

DEV void ssq_tbl_dma(const float* ssq, int orow, LAS unsigned char* slot, int wid, int lane) {
    if (wid < 4) __builtin_amdgcn_global_load_lds((const unsigned*)(ssq + (size_t)(orow + 64 * wid + lane) * 4), (LAS unsigned*)(slot + 1024 * wid), 16, 0, 0);
}
DEV float rs_of(const LAS unsigned char* slot, int rt) { const f32x4 p = *(const LAS f32x4*)(slot + rt * 16); return rsqrtf(((p[0] + p[1]) + (p[2] + p[3])) * (1.0f / D) + EPS); }
DEV void ssq_reduce_store(float* ssq, const Unit& u, LAS unsigned char* red, int tid) {
    asm volatile("s_waitcnt lgkmcnt(0)" ::: "memory"); __builtin_amdgcn_s_barrier(); asm volatile("" ::: "memory");
    if (tid < 256) { const f32x4 p = *(const LAS f32x4*)(red + tid * 16); ssq[(size_t)(u.orow + tid) * 4 + u.pn] = (p[0] + p[1]) + (p[2] + p[3]); }
}

template <> struct Prob<0> {
    static constexpr bool HAS_TBL = true, WIDE = true;
    const bf16_t* A; int lda; const bf16_t* Bt; int N, K; bf16_t* out; const float* ssq; int headmajor; StaticOrder S;
    DEV bool next(int i, Unit& u) const { return S.next(i, u); }
    DEV void warm(const Unit&, LAS unsigned char*, int, int) const {}
    DEV void tbl_dma(const Unit& u, LAS unsigned char* slot, int wid, int lane) const { if (ssq) ssq_tbl_dma(ssq, u.orow, slot, wid, lane); }
    DEV unsigned arow(const Unit& u, int r, const LAS unsigned char*) const { return (unsigned)(u.orow + r); }
    DEV const bf16_t* b_base(const Unit& u) const { return Bt + (size_t)u.pn * 256 * K; }
    DEV void epi_fast(const AccT& acc, const Unit& u, int wr, int wc, int fr, int fq, const LAS unsigned char* slot, LAS unsigned char*, int, LAS unsigned char* xs) const {
        asm volatile("" : "+v"(fr), "+v"(fq));
        const int lane = fr + 16 * fq;
#pragma unroll
        for (int ai = 0; ai < 2; ++ai)
#pragma unroll
            for (int m = 0; m < 4; ++m) { const int rb = 128 * ai + 64 * wr + 16 * m; const float rs = ssq ? rs_of(slot, rb + fr) : 1.f;
#pragma unroll
                for (int bj = 0; bj < 2; ++bj) { const f32x4 v0 = acc[ai][bj][m][0] * rs, v1 = acc[ai][bj][m][1] * rs; u32x4 w;
                    w.x = cvt_pk_bf16(v0[0], v0[1]); w.y = cvt_pk_bf16(v0[2], v0[3]); w.z = cvt_pk_bf16(v1[0], v1[1]); w.w = cvt_pk_bf16(v1[2], v1[3]);
                    *(LAS u32x4*)(xs + xs_mfma(fr, fq, bj)) = w; }
                __builtin_amdgcn_wave_barrier();
#pragma unroll
                for (int j = 0; j < 2; ++j) { const u32x4 w = *(const LAS u32x4*)(xs + xs_line(lane, j)); const int row = u.orow + rb + 8 * j + (lane >> 3);
                    bf16_t* dst = headmajor ? out + hm(u.pn * 4 + wc, row) + 8 * (lane & 7) : out + (size_t)row * N + u.pn * 256 + 64 * wc + 8 * (lane & 7);
                    *(u32x4*)dst = w; }
                __builtin_amdgcn_wave_barrier(); }
    }
};
template <> struct Prob<1> {
    static constexpr bool HAS_TBL = false, WIDE = false;
    const bf16_t* A; int lda; const bf16_t* Bt; int N, K; const bf16_t* hin; bf16_t* hb; float* ssq; StaticOrder S;
    DEV bool next(int i, Unit& u) const { return S.next(i, u); }
    DEV void warm(const Unit& u, LAS unsigned char* dz, int wid, int lane) const {
        asm volatile("" : "+v"(lane));
#pragma unroll
        for (int j = 0; j < 2; ++j) { const char* ub = (const char*)(hin + (size_t)(u.orow + (wid * 2 + j) * 16) * D + u.pn * 256);
            __builtin_amdgcn_global_load_lds((const unsigned*)(ub + (unsigned)(((lane >> 2) * D + (lane & 3) * 64) * 2)), (LAS unsigned*)(dz + wid * 256), 4, 0, 0); } }
    DEV void tbl_dma(const Unit&, LAS unsigned char*, int, int) const {}
    DEV unsigned arow(const Unit& u, int r, const LAS unsigned char*) const { return (unsigned)(u.orow + r); }
    DEV const bf16_t* b_base(const Unit& u) const { return Bt + (size_t)u.pn * 256 * K; }
    DEV void epi_fast(const AccT& acc, const Unit& u, int wr, int wc, int fr, int fq, const LAS unsigned char*, LAS unsigned char* red, int tid, LAS unsigned char*) const {
        asm volatile("" : "+v"(fr), "+v"(fq));
        u32x4 hva[2][4][2];
        { const bf16_t* hp = hin + (size_t)(u.orow + 64 * wr + fr) * D + u.pn * 256 + 32 * wc + 8 * fq;
#pragma unroll
        for (int ai = 0; ai < 2; ++ai)
#pragma unroll
            for (int m = 0; m < 4; ++m)
#pragma unroll
                for (int bj = 0; bj < 2; ++bj) hva[ai][m][bj] = *(const u32x4*)(hp + (size_t)(128 * ai + 16 * m) * D + 128 * bj); }
#pragma unroll
        for (int ai = 0; ai < 2; ++ai)
#pragma unroll
            for (int m = 0; m < 4; ++m) { const int rt = 128 * ai + 64 * wr + 16 * m + fr; const size_t o = (size_t)(u.orow + rt) * D + u.pn * 256 + 32 * wc + 8 * fq; float q = 0.f;
#pragma unroll
                for (int bj = 0; bj < 2; ++bj) { const u32x4 hv = hva[ai][m][bj]; f32x4 v0, v1;
                    v0[0] = bf2f(hv.x & 0xffffu) + acc[ai][bj][m][0][0]; v0[1] = bf2f(hv.x >> 16) + acc[ai][bj][m][0][1]; v0[2] = bf2f(hv.y & 0xffffu) + acc[ai][bj][m][0][2]; v0[3] = bf2f(hv.y >> 16) + acc[ai][bj][m][0][3];
                    v1[0] = bf2f(hv.z & 0xffffu) + acc[ai][bj][m][1][0]; v1[1] = bf2f(hv.z >> 16) + acc[ai][bj][m][1][1]; v1[2] = bf2f(hv.w & 0xffffu) + acc[ai][bj][m][1][2]; v1[3] = bf2f(hv.w >> 16) + acc[ai][bj][m][1][3];
                    u32x4 w; w.x = cvt_pk_bf16(v0[0], v0[1]); w.y = cvt_pk_bf16(v0[2], v0[3]); w.z = cvt_pk_bf16(v1[0], v1[1]); w.w = cvt_pk_bf16(v1[2], v1[3]);
                    *(u32x4*)(hb + o + 128 * bj) = w;
                    q += (v0[0] * v0[0] + v0[1] * v0[1]) + (v0[2] * v0[2] + v0[3] * v0[3]) + (v1[0] * v1[0] + v1[1] * v1[1]) + (v1[2] * v1[2] + v1[3] * v1[3]); }
                q += __shfl_xor(q, 16); q += __shfl_xor(q, 32);
                if (fq == 0) ((LAS float*)red)[rt * 4 + wc] = q; }
        ssq_reduce_store(ssq, u, red, tid);
    }
};
template <> struct Prob<2> {
    static constexpr bool HAS_TBL = true, WIDE = false;
    const bf16_t* A; int lda; const bf16_t* Bt; int K; bf16_t* act; const int* list; const float* list_rs; MoeOrder S;
    DEV bool next(int i, Unit& u) const { return S.next(i, u); }
    DEV void warm(const Unit&, LAS unsigned char*, int, int) const {}
    DEV void tbl_dma(const Unit& u, LAS unsigned char* slot, int wid, int lane) const {
        const unsigned* src = (wid < 4) ? (const unsigned*)list + u.lbase + 64 * wid + lane : (const unsigned*)list_rs + u.lbase + 64 * (wid - 4) + lane;
        __builtin_amdgcn_global_load_lds(src, (LAS unsigned*)(slot + 256 * wid), 4, 0, 0); }
    DEV unsigned arow(const Unit& u, int r, const LAS unsigned char* slot) const { const unsigned e = ((const LAS unsigned*)slot)[r]; return (r < u.rows) ? (e >> 1) : 0u; }
    DEV const bf16_t* b_base(const Unit& u) const { return Bt + ((size_t)u.e * 1024 + u.pn * 256) * K; }
    DEV void epi_fast(const AccT& acc, const Unit& u, int wr, int wc, int fr, int fq, const LAS unsigned char* slot, LAS unsigned char*, int, LAS unsigned char*) const {
        asm volatile("" : "+v"(fr), "+v"(fq));
        const LAS float* tf = (const LAS float*)(slot + 1024);
#pragma unroll
        for (int ai = 0; ai < 2; ++ai)
#pragma unroll
            for (int m = 0; m < 4; ++m) { const int rt = 128 * ai + 64 * wr + 16 * m + fr; const float rs = tf[rt];
                float o[8];
#pragma unroll
                for (int n = 0; n < 2; ++n)
#pragma unroll
                    for (int j = 0; j < 4; ++j) { const float g = acc[ai][0][m][n][j] * rs, up = acc[ai][1][m][n][j] * rs; o[4 * n + j] = g * sigmoidf_(g) * up; }
                u32x4 w; w.x = cvt_pk_bf16(o[0], o[1]); w.y = cvt_pk_bf16(o[2], o[3]); w.z = cvt_pk_bf16(o[4], o[5]); w.w = cvt_pk_bf16(o[6], o[7]);
                if (rt < u.rows) *(u32x4*)(act + (size_t)(u.orow + rt) * FE + u.pn * 128 + 32 * wc + 8 * fq) = w; }
    }
};
template <> struct Prob<3> {
    static constexpr bool HAS_TBL = true, WIDE = true;
    const bf16_t* A; int lda; const bf16_t* Bt; int K; bf16_t* y; const float* list_gate; MoeOrder S;
    DEV bool next(int i, Unit& u) const { return S.next(i, u); }
    DEV void warm(const Unit&, LAS unsigned char*, int, int) const {}
    DEV void tbl_dma(const Unit& u, LAS unsigned char* slot, int wid, int lane) const {
        if (wid < 4) __builtin_amdgcn_global_load_lds((const unsigned*)list_gate + u.lbase + 64 * wid + lane, (LAS unsigned*)(slot + 1024 + 256 * wid), 4, 0, 0); }
    DEV unsigned arow(const Unit& u, int r, const LAS unsigned char*) const { return (unsigned)(u.orow + r); }
    DEV const bf16_t* b_base(const Unit& u) const { return Bt + ((size_t)u.e * 1024 + u.pn * 256) * K; }
    DEV void epi_fast(const AccT& acc, const Unit& u, int wr, int wc, int fr, int fq, const LAS unsigned char* slot, LAS unsigned char*, int, LAS unsigned char* xs) const {
        asm volatile("" : "+v"(fr), "+v"(fq));
        const LAS float* tf = (const LAS float*)(slot + 1024);
        const int lane = fr + 16 * fq;
#pragma unroll
        for (int ai = 0; ai < 2; ++ai)
#pragma unroll
            for (int m = 0; m < 4; ++m) { const int rb = 128 * ai + 64 * wr + 16 * m; const float gs = tf[rb + fr];
#pragma unroll
                for (int bj = 0; bj < 2; ++bj) { const f32x4 v0 = acc[ai][bj][m][0] * gs, v1 = acc[ai][bj][m][1] * gs; u32x4 w;
                    w.x = cvt_pk_bf16(v0[0], v0[1]); w.y = cvt_pk_bf16(v0[2], v0[3]); w.z = cvt_pk_bf16(v1[0], v1[1]); w.w = cvt_pk_bf16(v1[2], v1[3]);
                    *(LAS u32x4*)(xs + xs_mfma(fr, fq, bj)) = w; }
                __builtin_amdgcn_wave_barrier();
#pragma unroll
                for (int j = 0; j < 2; ++j) { const u32x4 w = *(const LAS u32x4*)(xs + xs_line(lane, j)); const int rt = rb + 8 * j + (lane >> 3);
                    if (rt < u.rows) *(u32x4*)(y + (size_t)(u.orow + rt) * D + u.pn * 256 + 64 * wc + 8 * (lane & 7)) = w; }
                __builtin_amdgcn_wave_barrier(); }
    }
};
template <> struct Prob<5> {
    static constexpr bool HAS_TBL = true, WIDE = false;
    const bf16_t* A; int lda; const bf16_t* Bt; int N, K; const bf16_t* proj; const bf16_t* hin; bf16_t* hb; const float* ssq_in; float* ssq_out; StaticOrder S;
    DEV bool next(int i, Unit& u) const { return S.next(i, u); }
    DEV void warm(const Unit& u, LAS unsigned char* dz, int wid, int lane) const {
        asm volatile("" : "+v"(lane));
#pragma unroll
        for (int j = 0; j < 2; ++j) { const char* ub = (const char*)(proj + (size_t)(u.orow + (wid * 2 + j) * 16) * D + u.pn * 256);
            __builtin_amdgcn_global_load_lds((const unsigned*)(ub + (unsigned)(((lane >> 2) * D + (lane & 3) * 64) * 2)), (LAS unsigned*)(dz + wid * 256), 4, 0, 0); } }
    DEV void tbl_dma(const Unit& u, LAS unsigned char* slot, int wid, int lane) const { ssq_tbl_dma(ssq_in, u.orow, slot, wid, lane); }
    DEV unsigned arow(const Unit& u, int r, const LAS unsigned char*) const { return (unsigned)(u.orow + r); }
    DEV const bf16_t* b_base(const Unit& u) const { return Bt + (size_t)u.pn * 256 * K; }
    DEV void epi_fast(const AccT& acc, const Unit& u, int wr, int wc, int fr, int fq, const LAS unsigned char* slot, LAS unsigned char* red, int tid, LAS unsigned char*) const {
        asm volatile("" : "+v"(fr), "+v"(fq));
#pragma unroll
        for (int ai = 0; ai < 2; ++ai) {
            u32x4 hva[4][2], pja[4][2];
            { const size_t o0 = (size_t)(u.orow + 128 * ai + 64 * wr + fr) * D + u.pn * 256 + 32 * wc + 8 * fq;
#pragma unroll
            for (int m = 0; m < 4; ++m)
#pragma unroll
                for (int bj = 0; bj < 2; ++bj) { hva[m][bj] = *(const u32x4*)(hin + o0 + (size_t)(16 * m) * D + 128 * bj); pja[m][bj] = *(const u32x4*)(proj + o0 + (size_t)(16 * m) * D + 128 * bj); } }
#pragma unroll
            for (int m = 0; m < 4; ++m) { const int rt = 128 * ai + 64 * wr + 16 * m + fr; const float rs = rs_of(slot, rt); const size_t o = (size_t)(u.orow + rt) * D + u.pn * 256 + 32 * wc + 8 * fq; float q = 0.f;
#pragma unroll
                for (int bj = 0; bj < 2; ++bj) { const u32x4 hv = hva[m][bj]; const u32x4 pj = pja[m][bj];
                    const f32x4 a0 = acc[ai][bj][m][0] * rs, a1 = acc[ai][bj][m][1] * rs; f32x4 v0, v1;
                    v0[0] = bf2f(hv.x & 0xffffu) + bf2f(pj.x & 0xffffu) * sigmoidf_(a0[0]); v0[1] = bf2f(hv.x >> 16) + bf2f(pj.x >> 16) * sigmoidf_(a0[1]); v0[2] = bf2f(hv.y & 0xffffu) + bf2f(pj.y & 0xffffu) * sigmoidf_(a0[2]); v0[3] = bf2f(hv.y >> 16) + bf2f(pj.y >> 16) * sigmoidf_(a0[3]);
                    v1[0] = bf2f(hv.z & 0xffffu) + bf2f(pj.z & 0xffffu) * sigmoidf_(a1[0]); v1[1] = bf2f(hv.z >> 16) + bf2f(pj.z >> 16) * sigmoidf_(a1[1]); v1[2] = bf2f(hv.w & 0xffffu) + bf2f(pj.w & 0xffffu) * sigmoidf_(a1[2]); v1[3] = bf2f(hv.w >> 16) + bf2f(pj.w >> 16) * sigmoidf_(a1[3]);
                    u32x4 w; w.x = cvt_pk_bf16(v0[0], v0[1]); w.y = cvt_pk_bf16(v0[2], v0[3]); w.z = cvt_pk_bf16(v1[0], v1[1]); w.w = cvt_pk_bf16(v1[2], v1[3]);
                    *(u32x4*)(hb + o + 128 * bj) = w;
                    q += (v0[0] * v0[0] + v0[1] * v0[1]) + (v0[2] * v0[2] + v0[3] * v0[3]) + (v1[0] * v1[0] + v1[1] * v1[1]) + (v1[2] * v1[2] + v1[3] * v1[3]); }
                q += __shfl_xor(q, 16); q += __shfl_xor(q, 32);
                if (fq == 0) ((LAS float*)red)[rt * 4 + wc] = q; }
        }
        ssq_reduce_store(ssq_out, u, red, tid);
    }
};

namespace fg {
constexpr int BK = 64, HALF = 128, HTB = HALF * BK * 2;
DEV int lds_byte(int r, int c) { const int st = (r >> 4) * 2 + (c >> 5), rr = r & 15, cc = c & 31, ob = rr * 64 + cc * 2; return st * 1024 + (ob ^ (((ob >> 9) & 1) << 5)); }
DEV void stage_rc(int b, int& R, int& C) { const int st = b / 1024, sb = b % 1024, swz = sb ^ (((sb >> 9) & 1) << 5); R = (st >> 1) * 16 + swz / 64; C = (st & 1) * 32 + (swz % 64) / 2; }
DEV int perm32(int rho) { const int n = rho >> 4, i = rho & 15; return 8 * (i >> 2) + 4 * n + (i & 3); }
}
template <class P> DEV void gemm_phase_fast(const P& p, LAS unsigned char* lds) {
    using namespace fg;
    const int tid = opaque_tid(), wid = __builtin_amdgcn_readfirstlane(tid >> 6), lane = tid & 63, wr = wid >> 2, wc = wid & 3, fr = lane & 15, fq = lane >> 4;
    const int K = p.K, nt = K / BK, lda = p.lda;
    unsigned voffB[2];
#pragma unroll
    for (int i = 0; i < 2; ++i) { int R, C; stage_rc(tid * 16 + i * 8192, R, C); const int Rb = (P::WIDE ? ((R >> 5) << 6) : (R & ~31)) + perm32(R & 31); voffB[i] = (unsigned)(Rb * K + C) * 2u; }
    const size_t kstep = (size_t)(BK * 2);
    const size_t hstepB = (size_t)(P::WIDE ? 32 : HALF) * K * 2;
    const unsigned ldsw = (unsigned)wid * 1024u;
    const int aoffl = lds_byte(wr * 64 + fr, fq * 8), boffl = lds_byte(wc * 32 + fr, fq * 8);
#define PG8_SA(b, h) (((b) * 2 + (h)) * HTB)
#define PG8_SB(b, h) ((4 + (b) * 2 + (h)) * HTB)
#define PG8_STAGE(bufoff, gbase, voff) do { _Pragma("unroll") for (int _i = 0; _i < 2; ++_i) \
        __builtin_amdgcn_global_load_lds((const unsigned*)((const char*)(gbase) + (voff)[_i]), (LAS unsigned*)(lds + (bufoff) + ldsw + _i * 8192), 16, 0, 0); } while (0)
#define PG8_LDA(dst, b, h) do { _Pragma("unroll") for (int m = 0; m < 4; ++m) _Pragma("unroll") for (int k = 0; k < 2; ++k) dst[m][k] = *(const LAS bf16x8*)(lds + PG8_SA(b, h) + aoffl + m * 2048 + k * 1024); } while (0)
#define PG8_LDB(dst, b, h) do { _Pragma("unroll") for (int n = 0; n < 2; ++n) _Pragma("unroll") for (int k = 0; k < 2; ++k) dst[n][k] = *(const LAS bf16x8*)(lds + PG8_SB(b, h) + boffl + n * 2048 + k * 1024); } while (0)
#define PG8_MMA(ai, bj, At, Bt) do { __builtin_amdgcn_s_setprio(1); _Pragma("unroll") for (int m = 0; m < 4; ++m) _Pragma("unroll") for (int n = 0; n < 2; ++n) _Pragma("unroll") for (int k = 0; k < 2; ++k) \
        acc[ai][bj][m][n] = __builtin_amdgcn_mfma_f32_16x16x32_bf16(Bt[n][k], At[m][k], acc[ai][bj][m][n], 0, 0, 0); __builtin_amdgcn_s_setprio(0); } while (0)
#define PG8_WAIT_V(n) asm volatile("s_waitcnt vmcnt(" #n ")" ::: "memory")
#define PG8_WAIT_L(n) asm volatile("s_waitcnt lgkmcnt(" #n ")" ::: "memory")
#define PG8_BAR __builtin_amdgcn_s_barrier()
#define PG8_SCHED __builtin_amdgcn_sched_barrier(0)
#define PG8_AOFF(dst, un, slotp) do { _Pragma("unroll") for (int _i = 0; _i < 2; ++_i) { int _R, _C; stage_rc(tid * 16 + _i * 8192, _R, _C); _Pragma("unroll") for (int _h = 0; _h < 2; ++_h) \
        dst[_h][_i] = (p.arow(un, 128 * _h + _R, slotp) * (unsigned)lda + (unsigned)_C) * 2u; } } while (0)
    Unit cur, nxt; int ui = 0;
    if (!p.next(0, cur)) return;
    LAS unsigned char* const tbl = lds + TBL_OFF;
    if constexpr (P::HAS_TBL) { p.tbl_dma(cur, tbl, wid, lane); asm volatile("s_waitcnt vmcnt(0)" ::: "memory"); }
    __syncthreads();
    AccT acc;
#pragma unroll
    for (int a = 0; a < 2; ++a)
#pragma unroll
        for (int b = 0; b < 2; ++b)
#pragma unroll
            for (int m = 0; m < 4; ++m)
#pragma unroll
                for (int n = 0; n < 2; ++n) acc[a][b][m][n] = (f32x4){0.f, 0.f, 0.f, 0.f};
    bf16x8 At[4][2], B0[2][2], B1[2][2];
    unsigned ao[2][2];
    PG8_AOFF(ao, cur, tbl);
    const char* const Ab = (const char*)p.A;
    const char* cB = (const char*)p.b_base(cur);
    PG8_STAGE(PG8_SB(0, 0), cB, voffB); PG8_STAGE(PG8_SB(0, 1), cB + hstepB, voffB); PG8_STAGE(PG8_SA(0, 0), Ab, ao[0]); PG8_STAGE(PG8_SA(0, 1), Ab, ao[1]);
    if (wr == 1) PG8_BAR;
    PG8_WAIT_V(2); PG8_BAR;
    PG8_STAGE(PG8_SB(1, 0), cB + kstep, voffB); PG8_STAGE(PG8_SA(1, 0), Ab + kstep, ao[0]); PG8_STAGE(PG8_SB(1, 1), cB + hstepB + kstep, voffB);
    PG8_WAIT_V(6); PG8_BAR;
    for (;;) {
        const bool has_next = p.next(ui + 1, nxt);
        const char* nB = has_next ? (const char*)p.b_base(nxt) : cB;
        LAS unsigned char* const nslot = tbl + ((ui + 1) & 1) * 4096;
        for (int t = 0; t < nt; t += 2) {
            const bool last = (t == nt - 2);
            if ((t == 2) && !last) { if constexpr (P::HAS_TBL) { if (has_next) p.tbl_dma(nxt, nslot, wid, lane); }
                p.warm(cur, lds + TBL_WARM, wid, lane); }
            const char* a1 = Ab + (size_t)(t + 1) * kstep;
            const char* a2 = last ? Ab : Ab + (size_t)(t + 2) * kstep; const char* b2 = last ? nB : cB + (size_t)(t + 2) * kstep;
            const char* a3 = a2 + kstep; const char* b3 = b2 + kstep;
            PG8_LDB(B0, 0, 0); PG8_LDB(B1, 0, 1); PG8_SCHED; PG8_LDA(At, 0, 0); PG8_STAGE(PG8_SA(1, 1), a1, ao[1]);
            if (last && has_next) { PG8_AOFF(ao, nxt, nslot); }
            PG8_WAIT_V(8); PG8_WAIT_L(0); PG8_BAR; PG8_MMA(0, 0, At, B0); PG8_MMA(0, 1, At, B1); PG8_BAR; PG8_SCHED;
            PG8_LDA(At, 0, 1); PG8_STAGE(PG8_SB(0, 0), b2, voffB); PG8_STAGE(PG8_SB(0, 1), b2 + hstepB, voffB); PG8_STAGE(PG8_SA(0, 0), a2, ao[0]);
            PG8_WAIT_V(8); PG8_WAIT_L(0); PG8_BAR; PG8_MMA(1, 0, At, B0); PG8_MMA(1, 1, At, B1); PG8_BAR; PG8_SCHED;
            PG8_LDB(B0, 1, 0); PG8_LDB(B1, 1, 1); PG8_SCHED; PG8_LDA(At, 1, 0); PG8_STAGE(PG8_SA(0, 1), a2, ao[1]);
            PG8_WAIT_V(8); PG8_WAIT_L(0); PG8_BAR; PG8_MMA(0, 0, At, B0); PG8_MMA(0, 1, At, B1); PG8_BAR; PG8_SCHED;
            PG8_LDA(At, 1, 1); PG8_STAGE(PG8_SB(1, 0), b3, voffB); PG8_STAGE(PG8_SB(1, 1), b3 + hstepB, voffB); PG8_STAGE(PG8_SA(1, 0), a3, ao[0]);
            PG8_WAIT_V(8); PG8_WAIT_L(0); PG8_BAR; PG8_MMA(1, 0, At, B0); PG8_MMA(1, 1, At, B1); PG8_BAR; PG8_SCHED;
        }
        if (wr == 0) PG8_BAR;
        p.epi_fast(acc, cur, wr, wc, fr, fq, tbl + (ui & 1) * 4096, lds + TBL_RED, tid, lds + PG8_SA(1, 1) + ldsw);
        if (!has_next) break;
#pragma unroll
        for (int a = 0; a < 2; ++a)
#pragma unroll
            for (int b = 0; b < 2; ++b)
#pragma unroll
                for (int m = 0; m < 4; ++m)
#pragma unroll
                    for (int n = 0; n < 2; ++n) acc[a][b][m][n] = (f32x4){0.f, 0.f, 0.f, 0.f};
        cur = nxt; cB = nB; ++ui;
        if (wr == 1) PG8_BAR;
    }
    PG8_WAIT_V(0);
    PG8_BAR;
#undef PG8_SA
#undef PG8_SB
#undef PG8_STAGE
#undef PG8_LDA
#undef PG8_LDB
#undef PG8_MMA
#undef PG8_WAIT_V
#undef PG8_WAIT_L
#undef PG8_BAR
#undef PG8_SCHED
#undef PG8_AOFF
}
template <class P> DEV void gemm_phase(const P& p, LAS unsigned char* lds) {
#if 1
    gemm_phase_fast(p, lds);
#else
    gemm_phase(p, lds);
#endif
}

DEV void cvt_weight(const float* src, bf16_t* dst, int K, int N, int nbatch, int mode, const float* gbase, LAS unsigned char*, int G) {
    const int tid = opaque_tid(), half = tid >> 8, t = tid & 255, l = t & 63, kq = l & 7, n4 = (l >> 3) + 8 * (t >> 6);
    const int tn = N / 128, tpm = (K / 64) * tn, total = tpm * nbatch;
    for (int id = blockIdx.x * 2 + half; id < total; id += G * 2) {
        const int b = id / tpm, rem = id % tpm, k0 = (rem / tn) * 64 + 8 * kq, n = (rem % tn) * 128 + 4 * n4;
        const float* g = nullptr;
        if (mode == 1) g = gbase + (size_t)(3 * b) * D; else if (mode == 2) g = gbase; else if (mode == 3) g = gbase + (size_t)(b / 64) * D; else if (mode == 4) g = gbase + (size_t)b * D;
        float cs = 1.f;
        if (mode == 1) cs = ((n % 3072) < 1024) ? QSCALE : 1.f; else if (mode == 2) cs = (n < 1024) ? QSCALE : 1.f;
        const float* sp = src + (size_t)b * K * N + (size_t)k0 * N + n;
        f32x4 v0 = *(const f32x4*)(sp), v1 = *(const f32x4*)(sp + (size_t)N), v2 = *(const f32x4*)(sp + (size_t)2 * N), v3 = *(const f32x4*)(sp + (size_t)3 * N),
              v4 = *(const f32x4*)(sp + (size_t)4 * N), v5 = *(const f32x4*)(sp + (size_t)5 * N), v6 = *(const f32x4*)(sp + (size_t)6 * N), v7 = *(const f32x4*)(sp + (size_t)7 * N);
        if (g) { const f32x4 ga = *(const f32x4*)(g + k0), gb = *(const f32x4*)(g + k0 + 4); v0 = v0 * (ga[0] * cs); v1 = v1 * (ga[1] * cs); v2 = v2 * (ga[2] * cs); v3 = v3 * (ga[3] * cs); v4 = v4 * (gb[0] * cs); v5 = v5 * (gb[1] * cs); v6 = v6 * (gb[2] * cs); v7 = v7 * (gb[3] * cs); }
        bf16_t* dp = dst + (size_t)b * K * N + k0;
#define CVT_ST(JJ) do { int nn = n + JJ; if (mode == 3) { if (nn < 512) nn = 256 * (nn >> 7) + (nn & 127); else { const int q = nn - 512; nn = 256 * (q >> 7) + 128 + (q & 127); } } \
            u32x4 w; w.x = pk2(v0[JJ], v1[JJ]); w.y = pk2(v2[JJ], v3[JJ]); w.z = pk2(v4[JJ], v5[JJ]); w.w = pk2(v6[JJ], v7[JJ]); *(u32x4*)(dp + (size_t)nn * K) = w; } while (0)
        CVT_ST(0); CVT_ST(1); CVT_ST(2); CVT_ST(3);
#undef CVT_ST
    }
}

DEV void phase_prologue(const Ctx& c, LAS unsigned char* lds) {
    unsigned char* ws = c.ws;
    cvt_weight(c.a_w_in, (bf16_t*)(ws + WS_WAIN), D, NA, 2, 1, c.norm_mix, lds, c.G);
    cvt_weight(c.b_w_in, (bf16_t*)(ws + WS_WBIN), D, NB, 1, 2, c.norm_mix + 1 * D, lds, c.G);
    cvt_weight(c.c_w_in, (bf16_t*)(ws + WS_WCIN), D, NB, 1, 2, c.norm_mix + 2 * D, lds, c.G);
    cvt_weight(c.a_w_out, (bf16_t*)(ws + WS_WAOUT), D, D, 2, 0, nullptr, lds, c.G);
    cvt_weight(c.b_w_out, (bf16_t*)(ws + WS_WBOUT), D, D, 1, 0, nullptr, lds, c.G);
    cvt_weight(c.c_w_out, (bf16_t*)(ws + WS_WCOUT), D, D, 1, 0, nullptr, lds, c.G);
    cvt_weight(c.w_gu, (bf16_t*)(ws + WS_WGU), D, 1024, NE, 3, c.norm_ffn, lds, c.G);
    cvt_weight(c.w_dn, (bf16_t*)(ws + WS_WDN), FE, D, NE, 0, nullptr, lds, c.G);
    cvt_weight(c.w_pg, (bf16_t*)(ws + WS_WPG), D, D, DEPTH, 4, c.norm_ple, lds, c.G);
    cvt_weight(c.w_pp, (bf16_t*)(ws + WS_WPP), PLE, D, DEPTH, 0, nullptr, lds, c.G);
    { float* wr = (float*)(ws + WS_WR);
      for (int i = blockIdx.x * NTHR + threadIdx.x; i < DEPTH * 80 * D; i += c.G * NTHR) { const int k = i & (D - 1), n = (i >> 10) % 80, L = i / (80 * D);
          float v = 0.f; if (n < 8) v = c.w_coarse[((size_t)L * D + k) * 8 + n]; else if (n < 72) v = c.w_fine[((size_t)L * D + k) * 64 + (n - 8)];
          v *= c.norm_ffn[L * D + k]; wr[i] = v; const unsigned hb_ = f2bf(v); ((bf16_t*)(ws + WS_WRH))[i] = (bf16_t)hb_; ((bf16_t*)(ws + WS_WRH))[(size_t)DEPTH * 80 * D + i] = (bf16_t)f2bf(v - bf2f(hb_)); } }
    { float* ones = (float*)(ws + WS_ONES); for (int i = blockIdx.x * NTHR + threadIdx.x; i < 1024; i += c.G * NTHR) ones[i] = 1.f; }
    { const size_t n4 = (size_t)DEPTH * T * PLE / 4; const f32x4* s = (const f32x4*)c.p; uint2* d = (uint2*)(ws + WS_PB);
      for (size_t i = (size_t)blockIdx.x * NTHR + threadIdx.x; i < n4; i += (size_t)c.G * NTHR) { const f32x4 v = s[i]; d[i] = make_uint2(pk2(v.x, v.y), pk2(v.z, v.w)); } }
    { const int tid_ = opaque_tid(); const int w = tid_ >> 6, lane = tid_ & 63; bf16_t* hb = (bf16_t*)(ws + WS_HB); float* ssq = (float*)(ws + WS_SSQ);
      const int stride = c.G * NWAVES;
      for (int tok0 = blockIdx.x * NWAVES + w; tok0 < T; tok0 += 4 * stride) {
          f32x4 v[4][4];
#pragma unroll
          for (int q = 0; q < 4; ++q) { const int tok = tok0 + q * stride; const f32x4* xr = (const f32x4*)(c.x + (size_t)((tok < T) ? tok : tok0) * D) + lane;
#pragma unroll
              for (int j = 0; j < 4; ++j) v[q][j] = xr[64 * j]; }
#pragma unroll
          for (int q = 0; q < 4; ++q) { const int tok = tok0 + q * stride; if (tok < T) { uint2* o = (uint2*)(hb + (size_t)tok * D) + lane; float s = 0.f;
#pragma unroll
              for (int j = 0; j < 4; ++j) { const f32x4 t = v[q][j]; s += (t.x * t.x + t.y * t.y) + (t.z * t.z + t.w * t.w); o[64 * j] = make_uint2(pk2(t.x, t.y), pk2(t.z, t.w)); }
              s = wave_sum(s); if (lane < 4) ssq[(size_t)tok * 4 + lane] = (lane == 0) ? s : 0.f; } } } }
}


template <int NL> struct CvtGeo { static constexpr int NT = (NL == 8) ? 32 : 64, PER_LAYER = 64 * 16 * NT + 64 * 8 * NT, KQM = (NL == 8) ? 7 : 15, KQS = (NL == 8) ? 3 : 4; };
struct CvtAddr { const float* sp; bf16_t* dp; const float* g; int N, K, n, perm; };
template <int NL> DEV CvtAddr moe_cvt_addr(const Ctx& c, int L0, int idx, int lane) {
    typedef CvtGeo<NL> G_; CvtAddr a; const int Lc = L0 + idx / G_::PER_LAYER; int t = idx % G_::PER_LAYER; const int kq = lane & G_::KQM, n4 = lane >> G_::KQS;
    if (t < 64 * 16 * G_::NT) { const int e = t / (16 * G_::NT), kt = (t / G_::NT) & 15, nt = t % G_::NT; const int k0 = kt * 64 + NL * kq; a.n = nt * (4 * NL) + 4 * n4; a.N = 1024; a.K = D; a.perm = 1;
        a.sp = c.w_gu + ((size_t)(Lc * NE + e) * D + k0) * 1024 + a.n; a.dp = (bf16_t*)(c.ws + WS_WGU) + (size_t)(Lc * NE + e) * 1024 * D + k0; a.g = c.norm_ffn + Lc * D + k0; }
    else { t -= 64 * 16 * G_::NT; const int e = t / (8 * G_::NT), kt = (t / G_::NT) & 7, nt = t % G_::NT; const int k0 = kt * 64 + NL * kq; a.n = nt * (4 * NL) + 4 * n4; a.N = D; a.K = FE; a.perm = 0;
        a.sp = c.w_dn + ((size_t)(Lc * NE + e) * FE + k0) * D + a.n; a.dp = (bf16_t*)(c.ws + WS_WDN) + (size_t)(Lc * NE + e) * D * FE + k0; a.g = (const float*)(c.ws + WS_ONES) + k0; }
    return a;
}
template <int NL> DEV void moe_cvt_issue(const Ctx& c, int L0, int idx, int lane, f32x4 (&v)[NL], f32x4 (&gv)[NL / 4]) {
    const CvtAddr a = moe_cvt_addr<NL>(c, L0, idx, lane);
#pragma unroll
    for (int j = 0; j < NL; ++j) v[j] = *(const f32x4*)(a.sp + (size_t)j * a.N);
#pragma unroll
    for (int j = 0; j < NL / 4; ++j) gv[j] = *(const f32x4*)(a.g + 4 * j);
}
template <int NL> DEV void moe_cvt_finish(const Ctx& c, int L0, int idx, int lane, const f32x4 (&v)[NL], const f32x4 (&gv)[NL / 4]) {
    const CvtAddr a = moe_cvt_addr<NL>(c, L0, idx, lane);
#pragma unroll
    for (int jj = 0; jj < 4; ++jj) { int nn = a.n + jj;
        if (a.perm) { if (nn < 512) nn = 256 * (nn >> 7) + (nn & 127); else { const int q = nn - 512; nn = 256 * (q >> 7) + 128 + (q & 127); } }
        unsigned w[NL / 2];
#pragma unroll
        for (int j = 0; j < NL / 2; ++j) w[j] = cvt_pk_bf16(v[2 * j][jj] * gv[(2 * j) >> 2][(2 * j) & 3], v[2 * j + 1][jj] * gv[(2 * j + 1) >> 2][(2 * j + 1) & 3]);
        if constexpr (NL == 8) { u32x4 ww; ww.x = w[0]; ww.y = w[1]; ww.z = w[2]; ww.w = w[3]; *(u32x4*)(a.dp + (size_t)nn * a.K) = ww; }
        else { u32x2 ww; ww.x = w[0]; ww.y = w[1]; *(u32x2*)(a.dp + (size_t)nn * a.K) = ww; } }
}
struct CvtHost { int nxt, pend, step, total, L0; };
#define CVT_TICK(NL, H, c, lane, v, gv) do { if ((H).pend >= 0) { moe_cvt_finish<NL>(c, (H).L0, (H).pend, lane, v, gv); (H).pend = -1; } \
        if ((H).nxt < (H).total) { moe_cvt_issue<NL>(c, (H).L0, (H).nxt, lane, v, gv); (H).pend = (H).nxt; (H).nxt += (H).step; } } while (0)
#define CVT_DRAIN(NL, H, c, lane, v, gv) do { asm volatile("s_waitcnt vmcnt(0)" ::: "memory"); if ((H).pend >= 0) { moe_cvt_finish<NL>(c, (H).L0, (H).pend, lane, v, gv); (H).pend = -1; } \
        while ((H).nxt < (H).total) { f32x4 v1_[NL], g1_[NL / 4], v2_[NL], g2_[NL / 4], v3_[NL], g3_[NL / 4]; const int i0_ = (H).nxt, i1_ = i0_ + (H).step, i2_ = i1_ + (H).step, i3_ = i2_ + (H).step; \
            moe_cvt_issue<NL>(c, (H).L0, i0_, lane, v, gv); if (i1_ < (H).total) moe_cvt_issue<NL>(c, (H).L0, i1_, lane, v1_, g1_); if (i2_ < (H).total) moe_cvt_issue<NL>(c, (H).L0, i2_, lane, v2_, g2_); \
            if (i3_ < (H).total) moe_cvt_issue<NL>(c, (H).L0, i3_, lane, v3_, g3_); \
            moe_cvt_finish<NL>(c, (H).L0, i0_, lane, v, gv); if (i1_ < (H).total) moe_cvt_finish<NL>(c, (H).L0, i1_, lane, v1_, g1_); if (i2_ < (H).total) moe_cvt_finish<NL>(c, (H).L0, i2_, lane, v2_, g2_); \
            if (i3_ < (H).total) moe_cvt_finish<NL>(c, (H).L0, i3_, lane, v3_, g3_); (H).nxt = i3_ + (H).step; } } while (0)

typedef short s16x4 __attribute__((ext_vector_type(4)));
typedef short v4i16_t __attribute__((ext_vector_type(4)));
DEV s16x4 vtr(const LAS unsigned char* p) { return __builtin_bit_cast(s16x4, __builtin_amdgcn_ds_read_tr16_b64_v4i16((LAS v4i16_t*)p)); }
DEV void glds16(const void* g, LAS unsigned char* l) { __builtin_amdgcn_global_load_lds((const unsigned*)g, (LAS unsigned*)l, 16, 0, 0); }
DEV float xhalf_max(float v) { auto rr = __builtin_amdgcn_permlane32_swap(__float_as_uint(v), __float_as_uint(v), false, false); return fmaxf(__uint_as_float(rr[0]), __uint_as_float(rr[1])); }
DEV float xhalf_sum(float v) { auto rr = __builtin_amdgcn_permlane32_swap(__float_as_uint(v), __float_as_uint(v), false, false); return __uint_as_float(rr[0]) + __uint_as_float(rr[1]); }
DEV bf16x8 pack8(const f32x16& p, int s8) {
    u32x4 w; w.x = cvt_pk_bf16(p[s8], p[s8 + 1]); w.y = cvt_pk_bf16(p[s8 + 2], p[s8 + 3]); w.z = cvt_pk_bf16(p[s8 + 4], p[s8 + 5]); w.w = cvt_pk_bf16(p[s8 + 6], p[s8 + 7]);
    return __builtin_bit_cast(bf16x8, w);
}
#define ATT_WAITV(n) asm volatile("s_waitcnt vmcnt(" #n ")" ::: "memory")
#define ATT_BAR() asm volatile("s_waitcnt lgkmcnt(0)\n\ts_barrier" ::: "memory")
#define MFMA32(a, b, c) __builtin_amdgcn_mfma_f32_32x32x16_bf16((a), (b), (c), 0, 0, 0)

DEV void attB_stage(const bf16_t* kvb, int t, LAS unsigned char* buf, int wid, int lane) {
    if (wid < 4) { const int cc = wid >> 1;
#pragma unroll
        for (int j = 0; j < 4; ++j) { const int kk = (wid & 1) * 4 + j, row = 8 * kk + (lane >> 3), ch = (lane & 7) ^ ((row >> 1) & 7);
            glds16(kvb + hm(16 + cc, 64 * t + row) + ch * 8, buf + cc * 8192 + kk * 1024); }
    } else {
#pragma unroll
        for (int j = 0; j < 4; ++j) { const int kk = (wid - 4) * 4 + j, row = 4 * kk + (lane >> 4), ch = (lane & 15) ^ ((row & 3) << 2);
            glds16(kvb + hm(32 + (ch >> 3), 64 * t + row) + (ch & 7) * 8, buf + 16384 + kk * 1024); }
    }
}
DEV void attB_kmax(const Ctx& c) {
    const int tid_ = opaque_tid(); const int w = tid_ >> 6, lane = tid_ & 63;
    const bf16_t* qkv = (const bf16_t*)(c.ws + WS_QKV); float* km = (float*)(c.ws + WS_KMAX);
    for (int it = blockIdx.x * NWAVES + w; it < 8 * 8 * 2 * 64; it += c.G * NWAVES) {
        const int t = it & 63, cc = (it >> 6) & 1, h = (it >> 7) & 7, b = it >> 10;
        const uint4* kp = (const uint4*)(qkv + hm(16 + 2 * h + cc, b * SEQ + 64 * t + lane)); float s = 0.f;
#pragma unroll
        for (int j = 0; j < 8; ++j) { const uint4 v = kp[j]; const unsigned ws_[4] = {v.x, v.y, v.z, v.w};
#pragma unroll
            for (int k = 0; k < 4; ++k) { const float a = bf2f(ws_[k] & 0xffffu), bq = bf2f(ws_[k] >> 16); s += a * a + bq * bq; } }
        s = wave_max(s);
        if (lane == 0) km[it] = sqrtf(s) * 1.01f;
    }
}
DEV void attB_fast(const Ctx& c, float lam, float lambda_init, const float* subln, LAS unsigned char* lds) {
    const int tid = opaque_tid(), wid = __builtin_amdgcn_readfirstlane(tid >> 6), lane = tid & 63, r = lane & 31, hh = lane >> 5;
    const int qt = wid & 3, cc = wid >> 2;
    const bf16_t* qkv = (const bf16_t*)(c.ws + WS_QKV); bf16_t* o = (bf16_t*)(c.ws + WS_O);
    const int vcu = (c.G % 8 == 0) ? ((int)blockIdx.x % 8) * (c.G / 8) + (int)blockIdx.x / 8 : (int)blockIdx.x;
    int koff[4], voff[4];
#pragma unroll
    for (int ds = 0; ds < 4; ++ds) koff[ds] = r * 128 + (((2 * ds + hh) ^ ((r >> 1) & 7)) << 4);
    { const int i16 = lane & 15, qp = i16 >> 2, pp = i16 & 3, blk = (lane >> 4) & 1;
#pragma unroll
      for (int db = 0; db < 4; ++db) voff[db] = (4 * hh + qp) * 256 + 8 * (pp & 1) + ((((db ^ qp) << 2) + 2 * blk + (pp >> 1)) << 4); }
    CvtHost H; H.L0 = 1; H.total = 2 * CvtGeo<4>::PER_LAYER; H.step = c.G * NWAVES; H.nxt = (int)blockIdx.x * NWAVES + wid; H.pend = -1; f32x4 cv[4], cg[1];
    LAS unsigned* flags = (LAS unsigned*)(lds + TBL_RED);
    const float* kmaxp = (const float*)(c.ws + WS_KMAX);
    for (int pu = vcu; pu < 1024; pu += c.G) {
        const int iu = pu >> 8, vq = pu & 255, g16 = (vq >> 4) & 15, s = vq & 15, b = g16 >> 1;
        const int h = (g16 & 1) ? ((iu == 0) ? 6 : (iu == 1) ? 1 : (iu == 2) ? 0 : 5) : ((iu == 0) ? 7 : (iu == 1) ? 2 : (iu == 2) ? 3 : 4);
        float kms = kmaxp[((b * 8 + h) * 2 + cc) * 64 + lane];
#pragma unroll
        for (int d = 1; d < 64; d <<= 1) { const float v = __shfl_up(kms, d); if (lane >= d) kms = fmaxf(kms, v); }
        const float slope2 = exp2f(-(float)(h + 1)) * LOG2E;
        f32x16 Bt;
#pragma unroll
        for (int i = 0; i < 16; ++i) Bt[i] = slope2 * (float)(crow(i, hh) - r);
        const bf16_t* kvb = qkv + hm(2 * h, b * SEQ);
        for (int half = 0; half < 2; ++half) {
            const int qb = half ? 31 - s : s, Q0 = qb * 128, Tn = 2 * qb + 2, qrow0 = Q0 + 32 * qt;
            attB_stage(kvb, Tn - 1, lds, wid, lane);
            ATT_BAR();
            float qn = 0.f;
            LAS unsigned char* const qlds = lds + 98304 + wid * 4096 + lane * 16;
            { const bf16_t* qp_ = kvb + hm(cc, qrow0 + r) + 8 * hh;
#pragma unroll
              for (int ds = 0; ds < 4; ++ds) { const bf16x8 qv = *(const bf16x8*)(qp_ + 16 * ds); *(LAS bf16x8*)(qlds + ds * 1024) = qv;
#pragma unroll
                  for (int j = 0; j < 8; ++j) { const float v = bf2f((unsigned)(unsigned short)qv[j]); qn += v * v; } } }
            attB_stage(kvb, Tn - 2, lds + 32768, wid, lane);
            qn = sqrtf(xhalf_sum(qn)) * 1.01f;
            if (lane == 0) { flags[wid] = 1u; flags[8 + wid] = 1u; }
            int par = 0;
            f32x16 O[4];
#pragma unroll
            for (int db = 0; db < 4; ++db)
#pragma unroll
                for (int i = 0; i < 16; ++i) O[db][i] = 0.f;
            float m = -1e30f, l = 0.f; int bi = 0;
            for (int t = Tn - 1; t >= 0; --t) {
                ATT_WAITV(0);
                ATT_BAR();
                { unsigned al = 0u;
#pragma unroll
                  for (int k = 0; k < 8; ++k) al |= flags[par * 8 + k];
                  if (__builtin_amdgcn_readfirstlane(al) == 0u) break; }
                if ((par & 1) == 0) CVT_TICK(4, H, c, lane, cv, cg);
                if (t >= 2) attB_stage(kvb, t - 2, lds + ((bi + 2) % 3) * 32768, wid, lane);
                if (64 * t <= qrow0) {
                    const LAS unsigned char* Kb = lds + bi * 32768 + cc * 8192; const LAS unsigned char* Vb = lds + bi * 32768 + 16384;
                    f32x16 p0 = Bt, p1 = Bt;
#pragma unroll
                    for (int ds = 0; ds < 4; ++ds) { const bf16x8 k0 = *(const LAS bf16x8*)(Kb + koff[ds]), k1 = *(const LAS bf16x8*)(Kb + 4096 + koff[ds]), qv = *(const LAS bf16x8*)(qlds + ds * 1024); p0 = MFMA32(k0, qv, p0); p1 = MFMA32(k1, qv, p1); }
                    const float off0 = slope2 * (float)(64 * t - qrow0), off1 = off0 + 32.f * slope2;
                    if (64 * t + 63 > qrow0) {
#pragma unroll
                        for (int i = 0; i < 16; ++i) { const int key = 64 * t + crow(i, hh); if (key > qrow0 + r) p0[i] = -INFINITY; if (key + 32 > qrow0 + r) p1[i] = -INFINITY; } }
                    float mx0 = p0[0], mx1 = p1[0];
#pragma unroll
                    for (int i = 1; i < 16; ++i) { mx0 = fmaxf(mx0, p0[i]); mx1 = fmaxf(mx1, p1[i]); }
                    const float mx = xhalf_max(fmaxf(mx0 + off0, mx1 + off1));
                    if (__any(mx > m + 8.f)) { const float mn = fmaxf(m, mx), f = __builtin_amdgcn_exp2f(m - mn); l *= f; m = mn;
#pragma unroll
                        for (int db = 0; db < 4; ++db)
#pragma unroll
                            for (int i = 0; i < 16; ++i) O[db][i] *= f; }
                    const float e0 = off0 - m, e1 = off1 - m; float ls = 0.f;
#pragma unroll
                    for (int i = 0; i < 16; ++i) { p0[i] = __builtin_amdgcn_exp2f(p0[i] + e0); p1[i] = __builtin_amdgcn_exp2f(p1[i] + e1); ls += p0[i] + p1[i]; }
                    l += ls;
                    bf16x8 pa[4]; pa[0] = pack8(p0, 0); pa[1] = pack8(p0, 8); pa[2] = pack8(p1, 0); pa[3] = pack8(p1, 8);
#pragma unroll
                    for (int db = 0; db < 4; ++db) { const unsigned va = (unsigned)(uintptr_t)(Vb + voff[db]); s16x4 lo[4], hi[4];
#pragma unroll
                        for (int ks = 0; ks < 4; ++ks) { asm volatile("ds_read_b64_tr_b16 %0, %1 offset:%c2" : "=&v"(lo[ks]) : "v"(va), "i"(ks * 4096) : "memory");
                                                         asm volatile("ds_read_b64_tr_b16 %0, %1 offset:%c2" : "=&v"(hi[ks]) : "v"(va), "i"(ks * 4096 + 2048) : "memory"); }
                        asm volatile("s_waitcnt lgkmcnt(0)" ::: "memory"); __builtin_amdgcn_sched_barrier(0);
#pragma unroll
                        for (int ks = 0; ks < 4; ++ks) { const bf16x8 vf = (bf16x8){lo[ks][0], lo[ks][1], lo[ks][2], lo[ks][3], hi[ks][0], hi[ks][1], hi[ks][2], hi[ks][3]}; O[db] = MFMA32(vf, pa[ks], O[db]); } }
                }
                bi = (bi + 1) % 3; par ^= 1;
                if (t >= 1) { const float kb = __builtin_amdgcn_readlane(kms, t - 1);
                    const float ub = qn * kb + slope2 * (float)(64 * (t - 1) + 63 - (qrow0 + r)) - m;
                    const bool alive = __any(ub > -36.f); if (lane == 0) flags[par * 8 + wid] = alive ? 1u : 0u; }
            }
            ATT_WAITV(0);
            l = xhalf_sum(l);
            ATT_BAR();
            LAS float* X = (LAS float*)(lds + 65536) + qt * 4096;
            if (cc == 1) { const float sc = lam / l;
#pragma unroll
                for (int db = 0; db < 4; ++db)
#pragma unroll
                    for (int i = 0; i < 16; ++i) X[(db * 16 + i) * 64 + lane] = O[db][i] * sc; }
            ATT_BAR();
            if (cc == 0) { const float inv = 1.f / l; float ss = 0.f;
#pragma unroll
                for (int db = 0; db < 4; ++db)
#pragma unroll
                    for (int i = 0; i < 16; ++i) { const float v = O[db][i] * inv - X[(db * 16 + i) * 64 + lane]; O[db][i] = v; ss += v * v; }
                ss = xhalf_sum(ss); const float rs = rsqrtf(ss * (1.f / 128.f) + EPS) * (1.f - lambda_init);
                bf16_t* op = o + (size_t)(b * SEQ + qrow0 + r) * D + h * 128 + 4 * hh;
#pragma unroll
                for (int db = 0; db < 4; ++db)
#pragma unroll
                    for (int g = 0; g < 4; ++g) { const int d = 32 * db + 8 * g; const f32x4 sl = *(const f32x4*)(subln + d + 4 * hh);
                        u32x2 w; w.x = cvt_pk_bf16(O[db][4 * g] * rs * sl[0], O[db][4 * g + 1] * rs * sl[1]); w.y = cvt_pk_bf16(O[db][4 * g + 2] * rs * sl[2], O[db][4 * g + 3] * rs * sl[3]);
                        *(u32x2*)(op + d) = w; } }
        }
    }
    CVT_DRAIN(4, H, c, lane, cv, cg);
    ATT_WAITV(0);
    ATT_BAR();
}

DEV void attC_stage(const bf16_t* kvb, int t, LAS unsigned char* buf, int wid, int lane) {
    const int row = 8 * wid + (lane >> 3);
    glds16(kvb + hm(16, 64 * t + row) + (((lane & 7) ^ ((row >> 1) & 7)) << 3), buf + wid * 1024);
    glds16(kvb + hm(32, 64 * t + row) + (((lane & 7) ^ (((row >> 1) & 1) << 2)) << 3), buf + 8192 + wid * 1024);
}
DEV float sb_scan(const f32x16& w, f32x16& a, float Rin, int hh) {
    float ex[16], gp[4], gq[4];
#pragma unroll
    for (int g = 0; g < 4; ++g) { const float t23 = w[4 * g + 2] * w[4 * g + 3], s0 = w[4 * g + 1] * t23; gp[g] = w[4 * g] * s0; ex[4 * g] = s0; ex[4 * g + 1] = t23; ex[4 * g + 2] = w[4 * g + 3]; ex[4 * g + 3] = 1.f; }
    float pp[4];
#pragma unroll
    for (int g = 0; g < 4; ++g) { auto rr = __builtin_amdgcn_permlane32_swap(__float_as_uint(gp[g]), __float_as_uint(gp[g]), false, false);
        const float lo = __uint_as_float(rr[0]), hi = __uint_as_float(rr[1]); pp[g] = lo * hi; gq[g] = hh ? 1.f : hi; }
    float Q[4]; Q[3] = 1.f; Q[2] = pp[3]; Q[1] = pp[2] * Q[2]; Q[0] = pp[1] * Q[1];
    const float tot = pp[0] * Q[0];
#pragma unroll
    for (int g = 0; g < 4; ++g) { const float base = Rin * Q[g] * gq[g];
#pragma unroll
        for (int j = 0; j < 4; ++j) a[4 * g + j] = a[4 * g + j] * (base * ex[4 * g + j]); }
    return tot;
}
DEV void attC_fast(const Ctx& c, LAS unsigned char* lds) {
    const int tid = opaque_tid(), wid = __builtin_amdgcn_readfirstlane(tid >> 6), lane = tid & 63, r = lane & 31, hh = lane >> 5;
    const bf16_t* qkv = (const bf16_t*)(c.ws + WS_QKV); bf16_t* o = (bf16_t*)(c.ws + WS_O);
    const int vcu = (c.G % 8 == 0) ? ((int)blockIdx.x % 8) * (c.G / 8) + (int)blockIdx.x / 8 : (int)blockIdx.x;
    CvtHost H; H.L0 = 3; H.total = CvtGeo<8>::PER_LAYER; H.step = c.G * NWAVES; H.nxt = (int)blockIdx.x * NWAVES + wid; H.pend = -1; f32x4 cv[8], cg[2];
    LAS unsigned* flags = (LAS unsigned*)(lds + 49152);
    int koff[4], voff[2];
#pragma unroll
    for (int ds = 0; ds < 4; ++ds) koff[ds] = r * 128 + (((2 * ds + hh) ^ ((r >> 1) & 7)) << 4);
    { const int i16 = lane & 15, qp = i16 >> 2, pp = i16 & 3, blk = (lane >> 4) & 1;
#pragma unroll
      for (int db = 0; db < 2; ++db) voff[db] = (4 * hh + qp) * 128 + 8 * (pp & 1) + (((4 * (db ^ (qp >> 1))) + 2 * blk + (pp >> 1)) << 4); }
    for (int un = vcu; un < 2048; un += c.G) {
        const int bh = un >> 4, qb = un & 15, b = bh >> 4, h = bh & 15;
        const bf16_t* kvb = qkv + hm(h, b * SEQ);
        const int Q0 = qb * 256, qrow0 = Q0 + 32 * wid, T1 = Q0 / 64 + 3;
        attC_stage(kvb, T1, lds, wid, lane);
        bf16x8 qf[4];
        { const bf16_t* qp_ = kvb + hm(0, qrow0 + r) + 8 * hh;
#pragma unroll
          for (int ds = 0; ds < 4; ++ds) qf[ds] = *(const bf16x8*)(qp_ + 16 * ds); }
        attC_stage(kvb, T1 - 1, lds + 16384, wid, lane);
        f32x16 O[2];
#pragma unroll
        for (int db = 0; db < 2; ++db)
#pragma unroll
            for (int i = 0; i < 16; ++i) O[db][i] = 0.f;
        float R = 1.f; int bi = 0, par = 0;
        if (lane == 0) { flags[wid] = 1u; flags[8 + wid] = 1u; }
        for (int t = T1; t >= 0; --t) {
            ATT_WAITV(0);
            ATT_BAR();
            { unsigned al = 0u;
#pragma unroll
              for (int k = 0; k < 8; ++k) al |= flags[par * 8 + k];
              if (__builtin_amdgcn_readfirstlane(al) == 0u) break; }
            CVT_TICK(8, H, c, lane, cv, cg);
            if (t >= 2) attC_stage(kvb, t - 2, lds + ((bi + 2) % 3) * 16384, wid, lane);
            if (64 * t < qrow0 + 31) {
                const LAS unsigned char* Kb = lds + bi * 16384; const LAS unsigned char* Vb = Kb + 8192;
                f32x16 p0, p1;
#pragma unroll
                for (int i = 0; i < 16; ++i) { p0[i] = 0.f; p1[i] = 0.f; }
#pragma unroll
                for (int ds = 0; ds < 4; ++ds) { const bf16x8 k0 = *(const LAS bf16x8*)(Kb + koff[ds]), k1 = *(const LAS bf16x8*)(Kb + 4096 + koff[ds]); p0 = MFMA32(k0, qf[ds], p0); p1 = MFMA32(k1, qf[ds], p1); }
                const bool diag = 64 * t + 63 >= qrow0;
                f32x16 w0, w1;
#pragma unroll
                for (int i = 0; i < 16; ++i) {
                    const float E0 = __builtin_amdgcn_exp2f(fminf(p0[i], 60.f)), E1 = __builtin_amdgcn_exp2f(fminf(p1[i], 60.f));
                    float v0 = __builtin_amdgcn_rcpf(1.f + E0), v1 = __builtin_amdgcn_rcpf(1.f + E1); float b0 = E0 * v0, b1 = E1 * v1;
                    if (diag) { const int key = 64 * t + crow(i, hh); if (key >= qrow0 + r) { v0 = 1.f; b0 = 0.f; } if (key + 32 >= qrow0 + r) { v1 = 1.f; b1 = 0.f; } }
                    w0[i] = v0; w1[i] = v1; p0[i] = b0; p1[i] = b1; }
                const float tot1 = sb_scan(w1, p1, R, hh);
                const float R1 = R * tot1;
                const float tot0 = sb_scan(w0, p0, R1, hh);
                R = R1 * tot0;
                bf16x8 pa[4]; pa[0] = pack8(p0, 0); pa[1] = pack8(p0, 8); pa[2] = pack8(p1, 0); pa[3] = pack8(p1, 8);
#pragma unroll
                for (int db = 0; db < 2; ++db) { const unsigned va = (unsigned)(uintptr_t)(Vb + voff[db]); s16x4 lo[4], hi[4];
#pragma unroll
                    for (int ks = 0; ks < 4; ++ks) { asm volatile("ds_read_b64_tr_b16 %0, %1 offset:%c2" : "=&v"(lo[ks]) : "v"(va), "i"(ks * 2048) : "memory");
                                                     asm volatile("ds_read_b64_tr_b16 %0, %1 offset:%c2" : "=&v"(hi[ks]) : "v"(va), "i"(ks * 2048 + 1024) : "memory"); }
                    asm volatile("s_waitcnt lgkmcnt(0)" ::: "memory"); __builtin_amdgcn_sched_barrier(0);
#pragma unroll
                    for (int ks = 0; ks < 4; ++ks) { const bf16x8 vf = (bf16x8){lo[ks][0], lo[ks][1], lo[ks][2], lo[ks][3], hi[ks][0], hi[ks][1], hi[ks][2], hi[ks][3]}; O[db] = MFMA32(vf, pa[ks], O[db]); } }
            }
            par ^= 1;
            { const bool alive = __any(R > 8.6736174e-19f); if (lane == 0) flags[par * 8 + wid] = alive ? 1u : 0u; }
            bi = (bi + 1) % 3;
        }
        ATT_WAITV(0);
        bf16_t* op = o + (size_t)(b * SEQ + qrow0 + r) * D + h * 64 + 4 * hh;
#pragma unroll
        for (int db = 0; db < 2; ++db)
#pragma unroll
            for (int g = 0; g < 4; ++g) { u32x2 wv; wv.x = cvt_pk_bf16(O[db][4 * g], O[db][4 * g + 1]); wv.y = cvt_pk_bf16(O[db][4 * g + 2], O[db][4 * g + 3]); *(u32x2*)(op + 32 * db + 8 * g) = wv; }
        ATT_BAR();
    }
    CVT_DRAIN(8, H, c, lane, cv, cg);
    ATT_WAITV(0);
}

struct AUnit { int b, h, g, cres, rr, i0; };
DEV AUnit attA_unit(int un, int g) {
    AUnit u; const int bh = un >> 4, j = un & 15; u.b = bh >> 4; u.h = bh & 15; u.g = g;
    int m; if (g == 0) { u.cres = 0; m = j; } else if (g == 1) { u.cres = j >> 2; m = j & 3; } else { u.cres = j; m = 0; }
    u.rr = (g == 0) ? 1 : (g == 1 ? 4 : 16); u.i0 = m * 256; return u;
}
DEV void attA_fast(const Ctx& c, int grp, LAS unsigned char* lds) {
    const int tid = opaque_tid(), wid = __builtin_amdgcn_readfirstlane(tid >> 6), lane = tid & 63, r = lane & 31, hh = lane >> 5;
    const bf16_t* qkv = (const bf16_t*)(c.ws + WS_QKV + (size_t)(grp & 1) * 208 * MiB); bf16_t* og = (bf16_t*)(c.ws + WS_OG); float* lse = (float*)(c.ws + WS_LSE); bf16_t* omerged = (bf16_t*)(c.ws + WS_O);
    const int vcu = (c.G % 8 == 0) ? ((int)blockIdx.x % 8) * (c.G / 8) + (int)blockIdx.x / 8 : (int)blockIdx.x;
    int koff[4], voff[2];
#pragma unroll
    for (int ds = 0; ds < 4; ++ds) koff[ds] = r * 128 + (((2 * ds + hh) ^ ((r >> 1) & 7)) << 4);
    { const int i16 = lane & 15, qp = i16 >> 2, pp = i16 & 3, blk = (lane >> 4) & 1;
#pragma unroll
      for (int db = 0; db < 2; ++db) voff[db] = (4 * hh + qp) * 128 + 8 * (pp & 1) + (((4 * (db ^ (qp >> 1))) + 2 * blk + (pp >> 1)) << 4); }
    LAS unsigned char* const Kb = lds; LAS unsigned char* const Vb = lds + 49152;
    LAS unsigned char* const Qw = lds + 98304 + wid * 4096;
#define ATTA_LOAD_KQ(U) do { const bf16_t* base_ = qkv + hm((U).h, (U).b * SEQ); \
        _Pragma("unroll") for (int k = 0; k < 6; ++k) { const int row = 8 * (6 * wid + k) + (lane >> 3); int ik = (U).i0 - 128 + row; ik = ik < 0 ? 0 : ik; \
            glds16(base_ + hm(16, ik * (U).rr + (U).cres) + (((lane & 7) ^ ((row >> 1) & 7)) << 3), Kb + (6 * wid + k) * 1024); } \
        } while (0)
#define ATTA_LOAD_Q(U) do { const bf16_t* qp_ = qkv + hm((U).h, (U).b * SEQ) + hm(0, ((U).i0 + 32 * wid + r) * (U).rr + (U).cres) + 8 * hh; \
        _Pragma("unroll") for (int ds = 0; ds < 4; ++ds) glds16(qp_ + 16 * ds, Qw + ds * 1024); } while (0)
    int un = vcu;
    AUnit u = attA_unit(un < 2048 ? un : 0, grp);
    if (un < 2048) { ATTA_LOAD_KQ(u); ATTA_LOAD_Q(u); }
    for (; un < 2048; un += c.G) {
        const int unn = un + c.G; const AUnit nu = attA_unit(unn < 2048 ? unn : 0, grp);
        const bf16_t* base = qkv + hm(u.h, u.b * SEQ);
        ATT_WAITV(0);
        ATT_BAR();
#pragma unroll
        for (int k = 0; k < 6; ++k) { const int row = 8 * (6 * wid + k) + (lane >> 3); int ik = u.i0 - 128 + row; ik = ik < 0 ? 0 : ik;
            glds16(base + hm(32, ik * u.rr + u.cres) + (((lane & 7) ^ (((row >> 1) & 1) << 2)) << 3), Vb + (6 * wid + k) * 1024); }
        const int tokq = u.b * SEQ + (u.i0 + 32 * wid + r) * u.rr + u.cres;
        const float sr = exp2f(-0.5f * (float)(u.h + 1)) * LOG2E * (float)u.rr;
        f32x16 S[5];
#pragma unroll
        for (int sidx = 0; sidx < 5; ++sidx) {
#pragma unroll
            for (int i = 0; i < 16; ++i) S[sidx][i] = sr * (float)(crow(i, hh) - r + 32 * sidx - 128);
            if (u.i0 + 32 * wid - 128 + 32 * sidx >= 0) {
                const LAS unsigned char* kb = Kb + (32 * (wid + sidx)) * 128;
#pragma unroll
                for (int ds = 0; ds < 4; ++ds) { const bf16x8 kf = *(const LAS bf16x8*)(kb + koff[ds]), qv = *(const LAS bf16x8*)(Qw + ds * 1024 + lane * 16); S[sidx] = MFMA32(kf, qv, S[sidx]); }
                if (sidx == 0) {
#pragma unroll
                    for (int i = 0; i < 16; ++i) if (crow(i, hh) < r) S[sidx][i] = -INFINITY; }
                if (sidx == 4) {
#pragma unroll
                    for (int i = 0; i < 16; ++i) if (crow(i, hh) > r) S[sidx][i] = -INFINITY; }
            } else {
#pragma unroll
                for (int i = 0; i < 16; ++i) S[sidx][i] = -INFINITY; }
        }
        float mx = S[0][0];
#pragma unroll
        for (int sidx = 0; sidx < 5; ++sidx)
#pragma unroll
            for (int i = 0; i < 16; ++i) mx = fmaxf(mx, S[sidx][i]);
        mx = xhalf_max(mx);
        float l = 0.f; bf16x8 pa[5][2];
#pragma unroll
        for (int sidx = 0; sidx < 5; ++sidx) {
#pragma unroll
            for (int i = 0; i < 16; ++i) { S[sidx][i] = __builtin_amdgcn_exp2f(S[sidx][i] - mx); l += S[sidx][i]; }
            pa[sidx][0] = pack8(S[sidx], 0); pa[sidx][1] = pack8(S[sidx], 8); }
        l = xhalf_sum(l);
        ATT_WAITV(0);
        ATT_BAR();
        if (unn < 2048) ATTA_LOAD_KQ(nu);
        f32x16 O[2];
#pragma unroll
        for (int db = 0; db < 2; ++db)
#pragma unroll
            for (int i = 0; i < 16; ++i) O[db][i] = 0.f;
#pragma unroll
        for (int sidx = 0; sidx < 5; ++sidx) {
            if (u.i0 + 32 * wid - 128 + 32 * sidx >= 0) {
#pragma unroll
                for (int db = 0; db < 2; ++db) { const unsigned va = (unsigned)(uintptr_t)(Vb + (32 * (wid + sidx)) * 128 + voff[db]); s16x4 lo[2], hi[2];
#pragma unroll
                    for (int ks = 0; ks < 2; ++ks) { asm volatile("ds_read_b64_tr_b16 %0, %1 offset:%c2" : "=&v"(lo[ks]) : "v"(va), "i"(ks * 2048) : "memory");
                                                     asm volatile("ds_read_b64_tr_b16 %0, %1 offset:%c2" : "=&v"(hi[ks]) : "v"(va), "i"(ks * 2048 + 1024) : "memory"); }
                    asm volatile("s_waitcnt lgkmcnt(0)" ::: "memory"); __builtin_amdgcn_sched_barrier(0);
#pragma unroll
                    for (int ks = 0; ks < 2; ++ks) { const bf16x8 vf = (bf16x8){lo[ks][0], lo[ks][1], lo[ks][2], lo[ks][3], hi[ks][0], hi[ks][1], hi[ks][2], hi[ks][3]}; O[db] = MFMA32(vf, pa[sidx][ks], O[db]); } }
            }
        }
        const float inv = 1.f / l;
#pragma unroll
        for (int db = 0; db < 2; ++db)
#pragma unroll
            for (int q4 = 0; q4 < 4; ++q4) { u32x2 wv; wv.x = cvt_pk_bf16(O[db][4 * q4] * inv, O[db][4 * q4 + 1] * inv); wv.y = cvt_pk_bf16(O[db][4 * q4 + 2] * inv, O[db][4 * q4 + 3] * inv);
                *(LAS u32x2*)(Qw + r * 128 + (((4 * db + q4) ^ (r & 7)) << 4) + 8 * hh) = wv; }
        const float lse2 = mx + __builtin_amdgcn_logf(l);
        if (grp == 2 && hh == 0) ((LAS float*)(lds + TBL_OFF))[wid * 32 + r] = lse2;
        asm volatile("s_waitcnt lgkmcnt(0)" ::: "memory");
#pragma unroll
        for (int ps = 0; ps < 4; ++ps) { const int row = (lane >> 3) + 8 * ps; const u32x4 vv = *(const LAS u32x4*)(Qw + row * 128 + (((lane & 7) ^ (row & 7)) << 4));
            const int tk = u.b * SEQ + (u.i0 + 32 * wid + row) * u.rr + u.cres; const size_t oo = (size_t)tk * D + u.h * 64 + (lane & 7) * 8;
            if (grp < 2) { *(u32x4*)(og + (size_t)u.g * T * D + oo) = vv; }
            else { const float l0 = lse[(size_t)tk * 16 + u.h], l1 = lse[(size_t)T * 16 + (size_t)tk * 16 + u.h], l2 = ((const LAS float*)(lds + TBL_OFF))[wid * 32 + row];
                const float mm = fmaxf(l0, fmaxf(l1, l2)); const float e0 = __builtin_amdgcn_exp2f(l0 - mm), e1 = __builtin_amdgcn_exp2f(l1 - mm), e2 = __builtin_amdgcn_exp2f(l2 - mm); const float iv = 1.f / (e0 + e1 + e2);
                const float w0 = e0 * iv, w1 = e1 * iv, w2 = e2 * iv;
                const u32x4 x0 = *(const u32x4*)(og + oo), x1 = *(const u32x4*)(og + (size_t)T * D + oo); u32x4 res;
#pragma unroll
                for (int k = 0; k < 4; ++k) { const float lo = w0 * bf2f(x0[k] & 0xffffu) + w1 * bf2f(x1[k] & 0xffffu) + w2 * bf2f(vv[k] & 0xffffu), hi = w0 * bf2f(x0[k] >> 16) + w1 * bf2f(x1[k] >> 16) + w2 * bf2f(vv[k] >> 16); res[k] = cvt_pk_bf16(lo, hi); }
                *(u32x4*)(omerged + oo) = res; } }
        asm volatile("s_waitcnt lgkmcnt(0)" ::: "memory");
        if (unn < 2048) ATTA_LOAD_Q(nu);
        if (grp < 2 && hh == 0) lse[(size_t)u.g * T * 16 + (size_t)tokq * 16 + u.h] = lse2;
        u = nu;
    }
#undef ATTA_LOAD_KQ
#undef ATTA_LOAD_Q
    ATT_WAITV(0);
    ATT_BAR();
}
template <int L, int SH = 0> DEV void phase_router_fast(const Ctx& c, LAS unsigned char* lds) {
    const int tid = opaque_tid(), wid = __builtin_amdgcn_readfirstlane(tid >> 6), lane = tid & 63, fr = lane & 15, fq = lane >> 4;
    LAS float* lg;
    const bf16_t* hbr = (const bf16_t*)(c.ws + WS_HB + (size_t)(L & 1) * 64 * MiB);
    unsigned char* ob = SH ? c.ws + WS_OG : c.ws;
    float* tok_gate = (float*)(ob + (SH ? 0 : WS_TOK)); int* tok_e = (int*)(ob + (SH ? 0 : WS_TOK) + 262144); int* tok_slot = (int*)(ob + (SH ? 0 : WS_TOK) + 524288);
    int* list = (int*)(ob + (SH ? 2 * MiB : WS_LIST)); float* list_rs = (float*)(ob + (SH ? 12 * MiB : WS_LRS)); float* list_gate = (float*)(ob + (SH ? 22 * MiB : WS_LGATE)); unsigned* cnt = ctl(c) + CW_CNT + (SH ? 4 : L) * 64 * CNT_S;
    const bf16_t* wbase = (const bf16_t*)(c.ws + WS_WRH) + (size_t)L * 80 * D;
#define RT_STAGE(ck, bufp) do { _Pragma("unroll") for (int i_ = 0; i_ < 5; ++i_) { const int ii = 5 * wid + i_, part = ii / 20, ri = ii % 20, row = 4 * ri + (lane >> 4); \
        glds16(wbase + (size_t)part * DEPTH * 80 * D + (size_t)row * D + 128 * (ck) + 8 * ((lane & 15) ^ (row & 15)), (bufp) + part * 20480 + ri * 1024); } } while (0)
    lg = (LAS float*)(lds + 81920) + wid * 1344;
    volatile LAS unsigned* lcnt = (volatile LAS unsigned*)(lds + 126976); volatile LAS unsigned* lbase = lcnt + 64;
    if (tid < 64) lcnt[tid] = 0u;
    for (int pass = blockIdx.x; pass < T / 128; pass += c.G) {
        const int tok0 = pass * 128 + wid * 16;
        f32x4 acc[5];
#pragma unroll
        for (int nt = 0; nt < 5; ++nt) acc[nt] = (f32x4){0.f, 0.f, 0.f, 0.f};
        float ssq = 0.f;
        const u32x4* ap8 = (const u32x4*)(hbr + (size_t)(tok0 + fr) * D + 8 * fq);
        RT_STAGE(0, lds);
        for (int ck = 0; ck < 8; ++ck) {
            u32x4 xa[4];
#pragma unroll
            for (int kb = 0; kb < 4; ++kb) xa[kb] = ap8[ck * 16 + kb * 4];
            ATT_WAITV(0);
            ATT_BAR();
            if (ck + 1 < 8) RT_STAGE(ck + 1, lds + ((ck + 1) & 1) * 40960);
            const LAS unsigned char* wb = lds + (ck & 1) * 40960 + fr * 256;
#pragma unroll
            for (int kb = 0; kb < 4; ++kb) {
                { const u32x4 v = xa[kb]; const float e0 = bf2f(v.x & 0xffffu), e1 = bf2f(v.x >> 16), e2 = bf2f(v.y & 0xffffu), e3 = bf2f(v.y >> 16), e4 = bf2f(v.z & 0xffffu), e5 = bf2f(v.z >> 16), e6 = bf2f(v.w & 0xffffu), e7 = bf2f(v.w >> 16);
                  ssq += ((e0 * e0 + e1 * e1) + (e2 * e2 + e3 * e3)) + ((e4 * e4 + e5 * e5) + (e6 * e6 + e7 * e7)); }
                const bf16x8 xhv = __builtin_bit_cast(bf16x8, xa[kb]); const int co = (((4 * kb + fq) ^ fr) << 4);
#pragma unroll
                for (int nt = 0; nt < 5; ++nt) { const bf16x8 wh = *(const LAS bf16x8*)(wb + nt * 4096 + co), wl = *(const LAS bf16x8*)(wb + 20480 + nt * 4096 + co);
                    acc[nt] = __builtin_amdgcn_mfma_f32_16x16x32_bf16(xhv, wh, acc[nt], 0, 0, 0); acc[nt] = __builtin_amdgcn_mfma_f32_16x16x32_bf16(xhv, wl, acc[nt], 0, 0, 0); }
            }
        }
        ssq += __shfl_xor(ssq, 16); ssq += __shfl_xor(ssq, 32);
        const float rs = rsqrtf(ssq * (1.f / D) + EPS);
        if (fq == 0) lg[1280 + fr] = rs;
#pragma unroll
        for (int nt = 0; nt < 5; ++nt)
#pragma unroll
            for (int i = 0; i < 4; ++i) lg[(4 * fq + i) * 80 + 16 * nt + fr] = acc[nt][i];
        wave_lds_fence();
        int e1 = 0, e2i = 0, r1 = 0, r2 = 0; float g1 = 0.f, g2 = 0.f, rsv = 0.f;
        if (lane < 16) { const LAS float* l = lg + lane * 80; rsv = lg[1280 + lane];
            float lc[8]; int gi = 0; float gm = -INFINITY;
#pragma unroll
            for (int j = 0; j < 8; ++j) { lc[j] = l[j] * rsv + c.b_coarse[L * 8 + j]; if (lc[j] > gm) { gm = lc[j]; gi = j; } }
            float gs = 0.f;
#pragma unroll
            for (int j = 0; j < 8; ++j) gs += __expf(lc[j] - gm);
            const float gp = 1.f / gs;
            float f[8];
#pragma unroll
            for (int j = 0; j < 8; ++j) f[j] = l[8 + gi * 8 + j] * rsv + c.b_fine[L * 64 + gi * 8 + j];
            int i1 = 0; float f1 = f[0];
#pragma unroll
            for (int j = 1; j < 8; ++j) if (f[j] > f1) { f1 = f[j]; i1 = j; }
            int i2 = (i1 == 0) ? 1 : 0; float f2 = -INFINITY;
#pragma unroll
            for (int j = 0; j < 8; ++j) if (j != i1 && f[j] > f2) { f2 = f[j]; i2 = j; }
            const float e2 = __expf(f2 - f1); const float p1 = 1.f / (1.f + e2), p2 = e2 / (1.f + e2);
            e1 = gi * 8 + i1; e2i = gi * 8 + i2; g1 = gp * p1; g2 = gp * p2;
            r1 = (int)__hip_atomic_fetch_add((LAS unsigned*)lcnt + e1, 1u, __ATOMIC_RELAXED, __HIP_MEMORY_SCOPE_WORKGROUP); r2 = (int)__hip_atomic_fetch_add((LAS unsigned*)lcnt + e2i, 1u, __ATOMIC_RELAXED, __HIP_MEMORY_SCOPE_WORKGROUP); }
        __syncthreads();
        if (tid < 64) { const unsigned n = lcnt[tid]; lbase[tid] = n ? atomicAdd(cnt + tid * CNT_S, n) : 0u; lcnt[tid] = 0u; }
        __syncthreads();
        if (lane < 16) { const int tok = tok0 + lane; const int s1 = (int)lbase[e1] + r1, s2 = (int)lbase[e2i] + r2; const float gp = 1.f, p1 = g1, p2 = g2;
            list[(size_t)e1 * T + s1] = tok * 2; list[(size_t)e2i * T + s2] = tok * 2 + 1; list_rs[(size_t)e1 * T + s1] = rsv; list_rs[(size_t)e2i * T + s2] = rsv; list_gate[(size_t)e1 * T + s1] = gp * p1; list_gate[(size_t)e2i * T + s2] = gp * p2;
            tok_e[tok * 2] = e1; tok_e[tok * 2 + 1] = e2i; tok_slot[tok * 2] = s1; tok_slot[tok * 2 + 1] = s2; tok_gate[tok * 2] = gp * p1; tok_gate[tok * 2 + 1] = gp * p2; }
        wave_lds_fence();
    }
#undef RT_STAGE
    ATT_WAITV(0);
    ATT_BAR();
}

template <int L, int SH = 0> DEV void phase_combine(const Ctx& c, LAS unsigned char* lds) {
    const int tid_ = opaque_tid(); const int w = tid_ >> 6, lane = tid_ & 63;
    LAS int* tpre = (LAS int*)(lds + TBL_TPRE);
    moe_prefix((const int*)(ctl(c) + CW_CNT + L * 64 * CNT_S), tpre);
    const bf16_t* hsrc = (const bf16_t*)(c.ws + WS_HB + (size_t)(L & 1) * 64 * MiB); bf16_t* hb = SH ? (bf16_t*)(c.ws + WS_OG + 128 * MiB) : (bf16_t*)(c.ws + WS_HB + (size_t)(L & 1) * 64 * MiB);
    float* ssq = SH ? (float*)(c.ws + WS_LSE) : (float*)(c.ws + WS_SSQ + (size_t)(L & 1) * 2 * MiB); const bf16_t* y = (const bf16_t*)(c.ws + WS_Y);
    const int* tok_e = (const int*)(c.ws + WS_TOK + 262144); const int* tok_slot = (const int*)(c.ws + WS_TOK + 524288);
    const int stride = c.G * NWAVES;
    for (int tok0 = blockIdx.x * NWAVES + w; tok0 < T; tok0 += 4 * stride) {
        int e0[4], e1[4], s0[4], s1[4];
#pragma unroll
        for (int q = 0; q < 4; ++q) { const int tok = tok0 + q * stride; const bool ok = tok < T; const int tt = ok ? tok : tok0;
            e0[q] = tok_e[tt * 2]; e1[q] = tok_e[tt * 2 + 1]; s0[q] = tok_slot[tt * 2]; s1[q] = tok_slot[tt * 2 + 1]; }
        u32x4 hv[4][2], ya[4][2], yb[4][2];
#pragma unroll
        for (int q = 0; q < 4; ++q) { const int tok = tok0 + q * stride; const int tt = (tok < T) ? tok : tok0;
            const size_t p0 = (size_t)tpre[e0[q]] * 256 + s0[q], p1 = (size_t)tpre[e1[q]] * 256 + s1[q];
            const u32x4* hs = (const u32x4*)(hsrc + (size_t)tt * D) + lane; const u32x4* y0 = (const u32x4*)(y + p0 * D) + lane; const u32x4* y1 = (const u32x4*)(y + p1 * D) + lane;
#pragma unroll
            for (int j = 0; j < 2; ++j) { hv[q][j] = hs[64 * j]; ya[q][j] = y0[64 * j]; yb[q][j] = y1[64 * j]; } }
#pragma unroll
        for (int q = 0; q < 4; ++q) { const int tok = tok0 + q * stride; if (tok < T) { u32x4* o = (u32x4*)(hb + (size_t)tok * D) + lane; float s = 0.f;
#pragma unroll
            for (int j = 0; j < 2; ++j) { u32x4 r;
#pragma unroll
                for (int k = 0; k < 4; ++k) { const float lo = bf2f(hv[q][j][k] & 0xffffu) + bf2f(ya[q][j][k] & 0xffffu) + bf2f(yb[q][j][k] & 0xffffu), hi = bf2f(hv[q][j][k] >> 16) + bf2f(ya[q][j][k] >> 16) + bf2f(yb[q][j][k] >> 16); r[k] = cvt_pk_bf16(lo, hi); s += lo * lo + hi * hi; }
                o[64 * j] = r; }
            s = wave_sum(s); if (lane < 4) ssq[(size_t)tok * 4 + lane] = (lane == 0) ? s : 0.f; } }
    }
}

DEV void phase_final(const Ctx& c) {
    const int tid_ = opaque_tid(); const int w = tid_ >> 6, lane = tid_ & 63;
    const bf16_t* hb = (const bf16_t*)(c.ws + WS_HB + (size_t)(DEPTH & 1) * 64 * MiB); const float* ssq = (const float*)(c.ws + WS_SSQ + (size_t)(DEPTH & 1) * 2 * MiB);
    const int stride = c.G * NWAVES;
    f32x4 g0[2], g1[2];
#pragma unroll
    for (int j = 0; j < 2; ++j) { const int col = (64 * j + lane) * 8; g0[j] = *(const f32x4*)(c.norm_final + col); g1[j] = *(const f32x4*)(c.norm_final + col + 4); }
    for (int tok0 = blockIdx.x * NWAVES + w; tok0 < T; tok0 += 4 * stride) {
        f32x4 pq[4]; u32x4 hv[4][2];
#pragma unroll
        for (int q = 0; q < 4; ++q) { const int tok = tok0 + q * stride; const int tt = (tok < T) ? tok : tok0; pq[q] = *(const f32x4*)(ssq + (size_t)tt * 4);
            const u32x4* hr = (const u32x4*)(hb + (size_t)tt * D) + lane; hv[q][0] = hr[0]; hv[q][1] = hr[64]; }
#pragma unroll
        for (int q = 0; q < 4; ++q) { const int tok = tok0 + q * stride; if (tok < T) {
            const float a = (pq[q][0] + pq[q][1]) + (pq[q][2] + pq[q][3]); const float rs = rsqrtf(a * (1.f / D) + EPS); f32x4* o = (f32x4*)(c.out + (size_t)tok * D);
#pragma unroll
            for (int j = 0; j < 2; ++j) { const u32x4 v = hv[q][j]; const int col = (64 * j + lane) * 8; f32x4 r0, r1;
                r0[0] = bf2f(v.x & 0xffffu) * rs * g0[j][0]; r0[1] = bf2f(v.x >> 16) * rs * g0[j][1]; r0[2] = bf2f(v.y & 0xffffu) * rs * g0[j][2]; r0[3] = bf2f(v.y >> 16) * rs * g0[j][3];
                r1[0] = bf2f(v.z & 0xffffu) * rs * g1[j][0]; r1[1] = bf2f(v.z >> 16) * rs * g1[j][1]; r1[2] = bf2f(v.w & 0xffffu) * rs * g1[j][2]; r1[3] = bf2f(v.w >> 16) * rs * g1[j][3];
                o[col / 4] = r0; o[col / 4 + 1] = r1; } } }
    }
}

template <int PH, int SUB = 0> DEV void run_phase(const Ctx& c, LAS unsigned char* lds) {
    unsigned char* ws = c.ws;
    if constexpr (PH == 0) { phase_prologue(c, lds); }
    else if constexpr (PH == 41) { phase_final(c); }
    else {
        constexpr int L = (PH - 1) / 10, S = (PH - 1) % 10, KIND = L % 3, J = L / 3;
        constexpr size_t HBC = WS_HB + (size_t)(L & 1) * 64 * MiB, HBN = WS_HB + (size_t)((L + 1) & 1) * 64 * MiB, SQC = WS_SSQ + (size_t)(L & 1) * 2 * MiB, SQN = WS_SSQ + (size_t)((L + 1) & 1) * 2 * MiB;
        if constexpr (S == 0) {
            Prob<0> p; p.headmajor = 1; p.A = (const bf16_t*)(ws + HBC); p.lda = D; p.K = D; p.out = (bf16_t*)(ws + WS_QKV + ((KIND == 0) ? (size_t)(SUB & 1) * 208 * MiB : 0)); p.ssq = (const float*)(ws + SQC);
            if (KIND == 0) { p.Bt = (const bf16_t*)(ws + WS_WAIN) + (size_t)J * NA * D + (size_t)SUB * NB * D; p.N = NB; }   else if (KIND == 1) { p.Bt = (const bf16_t*)(ws + WS_WBIN); p.N = NB; } else { p.Bt = (const bf16_t*)(ws + WS_WCIN); p.N = NB; }
            p.S.init(T, p.N, c.G, blockIdx.x);
            gemm_phase(p, lds);
        } else if constexpr (S == 1) {
            if constexpr (KIND == 0) { attA_fast(c, SUB, lds);
                if constexpr (SUB < 2) { __syncthreads(); run_phase<PH - 1, SUB + 1>(c, lds); } }
            else if constexpr (KIND == 1) {
                const float lambda_init = 0.8f - 0.6f * expf(-0.3f * (float)L);
                float s1 = 0.f, s2 = 0.f; for (int i = 0; i < 64; ++i) { s1 += c.lq1[J * 64 + i] * c.lk1[J * 64 + i]; s2 += c.lq2[J * 64 + i] * c.lk2[J * 64 + i]; }
                const float lam = expf(s1) - expf(s2) + lambda_init;
                attB_fast(c, lam, lambda_init, c.subln + J * 128, lds);
            } else { attC_fast(c, lds); }
        } else if constexpr (S == 2) {
        } else if constexpr (S == 3) {
            Prob<1> p; p.A = (const bf16_t*)(ws + WS_O); p.lda = D; p.K = D; p.N = D;
            p.Bt = (KIND == 0) ? (const bf16_t*)(ws + WS_WAOUT) + (size_t)J * D * D : (KIND == 1) ? (const bf16_t*)(ws + WS_WBOUT) : (const bf16_t*)(ws + WS_WCOUT);
            p.hin = (const bf16_t*)(ws + HBC); p.hb = (bf16_t*)(ws + HBC); p.ssq = (float*)(ws + SQC);
            if constexpr (SUB == 7) { p.hb = (bf16_t*)(ws + WS_OG + 128 * MiB); p.ssq = (float*)(ws + WS_LSE); }
            p.S.init(T, D, c.G, blockIdx.x);
            gemm_phase(p, lds);
        } else if constexpr (S == 4) {
            phase_router_fast<L, (SUB == 7) ? 1 : 0>(c, lds);
        } else if constexpr (S == 5) {
            LAS int* tpre = (LAS int*)(lds + TBL_TPRE); const int* cnt = (const int*)(ctl(c) + CW_CNT + L * 64 * CNT_S);
            moe_prefix(cnt, tpre);
            Prob<2> p; p.A = (const bf16_t*)(ws + HBC); p.lda = D; p.K = D; p.Bt = (const bf16_t*)(ws + WS_WGU) + (size_t)L * NE * 1024 * D; p.act = (bf16_t*)(ws + WS_ACT);
            p.list = (const int*)(ws + WS_LIST); p.list_rs = (const float*)(ws + WS_LRS); p.S.init(tpre, cnt, c.G, blockIdx.x, 4);
            gemm_phase(p, lds);
        } else if constexpr (S == 6) {
            LAS int* tpre = (LAS int*)(lds + TBL_TPRE); const int* cnt = (const int*)(ctl(c) + CW_CNT + L * 64 * CNT_S);
            moe_prefix(cnt, tpre);
            Prob<3> p; p.A = (const bf16_t*)(ws + WS_ACT); p.lda = FE; p.K = FE; p.Bt = (const bf16_t*)(ws + WS_WDN) + (size_t)L * NE * D * FE; p.y = (bf16_t*)(ws + WS_Y);
            p.list_gate = (const float*)(ws + WS_LGATE); p.S.init(tpre, cnt, c.G, blockIdx.x, 4);
            gemm_phase(p, lds);
        } else if constexpr (S == 7) {
            phase_combine<L, (SUB == 7) ? 1 : 0>(c, lds);
            __syncthreads();
            Prob<0> p; p.headmajor = 0; p.ssq = nullptr; p.A = (const bf16_t*)(ws + WS_PB) + (size_t)L * T * PLE; p.lda = PLE; p.K = PLE; p.N = D; p.Bt = (const bf16_t*)(ws + WS_WPP) + (size_t)L * D * PLE; p.out = (bf16_t*)(ws + WS_PROJ);
            p.S.init(T, D, c.G, blockIdx.x);
            gemm_phase(p, lds);
        } else if constexpr (S == 9) {
            if constexpr (KIND == 1) attB_kmax(c);
        } else if constexpr (S == 8) {
            Prob<5> p; p.A = (const bf16_t*)(ws + HBC); p.lda = D; p.K = D; p.N = D; p.Bt = (const bf16_t*)(ws + WS_WPG) + (size_t)L * D * D; p.proj = (const bf16_t*)(ws + WS_PROJ);
            p.hin = (const bf16_t*)(ws + HBC); p.hb = (bf16_t*)(ws + HBN); p.ssq_in = (const float*)(ws + SQC); p.ssq_out = (float*)(ws + SQN);
            if constexpr (SUB == 7) { p.hb = (bf16_t*)(ws + WS_OG + 128 * MiB); p.ssq_out = (float*)(ws + WS_LSE); }
            p.S.init(T, D, c.G, blockIdx.x);
            gemm_phase(p, lds);
        }
    }
}

#define XB_TMO      128
#define XB_XCNT(j)  (256  + 64 * (j))
#define XB_XSUB(j)  (1280 + 64 * (j))
#define XB_XGEN(j)  (2304 + 64 * (j))
#define XB_TOP      3328
#define XB_TOPGEN   3392
#define XCD_BAR_WORDS 3456
#define XB_SPIN_CAP (1u << 18)
__device__ __forceinline__ unsigned xb_ld(unsigned* p)              { return __hip_atomic_load(p, __ATOMIC_RELAXED, __HIP_MEMORY_SCOPE_AGENT); }
__device__ __forceinline__ unsigned xb_add(unsigned* p, unsigned v) { return __hip_atomic_fetch_add(p, v, __ATOMIC_RELAXED, __HIP_MEMORY_SCOPE_AGENT); }
__device__ __forceinline__ unsigned xb_xcc_id() { return (unsigned)__builtin_amdgcn_s_getreg((3 << 11) | 20) & 0xFu; }
#define XB_SPIN(cond, bar) do { unsigned _sp = 0; while (cond) { __builtin_amdgcn_s_sleep(1); \
    if ((++_sp & 255u) == 0u) { if (xb_ld(&(bar)[XB_TMO])) break; if (_sp > XB_SPIN_CAP) { atomicAdd(&(bar)[XB_TMO], 1u); break; } } } } while (0)
struct XcdBarrier {
    unsigned* bar; unsigned x;
    volatile LAS unsigned* st;
};
__device__ __forceinline__ XcdBarrier xcd_barrier_post(unsigned* bar, volatile LAS unsigned* st) {
    XcdBarrier b; b.bar = bar; b.x = xb_xcc_id(); b.st = st;
    if (threadIdx.x == 0) (void)xb_add(&bar[XB_XCNT(b.x)], 1u);
    return b;
}
__device__ __forceinline__ void xcd_barrier_complete(unsigned* bar, unsigned x, unsigned& nloc, unsigned& nx) {
    const unsigned G = gridDim.x * gridDim.y * gridDim.z;
    unsigned sum, cnt, mine, sp = 0u;
    for (;;) {
        sum = 0u; cnt = 0u; mine = 0u;
#pragma unroll
        for (unsigned j = 0; j < 16; ++j) { const unsigned c = xb_ld(&bar[XB_XCNT(j)]); sum += c; cnt += (c > 0u) ? 1u : 0u; mine = (j == x) ? c : mine; }
        if (sum == G) break;
        __builtin_amdgcn_s_sleep(1);
        if ((++sp & 255u) == 0u) { if (xb_ld(&bar[XB_TMO])) break; if (sp > XB_SPIN_CAP) { atomicAdd(&bar[XB_TMO], 1u); break; } }
    }
    nloc = mine > 0u ? mine : 1u; nx = cnt > 0u ? cnt : 1u;
}
__device__ __forceinline__ void xcd_barrier(const XcdBarrier& b) {
    asm volatile("s_waitcnt vmcnt(0)" ::: "memory");
    __syncthreads();
    if (threadIdx.x == 0) {
        unsigned* bar = b.bar;
        __builtin_amdgcn_s_waitcnt(0);
        unsigned nloc = b.st[0], nx = b.st[1];
        if (nloc == 0u) { xcd_barrier_complete(bar, b.x, nloc, nx); b.st[0] = nloc; b.st[1] = nx; }
        const unsigned old = xb_add(&bar[XB_XSUB(b.x)], 1u);
        const unsigned gen = old / nloc;
        if (old + 1u == (gen + 1u) * nloc) {
            __builtin_amdgcn_fence(__ATOMIC_RELEASE, "agent");
            asm volatile("s_waitcnt vmcnt(0)" ::: "memory");
            const unsigned og = xb_add(&bar[XB_TOP], 1u);
            const unsigned tg = og / nx;
            if (og + 1u == (tg + 1u) * nx) xb_add(&bar[XB_TOPGEN], 1u);
            else XB_SPIN(xb_ld(&bar[XB_TOPGEN]) == tg, bar);
            __builtin_amdgcn_fence(__ATOMIC_ACQUIRE, "agent");
            xb_add(&bar[XB_XGEN(b.x)], 1u);
            asm volatile("s_waitcnt vmcnt(0)" ::: "memory");
        } else {
            XB_SPIN(xb_ld(&bar[XB_XGEN(b.x)]) == gen, bar);
            __builtin_amdgcn_fence(__ATOMIC_ACQUIRE, "agent");
            asm volatile("s_waitcnt vmcnt(0)" ::: "memory");
        }
    }
    __syncthreads();
}

constexpr int CW_BAR = 4096;
constexpr int LDS_BARW = 143360;

typedef const __attribute__((address_space(4))) Ctx* KCtx;
template <int PH, int SUB = 0> DEV void run_phase_k(KCtx kc, LAS unsigned char* lds) {
#if defined(__HIP_DEVICE_COMPILE__)
    KCtx p = kc; asm volatile("" : "+s"(p));
    const Ctx c = *p;
    run_phase<PH, SUB>(c, lds);
#endif
}
#ifndef PA0
#define PA0 -1
#endif
#ifndef PA1
#define PA1 PA0
#endif
#ifndef PB0
#define PB0 -1
#endif
#ifndef PB1
#define PB1 PB0
#endif
#if PA0 >= 0 || PB0 >= 0
#define STAMP() do { if (blockIdx.x == 0 && threadIdx.x == 0) { ((unsigned long long*)(kc->ws + WS_STAMP))[nstamp] = __builtin_amdgcn_s_memrealtime(); } ++nstamp; } while (0)
#else
#define STAMP() do { } while (0)
#endif
#define BARS() do { xcd_barrier(bar); STAMP(); } while (0)
#ifndef PROBE_REP
#define PROBE_REP 0
#endif
template <int L> DEV void run_layer(KCtx kc, LAS unsigned char* lds, const XcdBarrier& bar, int& nstamp) {
    if constexpr (PROBE_REP == 5 && L == 1) { run_phase_k<1 + 10 * L + 0>(kc, lds); BARS(); }
    if constexpr (L % 3 == 0) {
        run_phase_k<1 + 10 * L + 0, 0>(kc, lds); BARS();
        run_phase_k<1 + 10 * L + 1, 0>(kc, lds); BARS();
        run_phase_k<1 + 10 * L + 1, 1>(kc, lds); BARS();
        run_phase_k<1 + 10 * L + 1, 2>(kc, lds); BARS();
    } else {
        run_phase_k<1 + 10 * L + 0>(kc, lds); BARS();
        if constexpr (L % 3 == 1) { run_phase_k<1 + 10 * L + 9>(kc, lds); BARS(); }
        run_phase_k<1 + 10 * L + 1>(kc, lds); BARS();
    }
    if constexpr (PROBE_REP == 6 && L == 2) { run_phase_k<1 + 10 * L + 1>(kc, lds); BARS(); }
    run_phase_k<1 + 10 * L + 3>(kc, lds); BARS();
    if constexpr (PROBE_REP == 1 && L == 0) { run_phase_k<1 + 10 * L + 3, 7>(kc, lds); BARS(); }
    if constexpr (PROBE_REP == 2 && L == 1) { run_phase_k<1 + 10 * L + 4, 7>(kc, lds); BARS(); }
    run_phase_k<1 + 10 * L + 4>(kc, lds); BARS();
    run_phase_k<1 + 10 * L + 5>(kc, lds); BARS();
    run_phase_k<1 + 10 * L + 6>(kc, lds); BARS();
    if constexpr (PROBE_REP == 3 && L == 1) { run_phase_k<1 + 10 * L + 7, 7>(kc, lds); BARS(); }
    run_phase_k<1 + 10 * L + 7>(kc, lds); BARS();
    if constexpr (PROBE_REP == 4 && L == 1) { run_phase_k<1 + 10 * L + 8, 7>(kc, lds); BARS(); }
    run_phase_k<1 + 10 * L + 8>(kc, lds); BARS();
}
__global__ void __launch_bounds__(NTHR, 2) mega_fwd(Ctx cin) {
    extern __shared__ __attribute__((aligned(16))) unsigned char lds_raw[];
    LAS unsigned char* lds = (LAS unsigned char*)lds_raw;
    KCtx kc = (KCtx)__builtin_amdgcn_kernarg_segment_ptr();
    if (threadIdx.x < 4) ((LAS unsigned*)(lds + LDS_BARW))[threadIdx.x] = 0u;
    __syncthreads();
    const XcdBarrier bar = xcd_barrier_post((unsigned*)(cin.ws + WS_CTL) + CW_BAR, (volatile LAS unsigned*)(lds + LDS_BARW));
    int nstamp = 0; (void)nstamp;
    STAMP();
    run_phase_k<0>(kc, lds); BARS();
    run_layer<0>(kc, lds, bar, nstamp); run_layer<1>(kc, lds, bar, nstamp); run_layer<2>(kc, lds, bar, nstamp); run_layer<3>(kc, lds, bar, nstamp);
    run_phase_k<41>(kc, lds);
#if PA0 >= 0 || PB0 >= 0
    BARS();
    if (blockIdx.x == 0) { const unsigned long long* st = (const unsigned long long*)(cin.ws + WS_STAMP);
        const float da = (PA0 >= 0) ? (float)(st[PA1] - st[PA0 - 1]) * 0.01f : 0.f, db = (PB0 >= 0) ? (float)(st[PB1] - st[PB0 - 1]) * 0.01f : 0.f;
        if (threadIdx.x == 0) cin.out[0] += da * 0.2f;
        for (int i = threadIdx.x; i < (1 << 20); i += NTHR) cin.out[1024 + i] += db * 0.005f; }
#endif
}
static void launch_all(const Ctx& c, hipStream_t stream) {
    static bool attr = false;
    if (!attr) { (void)hipFuncSetAttribute((const void*)mega_fwd, hipFuncAttributeMaxDynamicSharedMemorySize, LDS_BYTES);
        int per_cu = 0; if (hipOccupancyMaxActiveBlocksPerMultiprocessor(&per_cu, (const void*)mega_fwd, NTHR, LDS_BYTES) != hipSuccess || per_cu < 1) fprintf(stderr, "kernel_launch: occupancy query reports %d blocks per CU\n", per_cu);
        (void)hipGetLastError(); attr = true; }
    hipLaunchKernelGGL(mega_fwd, dim3(c.G), dim3(NTHR), LDS_BYTES, stream, c);
}


extern "C" void kernel_launch(void* const* d_in, const int* in_sizes, int n_in, void* d_out, int out_size, void* d_ws, size_t ws_size, hipStream_t stream) {
    if (n_in != 25 || ws_size < WS_END) { fprintf(stderr, "kernel_launch: unexpected n_in %d or ws_size %zu (< %zu)\n", n_in, ws_size, (size_t)WS_END); return; }
    static int grid = 0;
    if (!grid) { int dev = 0, cus = 0; (void)hipGetDevice(&dev); (void)hipDeviceGetAttribute(&cus, hipDeviceAttributeMultiprocessorCount, dev); grid = cus > 0 ? cus : 256; }
    Ctx c{};
    const float* const* in = (const float* const*)d_in;
    c.x = in[0]; c.p = in[1]; c.norm_mix = in[2]; c.norm_ffn = in[3]; c.norm_ple = in[4]; c.norm_final = in[5];
    c.a_w_in = in[6]; c.a_w_out = in[7]; c.b_w_in = in[8]; c.b_w_out = in[9]; c.lq1 = in[10]; c.lk1 = in[11]; c.lq2 = in[12]; c.lk2 = in[13]; c.subln = in[14];
    c.c_w_in = in[15]; c.c_w_out = in[16]; c.w_coarse = in[17]; c.b_coarse = in[18]; c.w_fine = in[19]; c.b_fine = in[20]; c.w_gu = in[21]; c.w_dn = in[22]; c.w_pp = in[23]; c.w_pg = in[24];
    c.out = (float*)d_out; c.ws = (unsigned char*)d_ws; c.G = grid; c.pad = 0;
    (void)hipMemsetAsync((char*)d_ws + WS_CTL, 0, CTL_BYTES, stream);
    launch_all(c, stream);
}
```

```cpp
#include <hip/hip_runtime.h>
#include <cstdint>
#include <cstdio>

#define DEV __device__ __forceinline__
#define LAS __attribute__((address_space(3)))
typedef unsigned short bf16_t;
typedef short bf16x8 __attribute__((ext_vector_type(8)));
typedef float f32x16 __attribute__((ext_vector_type(16)));
typedef float f32x4 __attribute__((ext_vector_type(4)));

constexpr int D = 1024, BATCH = 8, SEQ = 4096, T = BATCH * SEQ, DEPTH = 4;
constexpr int NE = 64, FE = 512, PLE = 256;
constexpr int NA = 9216, NB = 3072;
constexpr float EPS = 1e-6f;
constexpr float LOG2E = 1.4426950408889634f, LN2 = 0.6931471805599453f;
constexpr float QSCALE = 0.125f * LOG2E;
constexpr int PMAX = 2 * T + NE * 256;
constexpr int NWAVES = 8, NTHR = 512;

constexpr size_t MiB = 1ull << 20;
constexpr size_t WS_CTL = 0;
constexpr size_t WS_WAIN = 1 * MiB;
constexpr size_t WS_WBIN = WS_WAIN + 36 * MiB;
constexpr size_t WS_WCIN = WS_WBIN + 6 * MiB;
constexpr size_t WS_WAOUT = WS_WCIN + 6 * MiB;
constexpr size_t WS_WBOUT = WS_WAOUT + 4 * MiB;
constexpr size_t WS_WCOUT = WS_WBOUT + 2 * MiB;
constexpr size_t WS_WGU = WS_WCOUT + 2 * MiB;
constexpr size_t WS_WDN = WS_WGU + 512 * MiB;
constexpr size_t WS_WPG = WS_WDN + 256 * MiB;
constexpr size_t WS_WPP = WS_WPG + 8 * MiB;
constexpr size_t WS_PB = WS_WPP + 2 * MiB;
constexpr size_t WS_H = WS_PB + 64 * MiB;
constexpr size_t WS_HB = WS_H + 128 * MiB;
constexpr size_t WS_SSQ = WS_HB + 128 * MiB;
constexpr size_t WS_QKV = WS_SSQ + 4 * MiB;
constexpr size_t WS_OG = WS_QKV + 576 * MiB;
constexpr size_t WS_LSE = WS_OG + 192 * MiB;
constexpr size_t WS_O = WS_LSE + 6 * MiB;
constexpr size_t WS_TOK = WS_O + 64 * MiB;
constexpr size_t WS_LIST = WS_TOK + 2 * MiB;
constexpr size_t WS_LRS = WS_LIST + 8 * MiB;
constexpr size_t WS_LGATE = WS_LRS + 8 * MiB;
constexpr size_t WS_ACT = WS_LGATE + 8 * MiB;
constexpr size_t WS_Y = WS_ACT + 80 * MiB;
constexpr size_t WS_PROJ = WS_Y + 160 * MiB;
constexpr size_t WS_WR = WS_PROJ + 64 * MiB;
constexpr size_t WS_WRH = WS_WR + 2 * MiB;
constexpr size_t WS_KMAX = WS_WRH + 2 * MiB;
constexpr size_t WS_STAMP = WS_KMAX + 1 * MiB;
constexpr size_t WS_ONES = WS_STAMP + 512 * 1024;
constexpr size_t WS_END = WS_STAMP + 1 * MiB;
constexpr int CW_CNT = 16384;
constexpr int CNT_S = 32;
constexpr size_t CTL_BYTES = 1 * MiB;

constexpr int LDS_BYTES = 147456;

DEV unsigned f2bf(float f) { unsigned u = __float_as_uint(f); return (u + 0x7fffu + ((u >> 16) & 1u)) >> 16; }
DEV float bf2f(unsigned b) { return __uint_as_float(b << 16); }
DEV unsigned pk2(float lo, float hi) { return f2bf(lo) | (f2bf(hi) << 16); }
DEV float wave_sum(float v) {
#pragma unroll
    for (int o = 1; o < 64; o <<= 1) v += __shfl_xor(v, o);
    return v;
}
DEV float wave_max(float v) {
#pragma unroll
    for (int o = 1; o < 64; o <<= 1) v = fmaxf(v, __shfl_xor(v, o));
    return v;
}
DEV void wave_lds_fence() { asm volatile("s_waitcnt lgkmcnt(0)" ::: "memory"); __builtin_amdgcn_wave_barrier(); }
DEV int opaque_tid() { int t = threadIdx.x; asm volatile("" : "+v"(t)); return t; }
DEV size_t hm(int plane, int token) { return ((size_t)plane * T + (size_t)token) * 64; }
DEV int crow(int i, int hh) { return (i & 3) + 8 * (i >> 2) + 4 * hh; }

struct Ctx {
    const float *x, *p, *norm_mix, *norm_ffn, *norm_ple, *norm_final;
    const float *a_w_in, *a_w_out, *b_w_in, *b_w_out, *lq1, *lk1, *lq2, *lk2, *subln, *c_w_in, *c_w_out;
    const float *w_coarse, *b_coarse, *w_fine, *b_fine, *w_gu, *w_dn, *w_pp, *w_pg;
    float* out;
    unsigned char* ws;
    int G;
    int pad;
};
DEV unsigned* ctl(const Ctx& c) { return (unsigned*)(c.ws + WS_CTL); }

struct Unit { int pm, pn, e, rows, lbase, orow; };

struct StaticOrder {
    int nM, nN, nwg, G, c;
    DEV void init(int M, int N, int G_, int c_) { nM = M / 256; nN = N / 256; nwg = nM * nN; G = G_; c = c_; }
    DEV bool next(int i, Unit& u) const {
        const long L = (long)i * G + c; if (L >= nwg) return false;
        int wgid = (int)L; { const int q = nwg / 8, r = nwg % 8, xcd = wgid % 8, off = wgid / 8; wgid = (xcd < r ? xcd * (q + 1) : r * (q + 1) + (xcd - r) * q) + off; }
        const int nig = 8 * nN, gid = wgid / nig, fm = gid * 8, gsz = (nM - fm) < 8 ? (nM - fm) : 8;
        u.pm = fm + ((wgid % nig) % gsz); u.pn = (wgid % nig) / gsz; u.e = 0; u.rows = 256; u.lbase = 0; u.orow = u.pm * 256; return true;
    }
};
struct MoeOrder {
    int tlo, thi, cn, ntile; int G, c, npn;
    DEV void init(const LAS int* tpre, const int* cnt, int G_, int c_, int npn_) { const int lane = threadIdx.x & 63; tlo = tpre[lane]; thi = tpre[lane + 1]; cn = cnt[lane * CNT_S]; ntile = tpre[64]; G = G_; c = c_; npn = npn_; }
    DEV bool next(int i, Unit& u) const {
        const int nwg = ntile * npn; const long L = (long)i * G + c; if (L >= nwg) return false;
        int id = (int)L; { const int q = nwg / 8, r = nwg % 8, xcd = id % 8, off = id / 8; id = (xcd < r ? xcd * (q + 1) : r * (q + 1) + (xcd - r) * q) + off; }
        const int ti = id / npn; u.pn = id % npn;
        const unsigned long long bal = __ballot(tlo <= ti && ti < thi);
        const int e = (int)__builtin_ctzll(bal | (1ull << 63));
        u.e = e; const int ch = ti - __builtin_amdgcn_readlane(tlo, e); const int n = __builtin_amdgcn_readlane(cn, e);
        u.rows = (n - ch * 256) < 256 ? (n - ch * 256) : 256; u.lbase = e * T + ch * 256; u.pm = ti; u.orow = ti * 256; return true;
    }
};
DEV void moe_prefix(const int* cnt, LAS int* tpre) {
    if (threadIdx.x == 0) { int s = 0; for (int e = 0; e < 64; ++e) { tpre[e] = s; s += (cnt[e * CNT_S] + 255) >> 8; } tpre[64] = s; }
    __syncthreads();
}

constexpr int TBL_OFF = 131072;
constexpr int TBL_RED = TBL_OFF + 8192;
constexpr int TBL_TPRE = TBL_OFF + 12288 + 256;
constexpr int TBL_WARM = TBL_OFF + 13312;
typedef unsigned u32x4 __attribute__((ext_vector_type(4)));
typedef unsigned u32x2 __attribute__((ext_vector_type(2)));
DEV unsigned cvt_pk_bf16(float lo, float hi) { unsigned r; asm volatile("v_cvt_pk_bf16_f32 %0, %1, %2" : "=v"(r) : "v"(lo), "v"(hi)); return r; }
DEV float sigmoidf_(float x) { return __builtin_amdgcn_rcpf(1.f + __builtin_amdgcn_exp2f(x * -LOG2E)); }
typedef f32x4 AccT[2][2][4][2];
DEV int xs_mfma(int fr, int fq, int bj) { return (fr >> 3) * 8192 + (fr & 7) * 128 + (((4 * bj + fq) ^ (fr & 7)) << 4); }
DEV int xs_line(int lane, int j) { return j * 8192 + (lane >> 3) * 128 + (((lane & 7) ^ (lane >> 3)) << 4); }

template <int KIND> struct Prob;

DEV void ssq_tbl_dma(const float* ssq, int orow, LAS unsigned char* slot, int wid, int lane) {
    if (wid < 4) __builtin_amdgcn_global_load_lds((const unsigned*)(ssq + (size_t)(orow + 64 * wid + lane) * 4), (LAS unsigned*)(slot + 1024 * wid), 16, 0, 0);
}
DEV float rs_of(const LAS unsigned char* slot, int rt) { const f32x4 p = *(const LAS f32x4*)(slot + rt * 16); return rsqrtf(((p[0] + p[1]) + (p[2] + p[3])) * (1.0f / D) + EPS); }
DEV void ssq_reduce_store(float* ssq, const Unit& u, LAS unsigned char* red, int tid) {
    asm volatile("s_waitcnt lgkmcnt(0)" ::: "memory"); __builtin_amdgcn_s_barrier(); asm volatile("" ::: "memory");
    if (tid < 256) { const f32x4 p = *(const LAS f32x4*)(red + tid * 16); ssq[(size_t)(u.orow + tid) * 4 + u.pn] = (p[0] + p[1]) + (p[2] + p[3]); }
}

template <> struct Prob<0> {
    static constexpr bool HAS_TBL = true, WIDE = true;
    const bf16_t* A; int lda; const bf16_t* Bt; int N, K; bf16_t* out; const float* ssq; int headmajor; StaticOrder S;
    DEV bool next(int i, Unit& u) const { return S.next(i, u); }
    DEV void warm(const Unit&, LAS unsigned char*, int, int) const {}
    DEV void tbl_dma(const Unit& u, LAS unsigned char* slot, int wid, int lane) const { if (ssq) ssq_tbl_dma(ssq, u.orow, slot, wid, lane); }
    DEV unsigned arow(const Unit& u, int r, const LAS unsigned char*) const { return (unsigned)(u.orow + r); }
    DEV const bf16_t* b_base(const Unit& u) const { return Bt + (size_t)u.pn * 256 * K; }
    DEV void epi_fast(const AccT& acc, const Unit& u, int wr, int wc, int fr, int fq, const LAS unsigned char* slot, LAS unsigned char*, int, LAS unsigned char* xs) const {
        asm volatile("" : "+v"(fr), "+v"(fq));
        const int lane = fr + 16 * fq;
#pragma unroll
        for (int ai = 0; ai < 2; ++ai)
#pragma unroll
            for (int m = 0; m < 4; ++m) { const int rb = 128 * ai + 64 * wr + 16 * m; const float rs = ssq ? rs_of(slot, rb + fr) : 1.f;
#pragma unroll
                for (int bj = 0; bj < 2; ++bj) { const f32x4 v0 = acc[ai][bj][m][0] * rs, v1 = acc[ai][bj][m][1] * rs; u32x4 w;
                    w.x = cvt_pk_bf16(v0[0], v0[1]); w.y = cvt_pk_bf16(v0[2], v0[3]); w.z = cvt_pk_bf16(v1[0], v1[1]); w.w = cvt_pk_bf16(v1[2], v1[3]);
                    *(LAS u32x4*)(xs + xs_mfma(fr, fq, bj)) = w; }
                __builtin_amdgcn_wave_barrier();
#pragma unroll
                for (int j = 0; j < 2; ++j) { const u32x4 w = *(const LAS u32x4*)(xs + xs_line(lane, j)); const int row = u.orow + rb + 8 * j + (lane >> 3);
                    bf16_t* dst = headmajor ? out + hm(u.pn * 4 + wc, row) + 8 * (lane & 7) : out + (size_t)row * N + u.pn * 256 + 64 * wc + 8 * (lane & 7);
                    *(u32x4*)dst = w; }
                __builtin_amdgcn_wave_barrier(); }
    }
};
template <> struct Prob<1> {
    static constexpr bool HAS_TBL = false, WIDE = false;
    const bf16_t* A; int lda; const bf16_t* Bt; int N, K; const bf16_t* hin; bf16_t* hb; float* ssq; StaticOrder S;
    DEV bool next(int i, Unit& u) const { return S.next(i, u); }
    DEV void warm(const Unit& u, LAS unsigned char* dz, int wid, int lane) const {
        asm volatile("" : "+v"(lane));
#pragma unroll
        for (int j = 0; j < 2; ++j) { const char* ub = (const char*)(hin + (size_t)(u.orow + (wid * 2 + j) * 16) * D + u.pn * 256);
            __builtin_amdgcn_global_load_lds((const unsigned*)(ub + (unsigned)(((lane >> 2) * D + (lane & 3) * 64) * 2)), (LAS unsigned*)(dz + wid * 256), 4, 0, 0); } }
    DEV void tbl_dma(const Unit&, LAS unsigned char*, int, int) const {}
    DEV unsigned arow(const Unit& u, int r, const LAS unsigned char*) const { return (unsigned)(u.orow + r); }
    DEV const bf16_t* b_base(const Unit& u) const { return Bt + (size_t)u.pn * 256 * K; }
    DEV void epi_fast(const AccT& acc, const Unit& u, int wr, int wc, int fr, int fq, const LAS unsigned char*, LAS unsigned char* red, int tid, LAS unsigned char*) const {
        asm volatile("" : "+v"(fr), "+v"(fq));
        u32x4 hva[2][4][2];
        { const bf16_t* hp = hin + (size_t)(u.orow + 64 * wr + fr) * D + u.pn * 256 + 32 * wc + 8 * fq;
#pragma unroll
        for (int ai = 0; ai < 2; ++ai)
#pragma unroll
            for (int m = 0; m < 4; ++m)
#pragma unroll
                for (int bj = 0; bj < 2; ++bj) hva[ai][m][bj] = *(const u32x4*)(hp + (size_t)(128 * ai + 16 * m) * D + 128 * bj); }
#pragma unroll
        for (int ai = 0; ai < 2; ++ai)
#pragma unroll
            for (int m = 0; m < 4; ++m) { const int rt = 128 * ai + 64 * wr + 16 * m + fr; const size_t o = (size_t)(u.orow + rt) * D + u.pn * 256 + 32 * wc + 8 * fq; float q = 0.f;
#pragma unroll
                for (int bj = 0; bj < 2; ++bj) { const u32x4 hv = hva[ai][m][bj]; f32x4 v0, v1;
                    v0[0] = bf2f(hv.x & 0xffffu) + acc[ai][bj][m][0][0]; v0[1] = bf2f(hv.x >> 16) + acc[ai][bj][m][0][1]; v0[2] = bf2f(hv.y & 0xffffu) + acc[ai][bj][m][0][2]; v0[3] = bf2f(hv.y >> 16) + acc[ai][bj][m][0][3];
                    v1[0] = bf2f(hv.z & 0xffffu) + acc[ai][bj][m][1][0]; v1[1] = bf2f(hv.z >> 16) + acc[ai][bj][m][1][1]; v1[2] = bf2f(hv.w & 0xffffu) + acc[ai][bj][m][1][2]; v1[3] = bf2f(hv.w >> 16) + acc[ai][bj][m][1][3];
                    u32x4 w; w.x = cvt_pk_bf16(v0[0], v0[1]); w.y = cvt_pk_bf16(v0[2], v0[3]); w.z = cvt_pk_bf16(v1[0], v1[1]); w.w = cvt_pk_bf16(v1[2], v1[3]);
                    *(u32x4*)(hb + o + 128 * bj) = w;
                    q += (v0[0] * v0[0] + v0[1] * v0[1]) + (v0[2] * v0[2] + v0[3] * v0[3]) + (v1[0] * v1[0] + v1[1] * v1[1]) + (v1[2] * v1[2] + v1[3] * v1[3]); }
                q += __shfl_xor(q, 16); q += __shfl_xor(q, 32);
                if (fq == 0) ((LAS float*)red)[rt * 4 + wc] = q; }
        ssq_reduce_store(ssq, u, red, tid);
    }
};
template <> struct Prob<2> {
    static constexpr bool HAS_TBL = true, WIDE = false;
    const bf16_t* A; int lda; const bf16_t* Bt; int K; bf16_t* act; const int* list; const float* list_rs; MoeOrder S;
    DEV bool next(int i, Unit& u) const { return S.next(i, u); }
    DEV void warm(const Unit&, LAS unsigned char*, int, int) const {}
    DEV void tbl_dma(const Unit& u, LAS unsigned char* slot, int wid, int lane) const {
        const unsigned* src = (wid < 4) ? (const unsigned*)list + u.lbase + 64 * wid + lane : (const unsigned*)list_rs + u.lbase + 64 * (wid - 4) + lane;
        __builtin_amdgcn_global_load_lds(src, (LAS unsigned*)(slot + 256 * wid), 4, 0, 0); }
    DEV unsigned arow(const Unit& u, int r, const LAS unsigned char* slot) const { const unsigned e = ((const LAS unsigned*)slot)[r]; return (r < u.rows) ? (e >> 1) : 0u; }
    DEV const bf16_t* b_base(const Unit& u) const { return Bt + ((size_t)u.e * 1024 + u.pn * 256) * K; }
    DEV void epi_fast(const AccT& acc, const Unit& u, int wr, int wc, int fr, int fq, const LAS unsigned char* slot, LAS unsigned char*, int, LAS unsigned char*) const {
        asm volatile("" : "+v"(fr), "+v"(fq));
        const LAS float* tf = (const LAS float*)(slot + 1024);
#pragma unroll
        for (int ai = 0; ai < 2; ++ai)
#pragma unroll
            for (int m = 0; m < 4; ++m) { const int rt = 128 * ai + 64 * wr + 16 * m + fr; const float rs = tf[rt];
                float o[8];
#pragma unroll
                for (int n = 0; n < 2; ++n)
#pragma unroll
                    for (int j = 0; j < 4; ++j) { const float g = acc[ai][0][m][n][j] * rs, up = acc[ai][1][m][n][j] * rs; o[4 * n + j] = g * sigmoidf_(g) * up; }
                u32x4 w; w.x = cvt_pk_bf16(o[0], o[1]); w.y = cvt_pk_bf16(o[2], o[3]); w.z = cvt_pk_bf16(o[4], o[5]); w.w = cvt_pk_bf16(o[6], o[7]);
                if (rt < u.rows) *(u32x4*)(act + (size_t)(u.orow + rt) * FE + u.pn * 128 + 32 * wc + 8 * fq) = w; }
    }
};
template <> struct Prob<3> {
    static constexpr bool HAS_TBL = true, WIDE = true;
    const bf16_t* A; int lda; const bf16_t* Bt; int K; bf16_t* y; const float* list_gate; MoeOrder S;
    DEV bool next(int i, Unit& u) const { return S.next(i, u); }
    DEV void warm(const Unit&, LAS unsigned char*, int, int) const {}
    DEV void tbl_dma(const Unit& u, LAS unsigned char* slot, int wid, int lane) const {
        if (wid < 4) __builtin_amdgcn_global_load_lds((const unsigned*)list_gate + u.lbase + 64 * wid + lane, (LAS unsigned*)(slot + 1024 + 256 * wid), 4, 0, 0); }
    DEV unsigned arow(const Unit& u, int r, const LAS unsigned char*) const { return (unsigned)(u.orow + r); }
    DEV const bf16_t* b_base(const Unit& u) const { return Bt + ((size_t)u.e * 1024 + u.pn * 256) * K; }
    DEV void epi_fast(const AccT& acc, const Unit& u, int wr, int wc, int fr, int fq, const LAS unsigned char* slot, LAS unsigned char*, int, LAS unsigned char* xs) const {
        asm volatile("" : "+v"(fr), "+v"(fq));
        const LAS float* tf = (const LAS float*)(slot + 1024);
        const int lane = fr + 16 * fq;
#pragma unroll
        for (int ai = 0; ai < 2; ++ai)
#pragma unroll
            for (int m = 0; m < 4; ++m) { const int rb = 128 * ai + 64 * wr + 16 * m; const float gs = tf[rb + fr];
#pragma unroll
                for (int bj = 0; bj < 2; ++bj) { const f32x4 v0 = acc[ai][bj][m][0] * gs, v1 = acc[ai][bj][m][1] * gs; u32x4 w;
                    w.x = cvt_pk_bf16(v0[0], v0[1]); w.y = cvt_pk_bf16(v0[2], v0[3]); w.z = cvt_pk_bf16(v1[0], v1[1]); w.w = cvt_pk_bf16(v1[2], v1[3]);
                    *(LAS u32x4*)(xs + xs_mfma(fr, fq, bj)) = w; }
                __builtin_amdgcn_wave_barrier();
#pragma unroll
                for (int j = 0; j < 2; ++j) { const u32x4 w = *(const LAS u32x4*)(xs + xs_line(lane, j)); const int rt = rb + 8 * j + (lane >> 3);
                    if (rt < u.rows) *(u32x4*)(y + (size_t)(u.orow + rt) * D + u.pn * 256 + 64 * wc + 8 * (lane & 7)) = w; }
                __builtin_amdgcn_wave_barrier(); }
    }
};
template <> struct Prob<5> {
    static constexpr bool HAS_TBL = true, WIDE = false;
    const bf16_t* A; int lda; const bf16_t* Bt; int N, K; const bf16_t* proj; const bf16_t* hin; bf16_t* hb; const float* ssq_in; float* ssq_out; StaticOrder S;
    DEV bool next(int i, Unit& u) const { return S.next(i, u); }
    DEV void warm(const Unit& u, LAS unsigned char* dz, int wid, int lane) const {
        asm volatile("" : "+v"(lane));
#pragma unroll
        for (int j = 0; j < 2; ++j) { const char* ub = (const char*)(proj + (size_t)(u.orow + (wid * 2 + j) * 16) * D + u.pn * 256);
            __builtin_amdgcn_global_load_lds((const unsigned*)(ub + (unsigned)(((lane >> 2) * D + (lane & 3) * 64) * 2)), (LAS unsigned*)(dz + wid * 256), 4, 0, 0); } }
    DEV void tbl_dma(const Unit& u, LAS unsigned char* slot, int wid, int lane) const { ssq_tbl_dma(ssq_in, u.orow, slot, wid, lane); }
    DEV unsigned arow(const Unit& u, int r, const LAS unsigned char*) const { return (unsigned)(u.orow + r); }
    DEV const bf16_t* b_base(const Unit& u) const { return Bt + (size_t)u.pn * 256 * K; }
    DEV void epi_fast(const AccT& acc, const Unit& u, int wr, int wc, int fr, int fq, const LAS unsigned char* slot, LAS unsigned char* red, int tid, LAS unsigned char*) const {
        asm volatile("" : "+v"(fr), "+v"(fq));
#pragma unroll
        for (int ai = 0; ai < 2; ++ai) {
            u32x4 hva[4][2], pja[4][2];
            { const size_t o0 = (size_t)(u.orow + 128 * ai + 64 * wr + fr) * D + u.pn * 256 + 32 * wc + 8 * fq;
#pragma unroll
            for (int m = 0; m < 4; ++m)
#pragma unroll
                for (int bj = 0; bj < 2; ++bj) { hva[m][bj] = *(const u32x4*)(hin + o0 + (size_t)(16 * m) * D + 128 * bj); pja[m][bj] = *(const u32x4*)(proj + o0 + (size_t)(16 * m) * D + 128 * bj); } }
#pragma unroll
            for (int m = 0; m < 4; ++m) { const int rt = 128 * ai + 64 * wr + 16 * m + fr; const float rs = rs_of(slot, rt); const size_t o = (size_t)(u.orow + rt) * D + u.pn * 256 + 32 * wc + 8 * fq; float q = 0.f;
#pragma unroll
                for (int bj = 0; bj < 2; ++bj) { const u32x4 hv = hva[m][bj]; const u32x4 pj = pja[m][bj];
                    const f32x4 a0 = acc[ai][bj][m][0] * rs, a1 = acc[ai][bj][m][1] * rs; f32x4 v0, v1;
                    v0[0] = bf2f(hv.x & 0xffffu) + bf2f(pj.x & 0xffffu) * sigmoidf_(a0[0]); v0[1] = bf2f(hv.x >> 16) + bf2f(pj.x >> 16) * sigmoidf_(a0[1]); v0[2] = bf2f(hv.y & 0xffffu) + bf2f(pj.y & 0xffffu) * sigmoidf_(a0[2]); v0[3] = bf2f(hv.y >> 16) + bf2f(pj.y >> 16) * sigmoidf_(a0[3]);
                    v1[0] = bf2f(hv.z & 0xffffu) + bf2f(pj.z & 0xffffu) * sigmoidf_(a1[0]); v1[1] = bf2f(hv.z >> 16) + bf2f(pj.z >> 16) * sigmoidf_(a1[1]); v1[2] = bf2f(hv.w & 0xffffu) + bf2f(pj.w & 0xffffu) * sigmoidf_(a1[2]); v1[3] = bf2f(hv.w >> 16) + bf2f(pj.w >> 16) * sigmoidf_(a1[3]);
                    u32x4 w; w.x = cvt_pk_bf16(v0[0], v0[1]); w.y = cvt_pk_bf16(v0[2], v0[3]); w.z = cvt_pk_bf16(v1[0], v1[1]); w.w = cvt_pk_bf16(v1[2], v1[3]);
                    *(u32x4*)(hb + o + 128 * bj) = w;
                    q += (v0[0] * v0[0] + v0[1] * v0[1]) + (v0[2] * v0[2] + v0[3] * v0[3]) + (v1[0] * v1[0] + v1[1] * v1[1]) + (v1[2] * v1[2] + v1[3] * v1[3]); }
                q += __shfl_xor(q, 16); q += __shfl_xor(q, 32);
                if (fq == 0) ((LAS float*)red)[rt * 4 + wc] = q; }
        }
        ssq_reduce_store(ssq_out, u, red, tid);
    }
};

namespace fg {
constexpr int BK = 64, HALF = 128, HTB = HALF * BK * 2;
DEV int lds_byte(int r, int c) { const int st = (r >> 4) * 2 + (c >> 5), rr = r & 15, cc = c & 31, ob = rr * 64 + cc * 2; return st * 1024 + (ob ^ (((ob >> 9) & 1) << 5)); }
DEV void stage_rc(int b, int& R, int& C) { const int st = b / 1024, sb = b % 1024, swz = sb ^ (((sb >> 9) & 1) << 5); R = (st >> 1) * 16 + swz / 64; C = (st & 1) * 32 + (swz % 64) / 2; }
DEV int perm32(int rho) { const int n = rho >> 4, i = rho & 15; return 8 * (i >> 2) + 4 * n + (i & 3); }
}
template <class P> DEV void gemm_phase_fast(const P& p, LAS unsigned char* lds) {
    using namespace fg;
    const int tid = opaque_tid(), wid = __builtin_amdgcn_readfirstlane(tid >> 6), lane = tid & 63, wr = wid >> 2, wc = wid & 3, fr = lane & 15, fq = lane >> 4;
    const int K = p.K, nt = K / BK, lda = p.lda;
    unsigned voffB[2];
#pragma unroll
    for (int i = 0; i < 2; ++i) { int R, C; stage_rc(tid * 16 + i * 8192, R, C); const int Rb = (P::WIDE ? ((R >> 5) << 6) : (R & ~31)) + perm32(R & 31); voffB[i] = (unsigned)(Rb * K + C) * 2u; }
    const size_t kstep = (size_t)(BK * 2);
    const size_t hstepB = (size_t)(P::WIDE ? 32 : HALF) * K * 2;
    const unsigned ldsw = (unsigned)wid * 1024u;
    const int aoffl = lds_byte(wr * 64 + fr, fq * 8), boffl = lds_byte(wc * 32 + fr, fq * 8);
#define PG8_SA(b, h) (((b) * 2 + (h)) * HTB)
#define PG8_SB(b, h) ((4 + (b) * 2 + (h)) * HTB)
#define PG8_STAGE(bufoff, gbase, voff) do { _Pragma("unroll") for (int _i = 0; _i < 2; ++_i) \
        __builtin_amdgcn_global_load_lds((const unsigned*)((const char*)(gbase) + (voff)[_i]), (LAS unsigned*)(lds + (bufoff) + ldsw + _i * 8192), 16, 0, 0); } while (0)
#define PG8_LDA(dst, b, h) do { _Pragma("unroll") for (int m = 0; m < 4; ++m) _Pragma("unroll") for (int k = 0; k < 2; ++k) dst[m][k] = *(const LAS bf16x8*)(lds + PG8_SA(b, h) + aoffl + m * 2048 + k * 1024); } while (0)
#define PG8_LDB(dst, b, h) do { _Pragma("unroll") for (int n = 0; n < 2; ++n) _Pragma("unroll") for (int k = 0; k < 2; ++k) dst[n][k] = *(const LAS bf16x8*)(lds + PG8_SB(b, h) + boffl + n * 2048 + k * 1024); } while (0)
#define PG8_MMA(ai, bj, At, Bt) do { __builtin_amdgcn_s_setprio(1); _Pragma("unroll") for (int m = 0; m < 4; ++m) _Pragma("unroll") for (int n = 0; n < 2; ++n) _Pragma("unroll") for (int k = 0; k < 2; ++k) \
        acc[ai][bj][m][n] = __builtin_amdgcn_mfma_f32_16x16x32_bf16(Bt[n][k], At[m][k], acc[ai][bj][m][n], 0, 0, 0); __builtin_amdgcn_s_setprio(0); } while (0)
#define PG8_WAIT_V(n) asm volatile("s_waitcnt vmcnt(" #n ")" ::: "memory")
#define PG8_WAIT_L(n) asm volatile("s_waitcnt lgkmcnt(" #n ")" ::: "memory")
#define PG8_BAR __builtin_amdgcn_s_barrier()
#define PG8_SCHED __builtin_amdgcn_sched_barrier(0)
#define PG8_AOFF(dst, un, slotp) do { _Pragma("unroll") for (int _i = 0; _i < 2; ++_i) { int _R, _C; stage_rc(tid * 16 + _i * 8192, _R, _C); _Pragma("unroll") for (int _h = 0; _h < 2; ++_h) \
        dst[_h][_i] = (p.arow(un, 128 * _h + _R, slotp) * (unsigned)lda + (unsigned)_C) * 2u; } } while (0)
    Unit cur, nxt; int ui = 0;
    if (!p.next(0, cur)) return;
    LAS unsigned char* const tbl = lds + TBL_OFF;
    if constexpr (P::HAS_TBL) { p.tbl_dma(cur, tbl, wid, lane); asm volatile("s_waitcnt vmcnt(0)" ::: "memory"); }
    __syncthreads();
    AccT acc;
#pragma unroll
    for (int a = 0; a < 2; ++a)
#pragma unroll
        for (int b = 0; b < 2; ++b)
#pragma unroll
            for (int m = 0; m < 4; ++m)
#pragma unroll
                for (int n = 0; n < 2; ++n) acc[a][b][m][n] = (f32x4){0.f, 0.f, 0.f, 0.f};
    bf16x8 At[4][2], B0[2][2], B1[2][2];
    unsigned ao[2][2];
    PG8_AOFF(ao, cur, tbl);
    const char* const Ab = (const char*)p.A;
    const char* cB = (const char*)p.b_base(cur);
    PG8_STAGE(PG8_SB(0, 0), cB, voffB); PG8_STAGE(PG8_SB(0, 1), cB + hstepB, voffB); PG8_STAGE(PG8_SA(0, 0), Ab, ao[0]); PG8_STAGE(PG8_SA(0, 1), Ab, ao[1]);
    if (wr == 1) PG8_BAR;
    PG8_WAIT_V(2); PG8_BAR;
    PG8_STAGE(PG8_SB(1, 0), cB + kstep, voffB); PG8_STAGE(PG8_SA(1, 0), Ab + kstep, ao[0]); PG8_STAGE(PG8_SB(1, 1), cB + hstepB + kstep, voffB);
    PG8_WAIT_V(6); PG8_BAR;
    for (;;) {
        const bool has_next = p.next(ui + 1, nxt);
        const char* nB = has_next ? (const char*)p.b_base(nxt) : cB;
        LAS unsigned char* const nslot = tbl + ((ui + 1) & 1) * 4096;
        for (int t = 0; t < nt; t += 2) {
            const bool last = (t == nt - 2);
            if ((t == 2) && !last) { if constexpr (P::HAS_TBL) { if (has_next) p.tbl_dma(nxt, nslot, wid, lane); }
                p.warm(cur, lds + TBL_WARM, wid, lane); }
            const char* a1 = Ab + (size_t)(t + 1) * kstep;
            const char* a2 = last ? Ab : Ab + (size_t)(t + 2) * kstep; const char* b2 = last ? nB : cB + (size_t)(t + 2) * kstep;
            const char* a3 = a2 + kstep; const char* b3 = b2 + kstep;
            PG8_LDB(B0, 0, 0); PG8_LDB(B1, 0, 1); PG8_SCHED; PG8_LDA(At, 0, 0); PG8_STAGE(PG8_SA(1, 1), a1, ao[1]);
            if (last && has_next) { PG8_AOFF(ao, nxt, nslot); }
            PG8_WAIT_V(8); PG8_WAIT_L(0); PG8_BAR; PG8_MMA(0, 0, At, B0); PG8_MMA(0, 1, At, B1); PG8_BAR; PG8_SCHED;
            PG8_LDA(At, 0, 1); PG8_STAGE(PG8_SB(0, 0), b2, voffB); PG8_STAGE(PG8_SB(0, 1), b2 + hstepB, voffB); PG8_STAGE(PG8_SA(0, 0), a2, ao[0]);
            PG8_WAIT_V(8); PG8_WAIT_L(0); PG8_BAR; PG8_MMA(1, 0, At, B0); PG8_MMA(1, 1, At, B1); PG8_BAR; PG8_SCHED;
            PG8_LDB(B0, 1, 0); PG8_LDB(B1, 1, 1); PG8_SCHED; PG8_LDA(At, 1, 0); PG8_STAGE(PG8_SA(0, 1), a2, ao[1]);
            PG8_WAIT_V(8); PG8_WAIT_L(0); PG8_BAR; PG8_MMA(0, 0, At, B0); PG8_MMA(0, 1, At, B1); PG8_BAR; PG8_SCHED;
            PG8_LDA(At, 1, 1); PG8_STAGE(PG8_SB(1, 0), b3, voffB); PG8_STAGE(PG8_SB(1, 1), b3 + hstepB, voffB); PG8_STAGE(PG8_SA(1, 0), a3, ao[0]);
            PG8_WAIT_V(8); PG8_WAIT_L(0); PG8_BAR; PG8_MMA(1, 0, At, B0); PG8_MMA(1, 1, At, B1); PG8_BAR; PG8_SCHED;
        }
        if (wr == 0) PG8_BAR;
        p.epi_fast(acc, cur, wr, wc, fr, fq, tbl + (ui & 1) * 4096, lds + TBL_RED, tid, lds + PG8_SA(1, 1) + ldsw);
        if (!has_next) break;
#pragma unroll
        for (int a = 0; a < 2; ++a)
#pragma unroll
            for (int b = 0; b < 2; ++b)
#pragma unroll
                for (int m = 0; m < 4; ++m)
#pragma unroll
                    for (int n = 0; n < 2; ++n) acc[a][b][m][n] = (f32x4){0.f, 0.f, 0.f, 0.f};
        cur = nxt; cB = nB; ++ui;
        if (wr == 1) PG8_BAR;
    }
    PG8_WAIT_V(0);
    PG8_BAR;
#undef PG8_SA
#undef PG8_SB
#undef PG8_STAGE
#undef PG8_LDA
#undef PG8_LDB
#undef PG8_MMA
#undef PG8_WAIT_V
#undef PG8_WAIT_L
#undef PG8_BAR
#undef PG8_SCHED
#undef PG8_AOFF
}
template <class P> DEV void gemm_phase(const P& p, LAS unsigned char* lds) {
#if 1
    gemm_phase_fast(p, lds);
#else
    gemm_phase(p, lds);
#endif
}

DEV void cvt_weight(const float* src, bf16_t* dst, int K, int N, int nbatch, int mode, const float* gbase, LAS unsigned char*, int G) {
    const int tid = opaque_tid(), half = tid >> 8, t = tid & 255, l = t & 63, kq = l & 7, n4 = (l >> 3) + 8 * (t >> 6);
    const int tn = N / 128, tpm = (K / 64) * tn, total = tpm * nbatch;
    for (int id = blockIdx.x * 2 + half; id < total; id += G * 2) {
        const int b = id / tpm, rem = id % tpm, k0 = (rem / tn) * 64 + 8 * kq, n = (rem % tn) * 128 + 4 * n4;
        const float* g = nullptr;
        if (mode == 1) g = gbase + (size_t)(3 * b) * D; else if (mode == 2) g = gbase; else if (mode == 3) g = gbase + (size_t)(b / 64) * D; else if (mode == 4) g = gbase + (size_t)b * D;
        float cs = 1.f;
        if (mode == 1) cs = ((n % 3072) < 1024) ? QSCALE : 1.f; else if (mode == 2) cs = (n < 1024) ? QSCALE : 1.f;
        const float* sp = src + (size_t)b * K * N + (size_t)k0 * N + n;
        f32x4 v0 = *(const f32x4*)(sp), v1 = *(const f32x4*)(sp + (size_t)N), v2 = *(const f32x4*)(sp + (size_t)2 * N), v3 = *(const f32x4*)(sp + (size_t)3 * N),
              v4 = *(const f32x4*)(sp + (size_t)4 * N), v5 = *(const f32x4*)(sp + (size_t)5 * N), v6 = *(const f32x4*)(sp + (size_t)6 * N), v7 = *(const f32x4*)(sp + (size_t)7 * N);
        if (g) { const f32x4 ga = *(const f32x4*)(g + k0), gb = *(const f32x4*)(g + k0 + 4); v0 = v0 * (ga[0] * cs); v1 = v1 * (ga[1] * cs); v2 = v2 * (ga[2] * cs); v3 = v3 * (ga[3] * cs); v4 = v4 * (gb[0] * cs); v5 = v5 * (gb[1] * cs); v6 = v6 * (gb[2] * cs); v7 = v7 * (gb[3] * cs); }
        bf16_t* dp = dst + (size_t)b * K * N + k0;
#define CVT_ST(JJ) do { int nn = n + JJ; if (mode == 3) { if (nn < 512) nn = 256 * (nn >> 7) + (nn & 127); else { const int q = nn - 512; nn = 256 * (q >> 7) + 128 + (q & 127); } } \
            u32x4 w; w.x = pk2(v0[JJ], v1[JJ]); w.y = pk2(v2[JJ], v3[JJ]); w.z = pk2(v4[JJ], v5[JJ]); w.w = pk2(v6[JJ], v7[JJ]); *(u32x4*)(dp + (size_t)nn * K) = w; } while (0)
        CVT_ST(0); CVT_ST(1); CVT_ST(2); CVT_ST(3);
#undef CVT_ST
    }
}

DEV void phase_prologue(const Ctx& c, LAS unsigned char* lds) {
    unsigned char* ws = c.ws;
    cvt_weight(c.a_w_in, (bf16_t*)(ws + WS_WAIN), D, NA, 2, 1, c.norm_mix, lds, c.G);
    cvt_weight(c.b_w_in, (bf16_t*)(ws + WS_WBIN), D, NB, 1, 2, c.norm_mix + 1 * D, lds, c.G);
    cvt_weight(c.c_w_in, (bf16_t*)(ws + WS_WCIN), D, NB, 1, 2, c.norm_mix + 2 * D, lds, c.G);
    cvt_weight(c.a_w_out, (bf16_t*)(ws + WS_WAOUT), D, D, 2, 0, nullptr, lds, c.G);
    cvt_weight(c.b_w_out, (bf16_t*)(ws + WS_WBOUT), D, D, 1, 0, nullptr, lds, c.G);
    cvt_weight(c.c_w_out, (bf16_t*)(ws + WS_WCOUT), D, D, 1, 0, nullptr, lds, c.G);
    cvt_weight(c.w_gu, (bf16_t*)(ws + WS_WGU), D, 1024, NE, 3, c.norm_ffn, lds, c.G);
    cvt_weight(c.w_dn, (bf16_t*)(ws + WS_WDN), FE, D, NE, 0, nullptr, lds, c.G);
    cvt_weight(c.w_pg, (bf16_t*)(ws + WS_WPG), D, D, DEPTH, 4, c.norm_ple, lds, c.G);
    cvt_weight(c.w_pp, (bf16_t*)(ws + WS_WPP), PLE, D, DEPTH, 0, nullptr, lds, c.G);
    { float* wr = (float*)(ws + WS_WR);
      for (int i = blockIdx.x * NTHR + threadIdx.x; i < DEPTH * 80 * D; i += c.G * NTHR) { const int k = i & (D - 1), n = (i >> 10) % 80, L = i / (80 * D);
          float v = 0.f; if (n < 8) v = c.w_coarse[((size_t)L * D + k) * 8 + n]; else if (n < 72) v = c.w_fine[((size_t)L * D + k) * 64 + (n - 8)];
          v *= c.norm_ffn[L * D + k]; wr[i] = v; const unsigned hb_ = f2bf(v); ((bf16_t*)(ws + WS_WRH))[i] = (bf16_t)hb_; ((bf16_t*)(ws + WS_WRH))[(size_t)DEPTH * 80 * D + i] = (bf16_t)f2bf(v - bf2f(hb_)); } }
    { float* ones = (float*)(ws + WS_ONES); for (int i = blockIdx.x * NTHR + threadIdx.x; i < 1024; i += c.G * NTHR) ones[i] = 1.f; }
    { const size_t n4 = (size_t)DEPTH * T * PLE / 4; const f32x4* s = (const f32x4*)c.p; uint2* d = (uint2*)(ws + WS_PB);
      for (size_t i = (size_t)blockIdx.x * NTHR + threadIdx.x; i < n4; i += (size_t)c.G * NTHR) { const f32x4 v = s[i]; d[i] = make_uint2(pk2(v.x, v.y), pk2(v.z, v.w)); } }
    { const int tid_ = opaque_tid(); const int w = tid_ >> 6, lane = tid_ & 63; bf16_t* hb = (bf16_t*)(ws + WS_HB); float* ssq = (float*)(ws + WS_SSQ);
      const int stride = c.G * NWAVES;
      for (int tok0 = blockIdx.x * NWAVES + w; tok0 < T; tok0 += 4 * stride) {
          f32x4 v[4][4];
#pragma unroll
          for (int q = 0; q < 4; ++q) { const int tok = tok0 + q * stride; const f32x4* xr = (const f32x4*)(c.x + (size_t)((tok < T) ? tok : tok0) * D) + lane;
#pragma unroll
              for (int j = 0; j < 4; ++j) v[q][j] = xr[64 * j]; }
#pragma unroll
          for (int q = 0; q < 4; ++q) { const int tok = tok0 + q * stride; if (tok < T) { uint2* o = (uint2*)(hb + (size_t)tok * D) + lane; float s = 0.f;
#pragma unroll
              for (int j = 0; j < 4; ++j) { const f32x4 t = v[q][j]; s += (t.x * t.x + t.y * t.y) + (t.z * t.z + t.w * t.w); o[64 * j] = make_uint2(pk2(t.x, t.y), pk2(t.z, t.w)); }
              s = wave_sum(s); if (lane < 4) ssq[(size_t)tok * 4 + lane] = (lane == 0) ? s : 0.f; } } } }
}


template <int NL> struct CvtGeo { static constexpr int NT = (NL == 8) ? 32 : 64, PER_LAYER = 64 * 16 * NT + 64 * 8 * NT, KQM = (NL == 8) ? 7 : 15, KQS = (NL == 8) ? 3 : 4; };
struct CvtAddr { const float* sp; bf16_t* dp; const float* g; int N, K, n, perm; };
template <int NL> DEV CvtAddr moe_cvt_addr(const Ctx& c, int L0, int idx, int lane) {
    typedef CvtGeo<NL> G_; CvtAddr a; const int Lc = L0 + idx / G_::PER_LAYER; int t = idx % G_::PER_LAYER; const int kq = lane & G_::KQM, n4 = lane >> G_::KQS;
    if (t < 64 * 16 * G_::NT) { const int e = t / (16 * G_::NT), kt = (t / G_::NT) & 15, nt = t % G_::NT; const int k0 = kt * 64 + NL * kq; a.n = nt * (4 * NL) + 4 * n4; a.N = 1024; a.K = D; a.perm = 1;
        a.sp = c.w_gu + ((size_t)(Lc * NE + e) * D + k0) * 1024 + a.n; a.dp = (bf16_t*)(c.ws + WS_WGU) + (size_t)(Lc * NE + e) * 1024 * D + k0; a.g = c.norm_ffn + Lc * D + k0; }
    else { t -= 64 * 16 * G_::NT; const int e = t / (8 * G_::NT), kt = (t / G_::NT) & 7, nt = t % G_::NT; const int k0 = kt * 64 + NL * kq; a.n = nt * (4 * NL) + 4 * n4; a.N = D; a.K = FE; a.perm = 0;
        a.sp = c.w_dn + ((size_t)(Lc * NE + e) * FE + k0) * D + a.n; a.dp = (bf16_t*)(c.ws + WS_WDN) + (size_t)(Lc * NE + e) * D * FE + k0; a.g = (const float*)(c.ws + WS_ONES) + k0; }
    return a;
}
template <int NL> DEV void moe_cvt_issue(const Ctx& c, int L0, int idx, int lane, f32x4 (&v)[NL], f32x4 (&gv)[NL / 4]) {
    const CvtAddr a = moe_cvt_addr<NL>(c, L0, idx, lane);
#pragma unroll
    for (int j = 0; j < NL; ++j) v[j] = *(const f32x4*)(a.sp + (size_t)j * a.N);
#pragma unroll
    for (int j = 0; j < NL / 4; ++j) gv[j] = *(const f32x4*)(a.g + 4 * j);
}
template <int NL> DEV void moe_cvt_finish(const Ctx& c, int L0, int idx, int lane, const f32x4 (&v)[NL], const f32x4 (&gv)[NL / 4]) {
    const CvtAddr a = moe_cvt_addr<NL>(c, L0, idx, lane);
#pragma unroll
    for (int jj = 0; jj < 4; ++jj) { int nn = a.n + jj;
        if (a.perm) { if (nn < 512) nn = 256 * (nn >> 7) + (nn & 127); else { const int q = nn - 512; nn = 256 * (q >> 7) + 128 + (q & 127); } }
        unsigned w[NL / 2];
#pragma unroll
        for (int j = 0; j < NL / 2; ++j) w[j] = cvt_pk_bf16(v[2 * j][jj] * gv[(2 * j) >> 2][(2 * j) & 3], v[2 * j + 1][jj] * gv[(2 * j + 1) >> 2][(2 * j + 1) & 3]);
        if constexpr (NL == 8) { u32x4 ww; ww.x = w[0]; ww.y = w[1]; ww.z = w[2]; ww.w = w[3]; *(u32x4*)(a.dp + (size_t)nn * a.K) = ww; }
        else { u32x2 ww; ww.x = w[0]; ww.y = w[1]; *(u32x2*)(a.dp + (size_t)nn * a.K) = ww; } }
}
struct CvtHost { int nxt, pend, step, total, L0; };
#define CVT_TICK(NL, H, c, lane, v, gv) do { if ((H).pend >= 0) { moe_cvt_finish<NL>(c, (H).L0, (H).pend, lane, v, gv); (H).pend = -1; } \
        if ((H).nxt < (H).total) { moe_cvt_issue<NL>(c, (H).L0, (H).nxt, lane, v, gv); (H).pend = (H).nxt; (H).nxt += (H).step; } } while (0)
#define CVT_DRAIN(NL, H, c, lane, v, gv) do { asm volatile("s_waitcnt vmcnt(0)" ::: "memory"); if ((H).pend >= 0) { moe_cvt_finish<NL>(c, (H).L0, (H).pend, lane, v, gv); (H).pend = -1; } \
        while ((H).nxt < (H).total) { f32x4 v1_[NL], g1_[NL / 4], v2_[NL], g2_[NL / 4], v3_[NL], g3_[NL / 4]; const int i0_ = (H).nxt, i1_ = i0_ + (H).step, i2_ = i1_ + (H).step, i3_ = i2_ + (H).step; \
            moe_cvt_issue<NL>(c, (H).L0, i0_, lane, v, gv); if (i1_ < (H).total) moe_cvt_issue<NL>(c, (H).L0, i1_, lane, v1_, g1_); if (i2_ < (H).total) moe_cvt_issue<NL>(c, (H).L0, i2_, lane, v2_, g2_); \
            if (i3_ < (H).total) moe_cvt_issue<NL>(c, (H).L0, i3_, lane, v3_, g3_); \
            moe_cvt_finish<NL>(c, (H).L0, i0_, lane, v, gv); if (i1_ < (H).total) moe_cvt_finish<NL>(c, (H).L0, i1_, lane, v1_, g1_); if (i2_ < (H).total) moe_cvt_finish<NL>(c, (H).L0, i2_, lane, v2_, g2_); \
            if (i3_ < (H).total) moe_cvt_finish<NL>(c, (H).L0, i3_, lane, v3_, g3_); (H).nxt = i3_ + (H).step; } } while (0)

typedef short s16x4 __attribute__((ext_vector_type(4)));
typedef short v4i16_t __attribute__((ext_vector_type(4)));
DEV s16x4 vtr(const LAS unsigned char* p) { return __builtin_bit_cast(s16x4, __builtin_amdgcn_ds_read_tr16_b64_v4i16((LAS v4i16_t*)p)); }
DEV void glds16(const void* g, LAS unsigned char* l) { __builtin_amdgcn_global_load_lds((const unsigned*)g, (LAS unsigned*)l, 16, 0, 0); }
DEV float xhalf_max(float v) { auto rr = __builtin_amdgcn_permlane32_swap(__float_as_uint(v), __float_as_uint(v), false, false); return fmaxf(__uint_as_float(rr[0]), __uint_as_float(rr[1])); }
DEV float xhalf_sum(float v) { auto rr = __builtin_amdgcn_permlane32_swap(__float_as_uint(v), __float_as_uint(v), false, false); return __uint_as_float(rr[0]) + __uint_as_float(rr[1]); }
DEV bf16x8 pack8(const f32x16& p, int s8) {
    u32x4 w; w.x = cvt_pk_bf16(p[s8], p[s8 + 1]); w.y = cvt_pk_bf16(p[s8 + 2], p[s8 + 3]); w.z = cvt_pk_bf16(p[s8 + 4], p[s8 + 5]); w.w = cvt_pk_bf16(p[s8 + 6], p[s8 + 7]);
    return __builtin_bit_cast(bf16x8, w);
}
#define ATT_WAITV(n) do { static_assert((n) == 0, "vmcnt(0) only"); __builtin_amdgcn_s_waitcnt(0x0F70); asm volatile("" ::: "memory"); } while (0)
#define ATT_BAR() asm volatile("s_waitcnt lgkmcnt(0)\n\ts_barrier" ::: "memory")
#define MFMA32(a, b, c) __builtin_amdgcn_mfma_f32_32x32x16_bf16((a), (b), (c), 0, 0, 0)

DEV void attB_stage(const bf16_t* kvb, int t, LAS unsigned char* buf, int wid, int lane) {
    if (wid < 4) { const int cc = wid >> 1;
#pragma unroll
        for (int j = 0; j < 4; ++j) { const int kk = (wid & 1) * 4 + j, row = 8 * kk + (lane >> 3), ch = (lane & 7) ^ ((row >> 1) & 7);
            glds16(kvb + hm(16 + cc, 64 * t + row) + ch * 8, buf + cc * 8192 + kk * 1024); }
    } else {
#pragma unroll
        for (int j = 0; j < 4; ++j) { const int kk = (wid - 4) * 4 + j, row = 4 * kk + (lane >> 4), ch = (lane & 15) ^ ((row & 3) << 2);
            glds16(kvb + hm(32 + (ch >> 3), 64 * t + row) + (ch & 7) * 8, buf + 16384 + kk * 1024); }
    }
}
DEV void attB_kmax(const Ctx& c) {
    const int tid_ = opaque_tid(); const int w = tid_ >> 6, lane = tid_ & 63;
    const bf16_t* qkv = (const bf16_t*)(c.ws + WS_QKV); float* km = (float*)(c.ws + WS_KMAX);
    for (int it = blockIdx.x * NWAVES + w; it < 8 * 8 * 2 * 64; it += c.G * NWAVES) {
        const int t = it & 63, cc = (it >> 6) & 1, h = (it >> 7) & 7, b = it >> 10;
        const uint4* kp = (const uint4*)(qkv + hm(16 + 2 * h + cc, b * SEQ + 64 * t + lane)); float s = 0.f;
#pragma unroll
        for (int j = 0; j < 8; ++j) { const uint4 v = kp[j]; const unsigned ws_[4] = {v.x, v.y, v.z, v.w};
#pragma unroll
            for (int k = 0; k < 4; ++k) { const float a = bf2f(ws_[k] & 0xffffu), bq = bf2f(ws_[k] >> 16); s += a * a + bq * bq; } }
        s = wave_max(s);
        if (lane == 0) km[it] = sqrtf(s) * 1.01f;
    }
}
DEV void attB_fast(const Ctx& c, float lam, float lambda_init, const float* subln, LAS unsigned char* lds) {
    const int tid = opaque_tid(), wid = __builtin_amdgcn_readfirstlane(tid >> 6), lane = tid & 63, r = lane & 31, hh = lane >> 5;
    const int qt = wid & 3, cc = wid >> 2;
    const bf16_t* qkv = (const bf16_t*)(c.ws + WS_QKV); bf16_t* o = (bf16_t*)(c.ws + WS_O);
    const int vcu = (c.G % 8 == 0) ? ((int)blockIdx.x % 8) * (c.G / 8) + (int)blockIdx.x / 8 : (int)blockIdx.x;
    int koff[4], voff[4];
#pragma unroll
    for (int ds = 0; ds < 4; ++ds) koff[ds] = r * 128 + (((2 * ds + hh) ^ ((r >> 1) & 7)) << 4);
    { const int i16 = lane & 15, qp = i16 >> 2, pp = i16 & 3, blk = (lane >> 4) & 1;
#pragma unroll
      for (int db = 0; db < 4; ++db) voff[db] = (4 * hh + qp) * 256 + 8 * (pp & 1) + ((((db ^ qp) << 2) + 2 * blk + (pp >> 1)) << 4); }
    CvtHost H; H.L0 = 1; H.total = 2 * CvtGeo<4>::PER_LAYER; H.step = c.G * NWAVES; H.nxt = (int)blockIdx.x * NWAVES + wid; H.pend = -1; f32x4 cv[4], cg[1];
    LAS unsigned* flags = (LAS unsigned*)(lds + TBL_RED);
    const float* kmaxp = (const float*)(c.ws + WS_KMAX);
    for (int pu = vcu; pu < 1024; pu += c.G) {
        const int iu = pu >> 8, vq = pu & 255, g16 = (vq >> 4) & 15, s = vq & 15, b = g16 >> 1;
        const int h = (g16 & 1) ? ((iu == 0) ? 6 : (iu == 1) ? 1 : (iu == 2) ? 0 : 5) : ((iu == 0) ? 7 : (iu == 1) ? 2 : (iu == 2) ? 3 : 4);
        float kms = kmaxp[((b * 8 + h) * 2 + cc) * 64 + lane];
#pragma unroll
        for (int d = 1; d < 64; d <<= 1) { const float v = __shfl_up(kms, d); if (lane >= d) kms = fmaxf(kms, v); }
        const float slope2 = exp2f(-(float)(h + 1)) * LOG2E;
        f32x16 Bt;
#pragma unroll
        for (int i = 0; i < 16; ++i) Bt[i] = slope2 * (float)(crow(i, hh) - r);
        const bf16_t* kvb = qkv + hm(2 * h, b * SEQ);
        for (int half = 0; half < 2; ++half) {
            const int qb = half ? 31 - s : s, Q0 = qb * 128, Tn = 2 * qb + 2, qrow0 = Q0 + 32 * qt;
            attB_stage(kvb, Tn - 1, lds, wid, lane);
            ATT_BAR();
            float qn = 0.f;
            LAS unsigned char* const qlds = lds + 98304 + wid * 4096 + lane * 16;
            { const bf16_t* qp_ = kvb + hm(cc, qrow0 + r) + 8 * hh;
#pragma unroll
              for (int ds = 0; ds < 4; ++ds) { const bf16x8 qv = *(const bf16x8*)(qp_ + 16 * ds); *(LAS bf16x8*)(qlds + ds * 1024) = qv;
#pragma unroll
                  for (int j = 0; j < 8; ++j) { const float v = bf2f((unsigned)(unsigned short)qv[j]); qn += v * v; } } }
            attB_stage(kvb, Tn - 2, lds + 32768, wid, lane);
            qn = sqrtf(xhalf_sum(qn)) * 1.01f;
            if (lane == 0) { flags[wid] = 1u; flags[8 + wid] = 1u; }
            int par = 0;
            f32x16 O[4];
#pragma unroll
            for (int db = 0; db < 4; ++db)
#pragma unroll
                for (int i = 0; i < 16; ++i) O[db][i] = 0.f;
            float m = -1e30f, l = 0.f; int bi = 0;
            for (int t = Tn - 1; t >= 0; --t) {
                ATT_WAITV(0);
                ATT_BAR();
                { unsigned al = 0u;
#pragma unroll
                  for (int k = 0; k < 8; ++k) al |= flags[par * 8 + k];
                  if (__builtin_amdgcn_readfirstlane(al) == 0u) break; }
                CVT_TICK(4, H, c, lane, cv, cg);
                if (t >= 2) attB_stage(kvb, t - 2, lds + ((bi + 2) % 3) * 32768, wid, lane);
                if (64 * t <= qrow0) {
                    const LAS unsigned char* Kb = lds + bi * 32768 + cc * 8192; const LAS unsigned char* Vb = lds + bi * 32768 + 16384;
                    f32x16 p0 = Bt, p1 = Bt;
#pragma unroll
                    for (int ds = 0; ds < 4; ++ds) { const bf16x8 k0 = *(const LAS bf16x8*)(Kb + koff[ds]), k1 = *(const LAS bf16x8*)(Kb + 4096 + koff[ds]), qv = *(const LAS bf16x8*)(qlds + ds * 1024); p0 = MFMA32(k0, qv, p0); p1 = MFMA32(k1, qv, p1); }
                    const float off0 = slope2 * (float)(64 * t - qrow0), off1 = off0 + 32.f * slope2;
                    if (64 * t + 63 > qrow0) {
#pragma unroll
                        for (int i = 0; i < 16; ++i) { const int key = 64 * t + crow(i, hh); if (key > qrow0 + r) p0[i] = -INFINITY; if (key + 32 > qrow0 + r) p1[i] = -INFINITY; } }
                    float mx0 = p0[0], mx1 = p1[0];
#pragma unroll
                    for (int i = 1; i < 16; ++i) { mx0 = fmaxf(mx0, p0[i]); mx1 = fmaxf(mx1, p1[i]); }
                    const float mx = xhalf_max(fmaxf(mx0 + off0, mx1 + off1));
                    if (__any(mx > m + 8.f)) { const float mn = fmaxf(m, mx), f = __builtin_amdgcn_exp2f(m - mn); l *= f; m = mn;
#pragma unroll
                        for (int db = 0; db < 4; ++db)
#pragma unroll
                            for (int i = 0; i < 16; ++i) O[db][i] *= f; }
                    const float e0 = off0 - m, e1 = off1 - m; float ls = 0.f;
#pragma unroll
                    for (int i = 0; i < 16; ++i) { p0[i] = __builtin_amdgcn_exp2f(p0[i] + e0); p1[i] = __builtin_amdgcn_exp2f(p1[i] + e1); ls += p0[i] + p1[i]; }
                    l += ls;
                    bf16x8 pa[4]; pa[0] = pack8(p0, 0); pa[1] = pack8(p0, 8); pa[2] = pack8(p1, 0); pa[3] = pack8(p1, 8);
#pragma unroll
                    for (int db = 0; db < 4; ++db) { const unsigned va = (unsigned)(uintptr_t)(Vb + voff[db]); s16x4 lo[4], hi[4];
#pragma unroll
                        for (int ks = 0; ks < 4; ++ks) { asm volatile("ds_read_b64_tr_b16 %0, %1 offset:%c2" : "=&v"(lo[ks]) : "v"(va), "i"(ks * 4096) : "memory");
                                                         asm volatile("ds_read_b64_tr_b16 %0, %1 offset:%c2" : "=&v"(hi[ks]) : "v"(va), "i"(ks * 4096 + 2048) : "memory"); }
                        asm volatile("s_waitcnt lgkmcnt(0)" ::: "memory"); __builtin_amdgcn_sched_barrier(0);
#pragma unroll
                        for (int ks = 0; ks < 4; ++ks) { const bf16x8 vf = (bf16x8){lo[ks][0], lo[ks][1], lo[ks][2], lo[ks][3], hi[ks][0], hi[ks][1], hi[ks][2], hi[ks][3]}; O[db] = MFMA32(vf, pa[ks], O[db]); } }
                }
                bi = (bi + 1) % 3; par ^= 1;
                if (t >= 1) { const float kb = __builtin_amdgcn_readlane(kms, t - 1);
                    const float ub = qn * kb + slope2 * (float)(64 * (t - 1) + 63 - (qrow0 + r)) - m;
                    const bool alive = __any(ub > -36.f); if (lane == 0) flags[par * 8 + wid] = alive ? 1u : 0u; }
            }
            ATT_WAITV(0);
            l = xhalf_sum(l);
            ATT_BAR();
            LAS float* X = (LAS float*)(lds + 65536) + qt * 4096;
            if (cc == 1) { const float sc = lam / l;
#pragma unroll
                for (int db = 0; db < 4; ++db)
#pragma unroll
                    for (int i = 0; i < 16; ++i) X[(db * 16 + i) * 64 + lane] = O[db][i] * sc; }
            ATT_BAR();
            if (cc == 0) { const float inv = 1.f / l; float ss = 0.f;
#pragma unroll
                for (int db = 0; db < 4; ++db)
#pragma unroll
                    for (int i = 0; i < 16; ++i) { const float v = O[db][i] * inv - X[(db * 16 + i) * 64 + lane]; O[db][i] = v; ss += v * v; }
                ss = xhalf_sum(ss); const float rs = rsqrtf(ss * (1.f / 128.f) + EPS) * (1.f - lambda_init);
                bf16_t* op = o + (size_t)(b * SEQ + qrow0 + r) * D + h * 128 + 4 * hh;
#pragma unroll
                for (int db = 0; db < 4; ++db)
#pragma unroll
                    for (int g = 0; g < 4; ++g) { const int d = 32 * db + 8 * g; const f32x4 sl = *(const f32x4*)(subln + d + 4 * hh);
                        u32x2 w; w.x = cvt_pk_bf16(O[db][4 * g] * rs * sl[0], O[db][4 * g + 1] * rs * sl[1]); w.y = cvt_pk_bf16(O[db][4 * g + 2] * rs * sl[2], O[db][4 * g + 3] * rs * sl[3]);
                        *(u32x2*)(op + d) = w; } }
        }
    }
    CVT_DRAIN(4, H, c, lane, cv, cg);
    ATT_WAITV(0);
    ATT_BAR();
}

DEV void attC_stage(const bf16_t* kvb, int t, LAS unsigned char* buf, int wid, int lane) {
    const int row = 8 * wid + (lane >> 3);
    glds16(kvb + hm(16, 64 * t + row) + (((lane & 7) ^ ((row >> 1) & 7)) << 3), buf + wid * 1024);
    glds16(kvb + hm(32, 64 * t + row) + (((lane & 7) ^ (((row >> 1) & 1) << 2)) << 3), buf + 8192 + wid * 1024);
}
DEV float sb_scan(const f32x16& w, f32x16& a, float Rin, int hh) {
    float ex[16], gp[4], gq[4];
#pragma unroll
    for (int g = 0; g < 4; ++g) { const float t23 = w[4 * g + 2] * w[4 * g + 3], s0 = w[4 * g + 1] * t23; gp[g] = w[4 * g] * s0; ex[4 * g] = s0; ex[4 * g + 1] = t23; ex[4 * g + 2] = w[4 * g + 3]; ex[4 * g + 3] = 1.f; }
    float pp[4];
#pragma unroll
    for (int g = 0; g < 4; ++g) { auto rr = __builtin_amdgcn_permlane32_swap(__float_as_uint(gp[g]), __float_as_uint(gp[g]), false, false);
        const float lo = __uint_as_float(rr[0]), hi = __uint_as_float(rr[1]); pp[g] = lo * hi; gq[g] = hh ? 1.f : hi; }
    float Q[4]; Q[3] = 1.f; Q[2] = pp[3]; Q[1] = pp[2] * Q[2]; Q[0] = pp[1] * Q[1];
    const float tot = pp[0] * Q[0];
#pragma unroll
    for (int g = 0; g < 4; ++g) { const float base = Rin * Q[g] * gq[g];
#pragma unroll
        for (int j = 0; j < 4; ++j) a[4 * g + j] = a[4 * g + j] * (base * ex[4 * g + j]); }
    return tot;
}
DEV void attC_fast(const Ctx& c, LAS unsigned char* lds) {
    const int tid = opaque_tid(), wid = __builtin_amdgcn_readfirstlane(tid >> 6), lane = tid & 63, r = lane & 31, hh = lane >> 5;
    const bf16_t* qkv = (const bf16_t*)(c.ws + WS_QKV); bf16_t* o = (bf16_t*)(c.ws + WS_O);
    const int vcu = (c.G % 8 == 0) ? ((int)blockIdx.x % 8) * (c.G / 8) + (int)blockIdx.x / 8 : (int)blockIdx.x;
    CvtHost H; H.L0 = 3; H.total = CvtGeo<8>::PER_LAYER; H.step = c.G * NWAVES; H.nxt = (int)blockIdx.x * NWAVES + wid; H.pend = -1; f32x4 cv[8], cg[2];
    LAS unsigned* flags = (LAS unsigned*)(lds + 49152);
    int koff[4], voff[2];
#pragma unroll
    for (int ds = 0; ds < 4; ++ds) koff[ds] = r * 128 + (((2 * ds + hh) ^ ((r >> 1) & 7)) << 4);
    { const int i16 = lane & 15, qp = i16 >> 2, pp = i16 & 3, blk = (lane >> 4) & 1;
#pragma unroll
      for (int db = 0; db < 2; ++db) voff[db] = (4 * hh + qp) * 128 + 8 * (pp & 1) + (((4 * (db ^ (qp >> 1))) + 2 * blk + (pp >> 1)) << 4); }
    for (int un = vcu; un < 2048; un += c.G) {
        const int bh = un >> 4, qb = un & 15, b = bh >> 4, h = bh & 15;
        const bf16_t* kvb = qkv + hm(h, b * SEQ);
        const int Q0 = qb * 256, qrow0 = Q0 + 32 * wid, T1 = Q0 / 64 + 3;
        attC_stage(kvb, T1, lds, wid, lane);
        bf16x8 qf[4];
        { const bf16_t* qp_ = kvb + hm(0, qrow0 + r) + 8 * hh;
#pragma unroll
          for (int ds = 0; ds < 4; ++ds) qf[ds] = *(const bf16x8*)(qp_ + 16 * ds); }
        attC_stage(kvb, T1 - 1, lds + 16384, wid, lane);
        f32x16 O[2];
#pragma unroll
        for (int db = 0; db < 2; ++db)
#pragma unroll
            for (int i = 0; i < 16; ++i) O[db][i] = 0.f;
        float R = 1.f; int bi = 0, par = 0;
        if (lane == 0) { flags[wid] = 1u; flags[8 + wid] = 1u; }
        for (int t = T1; t >= 0; --t) {
            ATT_WAITV(0);
            ATT_BAR();
            { unsigned al = 0u;
#pragma unroll
              for (int k = 0; k < 8; ++k) al |= flags[par * 8 + k];
              if (__builtin_amdgcn_readfirstlane(al) == 0u) break; }
            CVT_TICK(8, H, c, lane, cv, cg);
            if (t >= 2) attC_stage(kvb, t - 2, lds + ((bi + 2) % 3) * 16384, wid, lane);
            if (64 * t < qrow0 + 31) {
                const LAS unsigned char* Kb = lds + bi * 16384; const LAS unsigned char* Vb = Kb + 8192;
                f32x16 p0, p1;
#pragma unroll
                for (int i = 0; i < 16; ++i) { p0[i] = 0.f; p1[i] = 0.f; }
#pragma unroll
                for (int ds = 0; ds < 4; ++ds) { const bf16x8 k0 = *(const LAS bf16x8*)(Kb + koff[ds]), k1 = *(const LAS bf16x8*)(Kb + 4096 + koff[ds]); p0 = MFMA32(k0, qf[ds], p0); p1 = MFMA32(k1, qf[ds], p1); }
                const bool diag = 64 * t + 63 >= qrow0;
                f32x16 w0, w1;
#pragma unroll
                for (int i = 0; i < 16; ++i) {
                    const float E0 = __builtin_amdgcn_exp2f(fminf(p0[i], 60.f)), E1 = __builtin_amdgcn_exp2f(fminf(p1[i], 60.f));
                    float v0 = __builtin_amdgcn_rcpf(1.f + E0), v1 = __builtin_amdgcn_rcpf(1.f + E1); float b0 = E0 * v0, b1 = E1 * v1;
                    if (diag) { const int key = 64 * t + crow(i, hh); if (key >= qrow0 + r) { v0 = 1.f; b0 = 0.f; } if (key + 32 >= qrow0 + r) { v1 = 1.f; b1 = 0.f; } }
                    w0[i] = v0; w1[i] = v1; p0[i] = b0; p1[i] = b1; }
                const float tot1 = sb_scan(w1, p1, R, hh);
                const float R1 = R * tot1;
                const float tot0 = sb_scan(w0, p0, R1, hh);
                R = R1 * tot0;
                bf16x8 pa[4]; pa[0] = pack8(p0, 0); pa[1] = pack8(p0, 8); pa[2] = pack8(p1, 0); pa[3] = pack8(p1, 8);
#pragma unroll
                for (int db = 0; db < 2; ++db) { const unsigned va = (unsigned)(uintptr_t)(Vb + voff[db]); s16x4 lo[4], hi[4];
#pragma unroll
                    for (int ks = 0; ks < 4; ++ks) { asm volatile("ds_read_b64_tr_b16 %0, %1 offset:%c2" : "=&v"(lo[ks]) : "v"(va), "i"(ks * 2048) : "memory");
                                                     asm volatile("ds_read_b64_tr_b16 %0, %1 offset:%c2" : "=&v"(hi[ks]) : "v"(va), "i"(ks * 2048 + 1024) : "memory"); }
                    asm volatile("s_waitcnt lgkmcnt(0)" ::: "memory"); __builtin_amdgcn_sched_barrier(0);
#pragma unroll
                    for (int ks = 0; ks < 4; ++ks) { const bf16x8 vf = (bf16x8){lo[ks][0], lo[ks][1], lo[ks][2], lo[ks][3], hi[ks][0], hi[ks][1], hi[ks][2], hi[ks][3]}; O[db] = MFMA32(vf, pa[ks], O[db]); } }
            }
            par ^= 1;
            { const bool alive = __any(R > 8.6736174e-19f); if (lane == 0) flags[par * 8 + wid] = alive ? 1u : 0u; }
            bi = (bi + 1) % 3;
        }
        ATT_WAITV(0);
        bf16_t* op = o + (size_t)(b * SEQ + qrow0 + r) * D + h * 64 + 4 * hh;
#pragma unroll
        for (int db = 0; db < 2; ++db)
#pragma unroll
            for (int g = 0; g < 4; ++g) { u32x2 wv; wv.x = cvt_pk_bf16(O[db][4 * g], O[db][4 * g + 1]); wv.y = cvt_pk_bf16(O[db][4 * g + 2], O[db][4 * g + 3]); *(u32x2*)(op + 32 * db + 8 * g) = wv; }
        ATT_BAR();
    }
    CVT_DRAIN(8, H, c, lane, cv, cg);
    ATT_WAITV(0);
}

struct AUnit { int b, h, g, cres, rr, i0; };
DEV AUnit attA_unit(int un, int g) {
    AUnit u; const int bh = un >> 4, j = un & 15; u.b = bh >> 4; u.h = bh & 15; u.g = g;
    int m; if (g == 0) { u.cres = 0; m = j; } else if (g == 1) { u.cres = j >> 2; m = j & 3; } else { u.cres = j; m = 0; }
    u.rr = (g == 0) ? 1 : (g == 1 ? 4 : 16); u.i0 = m * 256; return u;
}
DEV void attA_fast(const Ctx& c, int grp, LAS unsigned char* lds) {
    const int tid = opaque_tid(), wid = __builtin_amdgcn_readfirstlane(tid >> 6), lane = tid & 63, r = lane & 31, hh = lane >> 5;
    const bf16_t* qkv = (const bf16_t*)(c.ws + WS_QKV + (size_t)(grp & 1) * 208 * MiB); bf16_t* og = (bf16_t*)(c.ws + WS_OG); float* lse = (float*)(c.ws + WS_LSE); bf16_t* omerged = (bf16_t*)(c.ws + WS_O);
    const int vcu = (c.G % 8 == 0) ? ((int)blockIdx.x % 8) * (c.G / 8) + (int)blockIdx.x / 8 : (int)blockIdx.x;
    int koff[4], voff[2];
#pragma unroll
    for (int ds = 0; ds < 4; ++ds) koff[ds] = r * 128 + (((2 * ds + hh) ^ ((r >> 1) & 7)) << 4);
    { const int i16 = lane & 15, qp = i16 >> 2, pp = i16 & 3, blk = (lane >> 4) & 1;
#pragma unroll
      for (int db = 0; db < 2; ++db) voff[db] = (4 * hh + qp) * 128 + 8 * (pp & 1) + (((4 * (db ^ (qp >> 1))) + 2 * blk + (pp >> 1)) << 4); }
    LAS unsigned char* const Kb = lds; LAS unsigned char* const Vb = lds + 49152;
    LAS unsigned char* const Qw = lds + 98304 + wid * 4096;
#define ATTA_LOAD_KQ(U) do { const bf16_t* base_ = qkv + hm((U).h, (U).b * SEQ); \
        _Pragma("unroll") for (int k = 0; k < 6; ++k) { const int row = 8 * (6 * wid + k) + (lane >> 3); int ik = (U).i0 - 128 + row; ik = ik < 0 ? 0 : ik; \
            glds16(base_ + hm(16, ik * (U).rr + (U).cres) + (((lane & 7) ^ ((row >> 1) & 7)) << 3), Kb + (6 * wid + k) * 1024); } \
        } while (0)
#define ATTA_LOAD_Q(U) do { const bf16_t* qp_ = qkv + hm((U).h, (U).b * SEQ) + hm(0, ((U).i0 + 32 * wid + r) * (U).rr + (U).cres) + 8 * hh; \
        _Pragma("unroll") for (int ds = 0; ds < 4; ++ds) glds16(qp_ + 16 * ds, Qw + ds * 1024); } while (0)
    int un = vcu;
    AUnit u = attA_unit(un < 2048 ? un : 0, grp);
    if (un < 2048) { ATTA_LOAD_KQ(u); ATTA_LOAD_Q(u); }
    for (; un < 2048; un += c.G) {
        const int unn = un + c.G; const AUnit nu = attA_unit(unn < 2048 ? unn : 0, grp);
        const bf16_t* base = qkv + hm(u.h, u.b * SEQ);
        ATT_WAITV(0);
        ATT_BAR();
#pragma unroll
        for (int k = 0; k < 6; ++k) { const int row = 8 * (6 * wid + k) + (lane >> 3); int ik = u.i0 - 128 + row; ik = ik < 0 ? 0 : ik;
            glds16(base + hm(32, ik * u.rr + u.cres) + (((lane & 7) ^ (((row >> 1) & 1) << 2)) << 3), Vb + (6 * wid + k) * 1024); }
        const int tokq = u.b * SEQ + (u.i0 + 32 * wid + r) * u.rr + u.cres;
        const float sr = exp2f(-0.5f * (float)(u.h + 1)) * LOG2E * (float)u.rr;
        f32x16 S[5];
#pragma unroll
        for (int sidx = 0; sidx < 5; ++sidx) {
#pragma unroll
            for (int i = 0; i < 16; ++i) S[sidx][i] = sr * (float)(crow(i, hh) - r + 32 * sidx - 128);
            if (u.i0 + 32 * wid - 128 + 32 * sidx >= 0) {
                const LAS unsigned char* kb = Kb + (32 * (wid + sidx)) * 128;
#pragma unroll
                for (int ds = 0; ds < 4; ++ds) { const bf16x8 kf = *(const LAS bf16x8*)(kb + koff[ds]), qv = *(const LAS bf16x8*)(Qw + ds * 1024 + lane * 16); S[sidx] = MFMA32(kf, qv, S[sidx]); }
                if (sidx == 0) {
#pragma unroll
                    for (int i = 0; i < 16; ++i) if (crow(i, hh) < r) S[sidx][i] = -INFINITY; }
                if (sidx == 4) {
#pragma unroll
                    for (int i = 0; i < 16; ++i) if (crow(i, hh) > r) S[sidx][i] = -INFINITY; }
            } else {
#pragma unroll
                for (int i = 0; i < 16; ++i) S[sidx][i] = -INFINITY; }
        }
        float mx = S[0][0];
#pragma unroll
        for (int sidx = 0; sidx < 5; ++sidx)
#pragma unroll
            for (int i = 0; i < 16; ++i) mx = fmaxf(mx, S[sidx][i]);
        mx = xhalf_max(mx);
        float l = 0.f; bf16x8 pa[5][2];
#pragma unroll
        for (int sidx = 0; sidx < 5; ++sidx) {
#pragma unroll
            for (int i = 0; i < 16; ++i) { S[sidx][i] = __builtin_amdgcn_exp2f(S[sidx][i] - mx); l += S[sidx][i]; }
            pa[sidx][0] = pack8(S[sidx], 0); pa[sidx][1] = pack8(S[sidx], 8); }
        l = xhalf_sum(l);
        ATT_WAITV(0);
        ATT_BAR();
        if (unn < 2048) ATTA_LOAD_KQ(nu);
        f32x16 O[2];
#pragma unroll
        for (int db = 0; db < 2; ++db)
#pragma unroll
            for (int i = 0; i < 16; ++i) O[db][i] = 0.f;
#pragma unroll
        for (int sidx = 0; sidx < 5; ++sidx) {
            if (u.i0 + 32 * wid - 128 + 32 * sidx >= 0) {
#pragma unroll
                for (int db = 0; db < 2; ++db) { const unsigned va = (unsigned)(uintptr_t)(Vb + (32 * (wid + sidx)) * 128 + voff[db]); s16x4 lo[2], hi[2];
#pragma unroll
                    for (int ks = 0; ks < 2; ++ks) { asm volatile("ds_read_b64_tr_b16 %0, %1 offset:%c2" : "=&v"(lo[ks]) : "v"(va), "i"(ks * 2048) : "memory");
                                                     asm volatile("ds_read_b64_tr_b16 %0, %1 offset:%c2" : "=&v"(hi[ks]) : "v"(va), "i"(ks * 2048 + 1024) : "memory"); }
                    asm volatile("s_waitcnt lgkmcnt(0)" ::: "memory"); __builtin_amdgcn_sched_barrier(0);
#pragma unroll
                    for (int ks = 0; ks < 2; ++ks) { const bf16x8 vf = (bf16x8){lo[ks][0], lo[ks][1], lo[ks][2], lo[ks][3], hi[ks][0], hi[ks][1], hi[ks][2], hi[ks][3]}; O[db] = MFMA32(vf, pa[sidx][ks], O[db]); } }
            }
        }
        const float inv = 1.f / l;
#pragma unroll
        for (int db = 0; db < 2; ++db)
#pragma unroll
            for (int q4 = 0; q4 < 4; ++q4) { u32x2 wv; wv.x = cvt_pk_bf16(O[db][4 * q4] * inv, O[db][4 * q4 + 1] * inv); wv.y = cvt_pk_bf16(O[db][4 * q4 + 2] * inv, O[db][4 * q4 + 3] * inv);
                *(LAS u32x2*)(Qw + r * 128 + (((4 * db + q4) ^ (r & 7)) << 4) + 8 * hh) = wv; }
        const float lse2 = mx + __builtin_amdgcn_logf(l);
        if (grp == 2 && hh == 0) ((LAS float*)(lds + TBL_OFF))[wid * 32 + r] = lse2;
        asm volatile("s_waitcnt lgkmcnt(0)" ::: "memory");
#pragma unroll
        for (int ps = 0; ps < 4; ++ps) { const int row = (lane >> 3) + 8 * ps; const u32x4 vv = *(const LAS u32x4*)(Qw + row * 128 + (((lane & 7) ^ (row & 7)) << 4));
            const int tk = u.b * SEQ + (u.i0 + 32 * wid + row) * u.rr + u.cres; const size_t oo = (size_t)tk * D + u.h * 64 + (lane & 7) * 8;
            if (grp < 2) { *(u32x4*)(og + (size_t)u.g * T * D + oo) = vv; }
            else { const float l0 = lse[(size_t)tk * 16 + u.h], l1 = lse[(size_t)T * 16 + (size_t)tk * 16 + u.h], l2 = ((const LAS float*)(lds + TBL_OFF))[wid * 32 + row];
                const float mm = fmaxf(l0, fmaxf(l1, l2)); const float e0 = __builtin_amdgcn_exp2f(l0 - mm), e1 = __builtin_amdgcn_exp2f(l1 - mm), e2 = __builtin_amdgcn_exp2f(l2 - mm); const float iv = 1.f / (e0 + e1 + e2);
                const float w0 = e0 * iv, w1 = e1 * iv, w2 = e2 * iv;
                const u32x4 x0 = *(const u32x4*)(og + oo), x1 = *(const u32x4*)(og + (size_t)T * D + oo); u32x4 res;
#pragma unroll
                for (int k = 0; k < 4; ++k) { const float lo = w0 * bf2f(x0[k] & 0xffffu) + w1 * bf2f(x1[k] & 0xffffu) + w2 * bf2f(vv[k] & 0xffffu), hi = w0 * bf2f(x0[k] >> 16) + w1 * bf2f(x1[k] >> 16) + w2 * bf2f(vv[k] >> 16); res[k] = cvt_pk_bf16(lo, hi); }
                *(u32x4*)(omerged + oo) = res; } }
        asm volatile("s_waitcnt lgkmcnt(0)" ::: "memory");
        if (unn < 2048) ATTA_LOAD_Q(nu);
        if (grp < 2 && hh == 0) lse[(size_t)u.g * T * 16 + (size_t)tokq * 16 + u.h] = lse2;
        u = nu;
    }
#undef ATTA_LOAD_KQ
#undef ATTA_LOAD_Q
    ATT_WAITV(0);
    ATT_BAR();
}
template <int L, int SH = 0> DEV void phase_router_fast(const Ctx& c, LAS unsigned char* lds) {
    const int tid = opaque_tid(), wid = __builtin_amdgcn_readfirstlane(tid >> 6), lane = tid & 63, fr = lane & 15, fq = lane >> 4;
    LAS float* lg;
    const bf16_t* hbr = (const bf16_t*)(c.ws + WS_HB + (size_t)(L & 1) * 64 * MiB);
    unsigned char* ob = SH ? c.ws + WS_OG : c.ws;
    float* tok_gate = (float*)(ob + (SH ? 0 : WS_TOK)); int* tok_e = (int*)(ob + (SH ? 0 : WS_TOK) + 262144); int* tok_slot = (int*)(ob + (SH ? 0 : WS_TOK) + 524288);
    int* list = (int*)(ob + (SH ? 2 * MiB : WS_LIST)); float* list_rs = (float*)(ob + (SH ? 12 * MiB : WS_LRS)); float* list_gate = (float*)(ob + (SH ? 22 * MiB : WS_LGATE)); unsigned* cnt = ctl(c) + CW_CNT + (SH ? 4 : L) * 64 * CNT_S;
    const bf16_t* wbase = (const bf16_t*)(c.ws + WS_WRH) + (size_t)L * 80 * D;
#define RT_STAGE(ck, bufp) do { _Pragma("unroll") for (int i_ = 0; i_ < 5; ++i_) { const int ii = 5 * wid + i_, part = ii / 20, ri = ii % 20, row = 4 * ri + (lane >> 4); \
        glds16(wbase + (size_t)part * DEPTH * 80 * D + (size_t)row * D + 128 * (ck) + 8 * ((lane & 15) ^ (row & 15)), (bufp) + part * 20480 + ri * 1024); } } while (0)
    lg = (LAS float*)(lds + 81920) + wid * 1344;
    volatile LAS unsigned* lcnt = (volatile LAS unsigned*)(lds + 126976); volatile LAS unsigned* lbase = lcnt + 64;
    if (tid < 64) lcnt[tid] = 0u;
    for (int pass = blockIdx.x; pass < T / 128; pass += c.G) {
        const int tok0 = pass * 128 + wid * 16;
        f32x4 acc[5];
#pragma unroll
        for (int nt = 0; nt < 5; ++nt) acc[nt] = (f32x4){0.f, 0.f, 0.f, 0.f};
        float ssq = 0.f;
        const u32x4* ap8 = (const u32x4*)(hbr + (size_t)(tok0 + fr) * D + 8 * fq);
        RT_STAGE(0, lds);
        for (int ck = 0; ck < 8; ++ck) {
            u32x4 xa[4];
#pragma unroll
            for (int kb = 0; kb < 4; ++kb) xa[kb] = ap8[ck * 16 + kb * 4];
            ATT_WAITV(0);
            ATT_BAR();
            if (ck + 1 < 8) RT_STAGE(ck + 1, lds + ((ck + 1) & 1) * 40960);
            const LAS unsigned char* wb = lds + (ck & 1) * 40960 + fr * 256;
#pragma unroll
            for (int kb = 0; kb < 4; ++kb) {
                { const u32x4 v = xa[kb]; const float e0 = bf2f(v.x & 0xffffu), e1 = bf2f(v.x >> 16), e2 = bf2f(v.y & 0xffffu), e3 = bf2f(v.y >> 16), e4 = bf2f(v.z & 0xffffu), e5 = bf2f(v.z >> 16), e6 = bf2f(v.w & 0xffffu), e7 = bf2f(v.w >> 16);
                  ssq += ((e0 * e0 + e1 * e1) + (e2 * e2 + e3 * e3)) + ((e4 * e4 + e5 * e5) + (e6 * e6 + e7 * e7)); }
                const bf16x8 xhv = __builtin_bit_cast(bf16x8, xa[kb]); const int co = (((4 * kb + fq) ^ fr) << 4);
#pragma unroll
                for (int nt = 0; nt < 5; ++nt) { const bf16x8 wh = *(const LAS bf16x8*)(wb + nt * 4096 + co), wl = *(const LAS bf16x8*)(wb + 20480 + nt * 4096 + co);
                    acc[nt] = __builtin_amdgcn_mfma_f32_16x16x32_bf16(xhv, wh, acc[nt], 0, 0, 0); acc[nt] = __builtin_amdgcn_mfma_f32_16x16x32_bf16(xhv, wl, acc[nt], 0, 0, 0); }
            }
        }
        ssq += __shfl_xor(ssq, 16); ssq += __shfl_xor(ssq, 32);
        const float rs = rsqrtf(ssq * (1.f / D) + EPS);
        if (fq == 0) lg[1280 + fr] = rs;
#pragma unroll
        for (int nt = 0; nt < 5; ++nt)
#pragma unroll
            for (int i = 0; i < 4; ++i) lg[(4 * fq + i) * 80 + 16 * nt + fr] = acc[nt][i];
        wave_lds_fence();
        int e1 = 0, e2i = 0, r1 = 0, r2 = 0; float g1 = 0.f, g2 = 0.f, rsv = 0.f;
        if (lane < 16) { const LAS float* l = lg + lane * 80; rsv = lg[1280 + lane];
            float lc[8]; int gi = 0; float gm = -INFINITY;
#pragma unroll
            for (int j = 0; j < 8; ++j) { lc[j] = l[j] * rsv + c.b_coarse[L * 8 + j]; if (lc[j] > gm) { gm = lc[j]; gi = j; } }
            float gs = 0.f;
#pragma unroll
            for (int j = 0; j < 8; ++j) gs += __expf(lc[j] - gm);
            const float gp = 1.f / gs;
            float f[8];
#pragma unroll
            for (int j = 0; j < 8; ++j) f[j] = l[8 + gi * 8 + j] * rsv + c.b_fine[L * 64 + gi * 8 + j];
            int i1 = 0; float f1 = f[0];
#pragma unroll
            for (int j = 1; j < 8; ++j) if (f[j] > f1) { f1 = f[j]; i1 = j; }
            int i2 = (i1 == 0) ? 1 : 0; float f2 = -INFINITY;
#pragma unroll
            for (int j = 0; j < 8; ++j) if (j != i1 && f[j] > f2) { f2 = f[j]; i2 = j; }
            const float e2 = __expf(f2 - f1); const float p1 = 1.f / (1.f + e2), p2 = e2 / (1.f + e2);
            e1 = gi * 8 + i1; e2i = gi * 8 + i2; g1 = gp * p1; g2 = gp * p2;
            r1 = (int)__hip_atomic_fetch_add((LAS unsigned*)lcnt + e1, 1u, __ATOMIC_RELAXED, __HIP_MEMORY_SCOPE_WORKGROUP); r2 = (int)__hip_atomic_fetch_add((LAS unsigned*)lcnt + e2i, 1u, __ATOMIC_RELAXED, __HIP_MEMORY_SCOPE_WORKGROUP); }
        __syncthreads();
        if (tid < 64) { const unsigned n = lcnt[tid]; lbase[tid] = n ? atomicAdd(cnt + tid * CNT_S, n) : 0u; lcnt[tid] = 0u; }
        __syncthreads();
        if (lane < 16) { const int tok = tok0 + lane; const int s1 = (int)lbase[e1] + r1, s2 = (int)lbase[e2i] + r2; const float gp = 1.f, p1 = g1, p2 = g2;
            list[(size_t)e1 * T + s1] = tok * 2; list[(size_t)e2i * T + s2] = tok * 2 + 1; list_rs[(size_t)e1 * T + s1] = rsv; list_rs[(size_t)e2i * T + s2] = rsv; list_gate[(size_t)e1 * T + s1] = gp * p1; list_gate[(size_t)e2i * T + s2] = gp * p2;
            tok_e[tok * 2] = e1; tok_e[tok * 2 + 1] = e2i; tok_slot[tok * 2] = s1; tok_slot[tok * 2 + 1] = s2; tok_gate[tok * 2] = gp * p1; tok_gate[tok * 2 + 1] = gp * p2; }
        wave_lds_fence();
    }
#undef RT_STAGE
    ATT_WAITV(0);
    ATT_BAR();
}

template <int L, int SH = 0> DEV void phase_combine(const Ctx& c, LAS unsigned char* lds) {
    const int tid_ = opaque_tid(); const int w = tid_ >> 6, lane = tid_ & 63;
    LAS int* tpre = (LAS int*)(lds + TBL_TPRE);
    moe_prefix((const int*)(ctl(c) + CW_CNT + L * 64 * CNT_S), tpre);
    const bf16_t* hsrc = (const bf16_t*)(c.ws + WS_HB + (size_t)(L & 1) * 64 * MiB); bf16_t* hb = SH ? (bf16_t*)(c.ws + WS_OG + 128 * MiB) : (bf16_t*)(c.ws + WS_HB + (size_t)(L & 1) * 64 * MiB);
    float* ssq = SH ? (float*)(c.ws + WS_LSE) : (float*)(c.ws + WS_SSQ + (size_t)(L & 1) * 2 * MiB); const bf16_t* y = (const bf16_t*)(c.ws + WS_Y);
    const int* tok_e = (const int*)(c.ws + WS_TOK + 262144); const int* tok_slot = (const int*)(c.ws + WS_TOK + 524288);
    const int stride = c.G * NWAVES;
    for (int tok0 = blockIdx.x * NWAVES + w; tok0 < T; tok0 += 4 * stride) {
        int e0[4], e1[4], s0[4], s1[4];
#pragma unroll
        for (int q = 0; q < 4; ++q) { const int tok = tok0 + q * stride; const bool ok = tok < T; const int tt = ok ? tok : tok0;
            e0[q] = tok_e[tt * 2]; e1[q] = tok_e[tt * 2 + 1]; s0[q] = tok_slot[tt * 2]; s1[q] = tok_slot[tt * 2 + 1]; }
        u32x4 hv[4][2], ya[4][2], yb[4][2];
#pragma unroll
        for (int q = 0; q < 4; ++q) { const int tok = tok0 + q * stride; const int tt = (tok < T) ? tok : tok0;
            const size_t p0 = (size_t)tpre[e0[q]] * 256 + s0[q], p1 = (size_t)tpre[e1[q]] * 256 + s1[q];
            const u32x4* hs = (const u32x4*)(hsrc + (size_t)tt * D) + lane; const u32x4* y0 = (const u32x4*)(y + p0 * D) + lane; const u32x4* y1 = (const u32x4*)(y + p1 * D) + lane;
#pragma unroll
            for (int j = 0; j < 2; ++j) { hv[q][j] = hs[64 * j]; ya[q][j] = y0[64 * j]; yb[q][j] = y1[64 * j]; } }
#pragma unroll
        for (int q = 0; q < 4; ++q) { const int tok = tok0 + q * stride; if (tok < T) { u32x4* o = (u32x4*)(hb + (size_t)tok * D) + lane; float s = 0.f;
#pragma unroll
            for (int j = 0; j < 2; ++j) { u32x4 r;
#pragma unroll
                for (int k = 0; k < 4; ++k) { const float lo = bf2f(hv[q][j][k] & 0xffffu) + bf2f(ya[q][j][k] & 0xffffu) + bf2f(yb[q][j][k] & 0xffffu), hi = bf2f(hv[q][j][k] >> 16) + bf2f(ya[q][j][k] >> 16) + bf2f(yb[q][j][k] >> 16); r[k] = cvt_pk_bf16(lo, hi); s += lo * lo + hi * hi; }
                o[64 * j] = r; }
            s = wave_sum(s); if (lane < 4) ssq[(size_t)tok * 4 + lane] = (lane == 0) ? s : 0.f; } }
    }
}

DEV void phase_final(const Ctx& c) {
    const int tid_ = opaque_tid(); const int w = tid_ >> 6, lane = tid_ & 63;
    const bf16_t* hb = (const bf16_t*)(c.ws + WS_HB + (size_t)(DEPTH & 1) * 64 * MiB); const float* ssq = (const float*)(c.ws + WS_SSQ + (size_t)(DEPTH & 1) * 2 * MiB);
    const int stride = c.G * NWAVES;
    f32x4 g0[2], g1[2];
#pragma unroll
    for (int j = 0; j < 2; ++j) { const int col = (64 * j + lane) * 8; g0[j] = *(const f32x4*)(c.norm_final + col); g1[j] = *(const f32x4*)(c.norm_final + col + 4); }
    for (int tok0 = blockIdx.x * NWAVES + w; tok0 < T; tok0 += 4 * stride) {
        f32x4 pq[4]; u32x4 hv[4][2];
#pragma unroll
        for (int q = 0; q < 4; ++q) { const int tok = tok0 + q * stride; const int tt = (tok < T) ? tok : tok0; pq[q] = *(const f32x4*)(ssq + (size_t)tt * 4);
            const u32x4* hr = (const u32x4*)(hb + (size_t)tt * D) + lane; hv[q][0] = hr[0]; hv[q][1] = hr[64]; }
#pragma unroll
        for (int q = 0; q < 4; ++q) { const int tok = tok0 + q * stride; if (tok < T) {
            const float a = (pq[q][0] + pq[q][1]) + (pq[q][2] + pq[q][3]); const float rs = rsqrtf(a * (1.f / D) + EPS); f32x4* o = (f32x4*)(c.out + (size_t)tok * D);
#pragma unroll
            for (int j = 0; j < 2; ++j) { const u32x4 v = hv[q][j]; const int col = (64 * j + lane) * 8; f32x4 r0, r1;
                r0[0] = bf2f(v.x & 0xffffu) * rs * g0[j][0]; r0[1] = bf2f(v.x >> 16) * rs * g0[j][1]; r0[2] = bf2f(v.y & 0xffffu) * rs * g0[j][2]; r0[3] = bf2f(v.y >> 16) * rs * g0[j][3];
                r1[0] = bf2f(v.z & 0xffffu) * rs * g1[j][0]; r1[1] = bf2f(v.z >> 16) * rs * g1[j][1]; r1[2] = bf2f(v.w & 0xffffu) * rs * g1[j][2]; r1[3] = bf2f(v.w >> 16) * rs * g1[j][3];
                o[col / 4] = r0; o[col / 4 + 1] = r1; } } }
    }
}

template <int PH, int SUB = 0> DEV void run_phase(const Ctx& c, LAS unsigned char* lds) {
    unsigned char* ws = c.ws;
    if constexpr (PH == 0) { phase_prologue(c, lds); }
    else if constexpr (PH == 41) { phase_final(c); }
    else {
        constexpr int L = (PH - 1) / 10, S = (PH - 1) % 10, KIND = L % 3, J = L / 3;
        constexpr size_t HBC = WS_HB + (size_t)(L & 1) * 64 * MiB, HBN = WS_HB + (size_t)((L + 1) & 1) * 64 * MiB, SQC = WS_SSQ + (size_t)(L & 1) * 2 * MiB, SQN = WS_SSQ + (size_t)((L + 1) & 1) * 2 * MiB;
        if constexpr (S == 0) {
            Prob<0> p; p.headmajor = 1; p.A = (const bf16_t*)(ws + HBC); p.lda = D; p.K = D; p.out = (bf16_t*)(ws + WS_QKV + ((KIND == 0) ? (size_t)(SUB & 1) * 208 * MiB : 0)); p.ssq = (const float*)(ws + SQC);
            if (KIND == 0) { p.Bt = (const bf16_t*)(ws + WS_WAIN) + (size_t)J * NA * D + (size_t)SUB * NB * D; p.N = NB; }   else if (KIND == 1) { p.Bt = (const bf16_t*)(ws + WS_WBIN); p.N = NB; } else { p.Bt = (const bf16_t*)(ws + WS_WCIN); p.N = NB; }
            p.S.init(T, p.N, c.G, blockIdx.x);
            gemm_phase(p, lds);
        } else if constexpr (S == 1) {
            if constexpr (KIND == 0) { attA_fast(c, SUB, lds);
                if constexpr (SUB < 2) { __syncthreads(); run_phase<PH - 1, SUB + 1>(c, lds); } }
            else if constexpr (KIND == 1) {
                const float lambda_init = 0.8f - 0.6f * expf(-0.3f * (float)L);
                float s1 = 0.f, s2 = 0.f; for (int i = 0; i < 64; ++i) { s1 += c.lq1[J * 64 + i] * c.lk1[J * 64 + i]; s2 += c.lq2[J * 64 + i] * c.lk2[J * 64 + i]; }
                const float lam = expf(s1) - expf(s2) + lambda_init;
                attB_fast(c, lam, lambda_init, c.subln + J * 128, lds);
            } else { attC_fast(c, lds); }
        } else if constexpr (S == 2) {
        } else if constexpr (S == 3) {
            Prob<1> p; p.A = (const bf16_t*)(ws + WS_O); p.lda = D; p.K = D; p.N = D;
            p.Bt = (KIND == 0) ? (const bf16_t*)(ws + WS_WAOUT) + (size_t)J * D * D : (KIND == 1) ? (const bf16_t*)(ws + WS_WBOUT) : (const bf16_t*)(ws + WS_WCOUT);
            p.hin = (const bf16_t*)(ws + HBC); p.hb = (bf16_t*)(ws + HBC); p.ssq = (float*)(ws + SQC);
            if constexpr (SUB == 7) { p.hb = (bf16_t*)(ws + WS_OG + 128 * MiB); p.ssq = (float*)(ws + WS_LSE); }
            p.S.init(T, D, c.G, blockIdx.x);
            gemm_phase(p, lds);
        } else if constexpr (S == 4) {
            phase_router_fast<L, (SUB == 7) ? 1 : 0>(c, lds);
        } else if constexpr (S == 5) {
            LAS int* tpre = (LAS int*)(lds + TBL_TPRE); const int* cnt = (const int*)(ctl(c) + CW_CNT + L * 64 * CNT_S);
            moe_prefix(cnt, tpre);
            Prob<2> p; p.A = (const bf16_t*)(ws + HBC); p.lda = D; p.K = D; p.Bt = (const bf16_t*)(ws + WS_WGU) + (size_t)L * NE * 1024 * D; p.act = (bf16_t*)(ws + WS_ACT);
            p.list = (const int*)(ws + WS_LIST); p.list_rs = (const float*)(ws + WS_LRS); p.S.init(tpre, cnt, c.G, blockIdx.x, 4);
            gemm_phase(p, lds);
        } else if constexpr (S == 6) {
            LAS int* tpre = (LAS int*)(lds + TBL_TPRE); const int* cnt = (const int*)(ctl(c) + CW_CNT + L * 64 * CNT_S);
            moe_prefix(cnt, tpre);
            Prob<3> p; p.A = (const bf16_t*)(ws + WS_ACT); p.lda = FE; p.K = FE; p.Bt = (const bf16_t*)(ws + WS_WDN) + (size_t)L * NE * D * FE; p.y = (bf16_t*)(ws + WS_Y);
            p.list_gate = (const float*)(ws + WS_LGATE); p.S.init(tpre, cnt, c.G, blockIdx.x, 4);
            gemm_phase(p, lds);
        } else if constexpr (S == 7) {
            phase_combine<L, (SUB == 7) ? 1 : 0>(c, lds);
            __syncthreads();
            Prob<0> p; p.headmajor = 0; p.ssq = nullptr; p.A = (const bf16_t*)(ws + WS_PB) + (size_t)L * T * PLE; p.lda = PLE; p.K = PLE; p.N = D; p.Bt = (const bf16_t*)(ws + WS_WPP) + (size_t)L * D * PLE; p.out = (bf16_t*)(ws + WS_PROJ);
            p.S.init(T, D, c.G, blockIdx.x);
            gemm_phase(p, lds);
        } else if constexpr (S == 9) {
            if constexpr (KIND == 1) attB_kmax(c);
        } else if constexpr (S == 8) {
            Prob<5> p; p.A = (const bf16_t*)(ws + HBC); p.lda = D; p.K = D; p.N = D; p.Bt = (const bf16_t*)(ws + WS_WPG) + (size_t)L * D * D; p.proj = (const bf16_t*)(ws + WS_PROJ);
            p.hin = (const bf16_t*)(ws + HBC); p.hb = (bf16_t*)(ws + HBN); p.ssq_in = (const float*)(ws + SQC); p.ssq_out = (float*)(ws + SQN);
            if constexpr (SUB == 7) { p.hb = (bf16_t*)(ws + WS_OG + 128 * MiB); p.ssq_out = (float*)(ws + WS_LSE); }
            p.S.init(T, D, c.G, blockIdx.x);
            gemm_phase(p, lds);
        }
    }
}

#define XB_TMO      128
#define XB_XCNT(j)  (256  + 64 * (j))
#define XB_XSUB(j)  (1280 + 64 * (j))
#define XB_XGEN(j)  (2304 + 64 * (j))
#define XB_TOP      3328
#define XB_TOPGEN   3392
#define XCD_BAR_WORDS 3456
#define XB_SPIN_CAP (1u << 18)
__device__ __forceinline__ unsigned xb_ld(unsigned* p)              { return __hip_atomic_load(p, __ATOMIC_RELAXED, __HIP_MEMORY_SCOPE_AGENT); }
__device__ __forceinline__ unsigned xb_add(unsigned* p, unsigned v) { return __hip_atomic_fetch_add(p, v, __ATOMIC_RELAXED, __HIP_MEMORY_SCOPE_AGENT); }
__device__ __forceinline__ unsigned xb_xcc_id() { return (unsigned)__builtin_amdgcn_s_getreg((3 << 11) | 20) & 0xFu; }
#define XB_SPIN(cond, bar) do { unsigned _sp = 0; while (cond) { __builtin_amdgcn_s_sleep(1); \
    if ((++_sp & 255u) == 0u) { if (xb_ld(&(bar)[XB_TMO])) break; if (_sp > XB_SPIN_CAP) { atomicAdd(&(bar)[XB_TMO], 1u); break; } } } } while (0)
struct XcdBarrier {
    unsigned* bar; unsigned x;
    volatile LAS unsigned* st;
};
__device__ __forceinline__ XcdBarrier xcd_barrier_post(unsigned* bar, volatile LAS unsigned* st) {
    XcdBarrier b; b.bar = bar; b.x = xb_xcc_id(); b.st = st;
    if (threadIdx.x == 0) (void)xb_add(&bar[XB_XCNT(b.x)], 1u);
    return b;
}
__device__ __forceinline__ void xcd_barrier_complete(unsigned* bar, unsigned x, unsigned& nloc, unsigned& nx) {
    const unsigned G = gridDim.x * gridDim.y * gridDim.z;
    unsigned sum, cnt, mine, sp = 0u;
    for (;;) {
        sum = 0u; cnt = 0u; mine = 0u;
#pragma unroll
        for (unsigned j = 0; j < 16; ++j) { const unsigned c = xb_ld(&bar[XB_XCNT(j)]); sum += c; cnt += (c > 0u) ? 1u : 0u; mine = (j == x) ? c : mine; }
        if (sum == G) break;
        __builtin_amdgcn_s_sleep(1);
        if ((++sp & 255u) == 0u) { if (xb_ld(&bar[XB_TMO])) break; if (sp > XB_SPIN_CAP) { atomicAdd(&bar[XB_TMO], 1u); break; } }
    }
    nloc = mine > 0u ? mine : 1u; nx = cnt > 0u ? cnt : 1u;
}
__device__ __forceinline__ void xcd_barrier(const XcdBarrier& b) {
    asm volatile("s_waitcnt vmcnt(0)" ::: "memory");
    __syncthreads();
    if (threadIdx.x == 0) {
        unsigned* bar = b.bar;
        __builtin_amdgcn_s_waitcnt(0);
        unsigned nloc = b.st[0], nx = b.st[1];
        if (nloc == 0u) { xcd_barrier_complete(bar, b.x, nloc, nx); b.st[0] = nloc; b.st[1] = nx; }
        const unsigned old = xb_add(&bar[XB_XSUB(b.x)], 1u);
        const unsigned gen = old / nloc;
        if (old + 1u == (gen + 1u) * nloc) {
            __builtin_amdgcn_fence(__ATOMIC_RELEASE, "agent");
            asm volatile("s_waitcnt vmcnt(0)" ::: "memory");
            const unsigned og = xb_add(&bar[XB_TOP], 1u);
            const unsigned tg = og / nx;
            if (og + 1u == (tg + 1u) * nx) xb_add(&bar[XB_TOPGEN], 1u);
            else XB_SPIN(xb_ld(&bar[XB_TOPGEN]) == tg, bar);
            __builtin_amdgcn_fence(__ATOMIC_ACQUIRE, "agent");
            xb_add(&bar[XB_XGEN(b.x)], 1u);
            asm volatile("s_waitcnt vmcnt(0)" ::: "memory");
        } else {
            XB_SPIN(xb_ld(&bar[XB_XGEN(b.x)]) == gen, bar);
            __builtin_amdgcn_fence(__ATOMIC_ACQUIRE, "agent");
            asm volatile("s_waitcnt vmcnt(0)" ::: "memory");
        }
    }
    __syncthreads();
}

constexpr int CW_BAR = 4096;
constexpr int LDS_BARW = 143360;

typedef const __attribute__((address_space(4))) Ctx* KCtx;
template <int PH, int SUB = 0> DEV void run_phase_k(KCtx kc, LAS unsigned char* lds) {
#if defined(__HIP_DEVICE_COMPILE__)
    KCtx p = kc; asm volatile("" : "+s"(p));
    const Ctx c = *p;
    run_phase<PH, SUB>(c, lds);
#endif
}
#ifndef PA0
#define PA0 -1
#endif
#ifndef PA1
#define PA1 PA0
#endif
#ifndef PB0
#define PB0 -1
#endif
#ifndef PB1
#define PB1 PB0
#endif
#if PA0 >= 0 || PB0 >= 0
#define STAMP() do { if (blockIdx.x == 0 && threadIdx.x == 0) { ((unsigned long long*)(kc->ws + WS_STAMP))[nstamp] = __builtin_amdgcn_s_memrealtime(); } ++nstamp; } while (0)
#else
#define STAMP() do { } while (0)
#endif
#define BARS() do { xcd_barrier(bar); STAMP(); } while (0)
#ifndef PROBE_REP
#define PROBE_REP 0
#endif
template <int L> DEV void run_layer(KCtx kc, LAS unsigned char* lds, const XcdBarrier& bar, int& nstamp) {
    if constexpr (PROBE_REP == 5 && L == 1) { run_phase_k<1 + 10 * L + 0>(kc, lds); BARS(); }
    if constexpr (L % 3 == 0) {
        run_phase_k<1 + 10 * L + 0, 0>(kc, lds); BARS();
        run_phase_k<1 + 10 * L + 1, 0>(kc, lds); BARS();
        run_phase_k<1 + 10 * L + 1, 1>(kc, lds); BARS();
        run_phase_k<1 + 10 * L + 1, 2>(kc, lds); BARS();
    } else {
        run_phase_k<1 + 10 * L + 0>(kc, lds); BARS();
        if constexpr (L % 3 == 1) { run_phase_k<1 + 10 * L + 9>(kc, lds); BARS(); }
        run_phase_k<1 + 10 * L + 1>(kc, lds); BARS();
    }
    if constexpr (PROBE_REP == 6 && L == 2) { run_phase_k<1 + 10 * L + 1>(kc, lds); BARS(); }
    run_phase_k<1 + 10 * L + 3>(kc, lds); BARS();
    if constexpr (PROBE_REP == 1 && L == 0) { run_phase_k<1 + 10 * L + 3, 7>(kc, lds); BARS(); }
    if constexpr (PROBE_REP == 2 && L == 1) { run_phase_k<1 + 10 * L + 4, 7>(kc, lds); BARS(); }
    run_phase_k<1 + 10 * L + 4>(kc, lds); BARS();
    run_phase_k<1 + 10 * L + 5>(kc, lds); BARS();
    run_phase_k<1 + 10 * L + 6>(kc, lds); BARS();
    if constexpr (PROBE_REP == 3 && L == 1) { run_phase_k<1 + 10 * L + 7, 7>(kc, lds); BARS(); }
    run_phase_k<1 + 10 * L + 7>(kc, lds); BARS();
    if constexpr (PROBE_REP == 4 && L == 1) { run_phase_k<1 + 10 * L + 8, 7>(kc, lds); BARS(); }
    run_phase_k<1 + 10 * L + 8>(kc, lds); BARS();
}
__global__ void __launch_bounds__(NTHR, 2) mega_fwd(Ctx cin) {
    extern __shared__ __attribute__((aligned(16))) unsigned char lds_raw[];
    LAS unsigned char* lds = (LAS unsigned char*)lds_raw;
    KCtx kc = (KCtx)__builtin_amdgcn_kernarg_segment_ptr();
    if (threadIdx.x < 4) ((LAS unsigned*)(lds + LDS_BARW))[threadIdx.x] = 0u;
    __syncthreads();
    const XcdBarrier bar = xcd_barrier_post((unsigned*)(cin.ws + WS_CTL) + CW_BAR, (volatile LAS unsigned*)(lds + LDS_BARW));
    int nstamp = 0; (void)nstamp;
    STAMP();
    run_phase_k<0>(kc, lds); BARS();
    run_layer<0>(kc, lds, bar, nstamp); run_layer<1>(kc, lds, bar, nstamp); run_layer<2>(kc, lds, bar, nstamp); run_layer<3>(kc, lds, bar, nstamp);
    run_phase_k<41>(kc, lds);
#if PA0 >= 0 || PB0 >= 0
    BARS();
    if (blockIdx.x == 0) { const unsigned long long* st = (const unsigned long long*)(cin.ws + WS_STAMP);
        const float da = (PA0 >= 0) ? (float)(st[PA1] - st[PA0 - 1]) * 0.01f : 0.f, db = (PB0 >= 0) ? (float)(st[PB1] - st[PB0 - 1]) * 0.01f : 0.f;
        if (threadIdx.x == 0) cin.out[0] += da * 0.2f;
        for (int i = threadIdx.x; i < (1 << 20); i += NTHR) cin.out[1024 + i] += db * 0.005f; }
#endif
}
static void launch_all(const Ctx& c, hipStream_t stream) {
    static bool attr = false;
    if (!attr) { (void)hipFuncSetAttribute((const void*)mega_fwd, hipFuncAttributeMaxDynamicSharedMemorySize, LDS_BYTES);
        int per_cu = 0; if (hipOccupancyMaxActiveBlocksPerMultiprocessor(&per_cu, (const void*)mega_fwd, NTHR, LDS_BYTES) != hipSuccess || per_cu < 1) fprintf(stderr, "kernel_launch: occupancy query reports %d blocks per CU\n", per_cu);
        (void)hipGetLastError(); attr = true; }
    hipLaunchKernelGGL(mega_fwd, dim3(c.G), dim3(NTHR), LDS_BYTES, stream, c);
}


extern "C" void kernel_launch(void* const* d_in, const int* in_sizes, int n_in, void* d_out, int out_size, void* d_ws, size_t ws_size, hipStream_t stream) {
    if (n_in != 25 || ws_size < WS_END) { fprintf(stderr, "kernel_launch: unexpected n_in %d or ws_size %zu (< %zu)\n", n_in, ws_size, (size_t)WS_END); return; }
    static int grid = 0;
    if (!grid) { int dev = 0, cus = 0; (void)hipGetDevice(&dev); (void)hipDeviceGetAttribute(&cus, hipDeviceAttributeMultiprocessorCount, dev); grid = cus > 0 ? cus : 256; }
    Ctx c{};
    const float* const* in = (const float* const*)d_in;
    c.x = in[0]; c.p = in[1]; c.norm_mix = in[2]; c.norm_ffn = in[3]; c.norm_ple = in[4]; c.norm_final = in[5];
    c.a_w_in = in[6]; c.a_w_out = in[7]; c.b_w_in = in[8]; c.b_w_out = in[9]; c.lq1 = in[10]; c.lk1 = in[11]; c.lq2 = in[12]; c.lk2 = in[13]; c.subln = in[14];
    c.c_w_in = in[15]; c.c_w_out = in[16]; c.w_coarse = in[17]; c.b_coarse = in[18]; c.w_fine = in[19]; c.b_fine = in[20]; c.w_gu = in[21]; c.w_dn = in[22]; c.w_pp = in[23]; c.w_pg = in[24];
    c.out = (float*)d_out; c.ws = (unsigned char*)d_ws; c.G = grid; c.pad = 0;
    (void)hipMemsetAsync((char*)d_ws + WS_CTL, 0, CTL_BYTES, stream);
    launch_all(c, stream);
}
```
